# Optimizing an MI355X kernel written in HIP

```python
import math
import jax, jax.numpy as jnp
from jax import lax
import numpy as np

D_MODEL = 1024
BATCH = 8
SEQ = 2048
DEPTH = 2

N_MIXERS = 2
N_A_LAYERS = (DEPTH + 1) // 2
N_B_LAYERS = DEPTH // 2
BLOCK_Q = 128
RMS_EPS = 1e-6

N_BUCKETS = 32
MAX_DISTANCE = 128
N_BIAS_COLS = 16

A_HEADS = 16
A_HEAD_DIM = D_MODEL // A_HEADS
A_WIDTH = A_HEADS * A_HEAD_DIM
A_Q_RANK = D_MODEL // 4
A_KV_RANK = D_MODEL // 8
IDX_HEADS = 8
IDX_DIM = 64
TOPK_MAX = 256
A_IN = A_Q_RANK + A_KV_RANK + IDX_DIM + IDX_HEADS + A_WIDTH

B_HEADS = 8
B_HEAD_DIM = D_MODEL // (2 * B_HEADS)
B_WIDTH = B_HEADS * 2 * B_HEAD_DIM
B_IN = 4 * B_WIDTH

kernel_name = "hybrid_dsa_diffattn_adaln_block"


def rms_norm(x, g):
    xf = x.astype(jnp.float32)
    y = xf * lax.rsqrt(jnp.mean(xf * xf, axis=-1, keepdims=True) + RMS_EPS)
    return (y * g.astype(jnp.float32)).astype(x.dtype)


def t5_bucket(rel):
    n = jnp.maximum(rel, 0)
    max_exact = N_BUCKETS // 2
    nf = jnp.maximum(n, 1).astype(jnp.float32)
    large = max_exact + (jnp.log(nf / max_exact) / math.log(MAX_DISTANCE / max_exact)
                         * (N_BUCKETS - max_exact)).astype(jnp.int32)
    large = jnp.minimum(large, N_BUCKETS - 1)
    return jnp.where(n < max_exact, n, large)


def to_blocks(a, nb):
    return jnp.moveaxis(a.reshape(a.shape[0], nb, BLOCK_Q, *a.shape[2:]), 1, 0)


def from_blocks(a):
    a = jnp.moveaxis(a, 0, 1)
    return a.reshape(a.shape[0], a.shape[1] * a.shape[2], *a.shape[3:])


def dsa_mixer(h, rel_bias, w_in, q_norm_g, kv_norm_g, kidx_norm_g, w_uq, w_qidx, w_uk, w_uv, w_out):
    bsz, L, _ = h.shape
    proj = h @ w_in
    o1 = A_Q_RANK
    o2 = o1 + A_KV_RANK
    o3 = o2 + IDX_DIM
    o4 = o3 + IDX_HEADS
    c_q = rms_norm(proj[..., :o1], q_norm_g)
    c_kv = rms_norm(proj[..., o1:o2], kv_norm_g)
    k_idx = rms_norm(proj[..., o2:o3], kidx_norm_g)
    w_idx = proj[..., o3:o4] * (IDX_HEADS ** -0.5 * IDX_DIM ** -0.5)
    gate = proj[..., o4:]

    q = (c_q @ w_uq).reshape(bsz, L, A_HEADS, A_HEAD_DIM)
    q_abs = jnp.einsum('blhd,hrd->blhr', q, w_uk) * (A_HEAD_DIM ** -0.5)
    q_idx = (c_q @ w_qidx).reshape(bsz, L, IDX_HEADS, IDX_DIM)

    k_top = min(TOPK_MAX, L // 4)
    nb = L // BLOCK_Q
    key_pos = jnp.arange(L)

    def block(args):
        qa, qi, wi, start = args
        t = start + jnp.arange(BLOCK_Q)
        causal = key_pos[None, :] <= t[:, None]
        s_idx = jnp.einsum('bqhd,bld->bqhl', qi, k_idx)
        score = jnp.einsum('bqh,bqhl->bql', wi.astype(jnp.float32),
                           jax.nn.relu(s_idx).astype(jnp.float32))
        score = jnp.where(causal[None], score, -jnp.inf)
        _, sel = lax.top_k(score, k_top)
        valid = sel <= t[None, :, None]
        kv_sel = jax.vmap(lambda ck, ix: ck[ix])(c_kv, sel)
        logits = jnp.einsum('bqhr,bqkr->bhqk', qa, kv_sel).astype(jnp.float32)
        bias = rel_bias[t5_bucket(t[None, :, None] - sel)].astype(jnp.float32)
        logits = logits + jnp.moveaxis(bias, -1, 1)
        logits = jnp.where(valid[:, None], logits, -jnp.inf)
        p = jax.nn.softmax(logits, axis=-1).astype(kv_sel.dtype)
        return jnp.einsum('bhqk,bqkr->bqhr', p, kv_sel)

    starts = jnp.arange(nb, dtype=jnp.int32) * BLOCK_Q
    o_lat = from_blocks(lax.map(block, (to_blocks(q_abs, nb), to_blocks(q_idx, nb),
                                        to_blocks(w_idx, nb), starts)))
    o = jnp.einsum('blhr,hrd->blhd', o_lat, w_uv).reshape(bsz, L, A_WIDTH)
    return (o * jax.nn.silu(gate)) @ w_out


def diff_mixer(h, rel_bias, w_in, lam_q1, lam_k1, lam_q2, lam_k2, subln_g, w_out, lambda_init):
    bsz, L, _ = h.shape
    proj = h @ w_in
    q = proj[..., :B_WIDTH].reshape(bsz, L, 2 * B_HEADS, B_HEAD_DIM) * (B_HEAD_DIM ** -0.5)
    k = proj[..., B_WIDTH:2 * B_WIDTH].reshape(bsz, L, 2 * B_HEADS, B_HEAD_DIM)
    v = proj[..., 2 * B_WIDTH:3 * B_WIDTH].reshape(bsz, L, B_HEADS, 2 * B_HEAD_DIM)
    gate = proj[..., 3 * B_WIDTH:]
    lam = (jnp.exp(jnp.sum(lam_q1.astype(jnp.float32) * lam_k1.astype(jnp.float32)))
           - jnp.exp(jnp.sum(lam_q2.astype(jnp.float32) * lam_k2.astype(jnp.float32)))
           + lambda_init)

    nb = L // BLOCK_Q
    key_pos = jnp.arange(L)

    def block(args):
        qb, start = args
        t = start + jnp.arange(BLOCK_Q)
        rel = t[:, None] - key_pos[None, :]
        bias = rel_bias[t5_bucket(rel)].astype(jnp.float32)
        logits = jnp.einsum('bqmd,blmd->bmql', qb, k).astype(jnp.float32)
        logits = logits + jnp.moveaxis(bias, -1, 0)[None]
        logits = jnp.where((rel >= 0)[None, None], logits, -jnp.inf)
        p = jax.nn.softmax(logits, axis=-1).reshape(bsz, B_HEADS, 2, BLOCK_Q, L)
        a = p[:, :, 0] - lam * p[:, :, 1]
        return jnp.einsum('bhql,blhe->bqhe', a.astype(v.dtype), v)

    starts = jnp.arange(nb, dtype=jnp.int32) * BLOCK_Q
    o = from_blocks(lax.map(block, (to_blocks(q, nb), starts)))
    o = rms_norm(o, subln_g) * (1.0 - lambda_init)
    o = o.reshape(bsz, L, B_WIDTH)
    return (o * jax.nn.silu(gate)) @ w_out


def setup_inputs(seed: int = 0) -> dict:
    key = jax.random.key(seed)
    ks = iter(jax.random.split(key, 32))

    def nrm(shape, fan_in, scale=1.0):
        return jax.random.normal(next(ks), shape, jnp.float32) * (scale * fan_in ** -0.5)

    def gain(shape):
        return 1.0 + 0.05 * jax.random.normal(next(ks), shape, jnp.float32)

    na, nbl = N_A_LAYERS, N_B_LAYERS
    return {
        "x": jax.random.normal(next(ks), (BATCH, SEQ, D_MODEL), jnp.float32),
        "c": jax.random.normal(next(ks), (BATCH, D_MODEL), jnp.float32),
        "rel_bias": 0.5 * jax.random.normal(next(ks), (N_BUCKETS, N_BIAS_COLS), jnp.float32),
        "mod_w": nrm((DEPTH, D_MODEL, 3 * D_MODEL), D_MODEL, 0.5),
        "mod_b": 0.02 * jax.random.normal(next(ks), (DEPTH, 3 * D_MODEL), jnp.float32),
        "pre_g": gain((DEPTH, D_MODEL)),
        "post_g": gain((DEPTH, D_MODEL)),
        "a_w_in": nrm((na, D_MODEL, A_IN), D_MODEL),
        "a_q_norm": gain((na, A_Q_RANK)),
        "a_kv_norm": gain((na, A_KV_RANK)),
        "a_kidx_norm": gain((na, IDX_DIM)),
        "a_w_uq": nrm((na, A_Q_RANK, A_WIDTH), A_Q_RANK),
        "a_w_qidx": nrm((na, A_Q_RANK, IDX_HEADS * IDX_DIM), A_Q_RANK),
        "a_w_uk": nrm((na, A_HEADS, A_KV_RANK, A_HEAD_DIM), A_KV_RANK),
        "a_w_uv": nrm((na, A_HEADS, A_KV_RANK, A_HEAD_DIM), A_KV_RANK),
        "a_w_out": nrm((na, A_WIDTH, D_MODEL), A_WIDTH),
        "b_w_in": nrm((nbl, D_MODEL, B_IN), D_MODEL),
        "b_lam_q1": 0.1 * jax.random.normal(next(ks), (nbl, B_HEAD_DIM), jnp.float32),
        "b_lam_k1": 0.1 * jax.random.normal(next(ks), (nbl, B_HEAD_DIM), jnp.float32),
        "b_lam_q2": 0.1 * jax.random.normal(next(ks), (nbl, B_HEAD_DIM), jnp.float32),
        "b_lam_k2": 0.1 * jax.random.normal(next(ks), (nbl, B_HEAD_DIM), jnp.float32),
        "b_subln": gain((nbl, 2 * B_HEAD_DIM)),
        "b_w_out": nrm((nbl, B_WIDTH, D_MODEL), B_WIDTH),
    }


def reference(x, c, rel_bias, mod_w, mod_b, pre_g, post_g,
              a_w_in, a_q_norm, a_kv_norm, a_kidx_norm, a_w_uq, a_w_qidx, a_w_uk, a_w_uv, a_w_out,
              b_w_in, b_lam_q1, b_lam_k1, b_lam_q2, b_lam_k2, b_subln, b_w_out):
    c_act = jax.nn.silu(c)
    for i in range(DEPTH):
        mod = (c_act @ mod_w[i] + mod_b[i])[:, None, :]
        shift = mod[..., :D_MODEL]
        scale = mod[..., D_MODEL:2 * D_MODEL]
        res_gate = mod[..., 2 * D_MODEL:]
        h = rms_norm(x, pre_g[i]) * (1.0 + scale) + shift
        if i % N_MIXERS == 0:
            j = i // N_MIXERS
            y = dsa_mixer(h, rel_bias, a_w_in[j], a_q_norm[j], a_kv_norm[j], a_kidx_norm[j],
                          a_w_uq[j], a_w_qidx[j], a_w_uk[j], a_w_uv[j], a_w_out[j])
        else:
            j = i // N_MIXERS
            lambda_init = 0.8 - 0.6 * math.exp(-0.3 * i)
            y = diff_mixer(h, rel_bias, b_w_in[j], b_lam_q1[j], b_lam_k1[j], b_lam_q2[j],
                           b_lam_k2[j], b_subln[j], b_w_out[j], lambda_init)
        x = x + res_gate * rms_norm(y, post_g[i])
    return x
```

```cpp
#include <hip/hip_runtime.h>
#include <stdint.h>
#include <math.h>

typedef unsigned short bf16_t;
__device__ __forceinline__ float bf2f(bf16_t v) { return __uint_as_float((unsigned)v << 16); }
__device__ __forceinline__ bf16_t f2bf(float f) { unsigned u = __float_as_uint(f); return (bf16_t)((u + 0x7fffu + ((u >> 16) & 1u)) >> 16); }

constexpr int NB = 8, L = 2048, D = 1024, M = NB * L;
constexpr int A_IN = 1480, A_INP = 1536, QR = 256, KVR = 128, IDXD = 64, IDXH = 8, AH = 16, AHD = 64, TOPK = 256;
constexpr int NQQ = 512 + 2048;
constexpr int B_IN = 4096, BH = 8, BHD = 64;
constexpr float EPS = 1e-6f;
constexpr float LOG2E = 1.4426950408889634f;
constexpr float LAMBDA_INIT = 0.35550906759096934f;

constexpr size_t MiB = 1u << 20;
constexpr size_t WS_CTL = 0;
constexpr size_t WS_WIN0 = 1 * MiB;
constexpr size_t WS_WQ2 = 4 * MiB;
constexpr size_t WS_WUV = 6 * MiB;
constexpr size_t WS_WOUT0 = 7 * MiB;
constexpr size_t WS_WIN1 = 9 * MiB;
constexpr size_t WS_WOUT1 = 17 * MiB;
constexpr size_t WS_MOD = 19 * MiB;
constexpr size_t WS_MISC = 19 * MiB + 512 * 1024;
constexpr size_t WS_CKV = 20 * MiB;
constexpr size_t WS_KI = 24 * MiB;
constexpr size_t WS_WI = 26 * MiB;
constexpr size_t WS_RSQ = 27 * MiB;
constexpr size_t WS_SEL = 28 * MiB;
constexpr size_t WS_H = 32 * MiB;
constexpr size_t WS_PROJ0 = 64 * MiB;
constexpr size_t WS_QQ = 112 * MiB;
constexpr size_t WS_OLAT = 192 * MiB;
constexpr size_t WS_OG0 = 112 * MiB;
constexpr size_t WS_Y0 = 144 * MiB;
constexpr size_t WS_PROJ1 = 64 * MiB;
constexpr size_t WS_OG1 = 224 * MiB;
constexpr size_t WS_Y1 = 32 * MiB;

struct Misc { float lam; int pad[31]; int lut[128]; float btab[128 * 16]; };

enum { I_X = 0, I_C, I_RELB, I_MODW, I_MODB, I_PREG, I_POSTG, I_AWIN, I_AQN, I_AKVN, I_AKIN, I_AWUQ, I_AWQIDX, I_AWUK, I_AWUV, I_AWOUT,
       I_BWIN, I_BLQ1, I_BLK1, I_BLQ2, I_BLK2, I_BSUBLN, I_BWOUT };

__device__ __forceinline__ float siluf(float v) { return v / (1.f + __expf(-v)); }

__global__ void k_prep_w(const float* src, int K, int N, int Npad, const float* g, float sc, bf16_t* dst, int ldd) {
    size_t i = (size_t)blockIdx.x * blockDim.x + threadIdx.x; if (i >= (size_t)Npad * K) return;
    int n = (int)(i / K), k = (int)(i % K);
    float v = 0.f; if (n < N) v = src[(size_t)k * N + n] * (g ? g[k] : 1.f) * sc;
    dst[(size_t)n * ldd + k] = f2bf(v);
}
__global__ void k_prep_wqabs(const float* w_uq, const float* w_uk, const float* g, bf16_t* wq2) {
    int i = blockIdx.x * blockDim.x + threadIdx.x; if (i >= 2048 * 256) return;
    int n = i / 256, k = i % 256, h = n / 128, r = n % 128; float s = 0.f;
    for (int d = 0; d < 64; ++d) s += w_uq[(size_t)k * 1024 + h * 64 + d] * w_uk[((size_t)h * 128 + r) * 64 + d];
    wq2[(size_t)(512 + n) * 256 + k] = f2bf(s * g[k] * (0.125f * LOG2E));
}
__global__ void k_prep_wuv(const float* w_uv, bf16_t* wuv) {
    int i = blockIdx.x * blockDim.x + threadIdx.x; if (i >= 1024 * 512) return;
    int n = i / 512, kp = i % 512, h = n / 64, d = n % 64; float v = 0.f;
    if (kp / 128 == (n % 256) / 64) v = w_uv[((size_t)h * 128 + (kp % 128)) * 64 + d];
    wuv[i] = f2bf(v);
}
__global__ void k_mod(const float* c, const float* mod_w, const float* mod_b, float* mod) {
    int i = blockIdx.x * blockDim.x + threadIdx.x; if (i >= 2 * 3072) return;
    int li = i / 3072, n = i % 3072; float acc[NB];
#pragma unroll
    for (int b = 0; b < NB; ++b) acc[b] = 0.f;
    for (int k = 0; k < D; ++k) { float w = mod_w[((size_t)li * D + k) * 3072 + n];
#pragma unroll
        for (int b = 0; b < NB; ++b) acc[b] += siluf(c[b * D + k]) * w; }
#pragma unroll
    for (int b = 0; b < NB; ++b) mod[((size_t)li * NB + b) * 3072 + n] = acc[b] + mod_b[li * 3072 + n];
}
__global__ void k_misc(const float* relb, const float* lq1, const float* lk1, const float* lq2, const float* lk2, Misc* ms) {
    int t = threadIdx.x;
    if (t == 0) { float s1 = 0.f, s2 = 0.f; for (int i = 0; i < 64; ++i) { s1 += lq1[i] * lk1[i]; s2 += lq2[i] * lk2[i]; } ms->lam = expf(s1) - expf(s2) + LAMBDA_INIT; }
    if (t < 128) { int bk; if (t < 16) bk = t; else { bk = 16 + (int)(logf((float)t / 16.f) / 2.0794415416798357f * 16.f); if (bk > 31) bk = 31; } ms->lut[t] = bk;
        for (int cix = 0; cix < 16; ++cix) ms->btab[t * 16 + cix] = relb[bk * 16 + cix]; }
}
__device__ __forceinline__ float block_sum(float v, float* red) {
    for (int o = 32; o > 0; o >>= 1) v += __shfl_xor(v, o);
    __syncthreads(); if ((threadIdx.x & 63) == 0) red[threadIdx.x >> 6] = v; __syncthreads();
    return red[0] + red[1] + red[2] + red[3];
}
__global__ void k_prenorm(const float* x, const float* g, const float* mod, bf16_t* h) {
    __shared__ float red[4]; int row = blockIdx.x, b = row / L, t = threadIdx.x;
    float4 v = ((const float4*)(x + (size_t)row * D))[t];
    float ss = block_sum(v.x * v.x + v.y * v.y + v.z * v.z + v.w * v.w, red);
    float rs = rsqrtf(ss / D + EPS); const float* sh = mod + (size_t)b * 3072; const float* sc = sh + 1024;
    float in[4] = {v.x, v.y, v.z, v.w};
    for (int j = 0; j < 4; ++j) { int cidx = 4 * t + j; h[(size_t)row * D + cidx] = f2bf(in[j] * rs * g[cidx] * (1.f + sc[cidx]) + sh[cidx]); }
}
enum { EPI_PLAIN = 0, EPI_ROWSCALE = 1, EPI_QSCALE = 2 };
template <int EPI> __global__ void k_gemm(const bf16_t* A, int lda, const bf16_t* Bt, int ldb, bf16_t* C, int ldc, int K, const float* rsq) {
    __shared__ float As[64][33], Bs[64][33];
    int tx = threadIdx.x & 15, ty = threadIdx.x >> 4, m0 = blockIdx.y * 64, n0 = blockIdx.x * 64;
    float acc[4][4] = {};
    int lr = threadIdx.x >> 2, lc = (threadIdx.x & 3) * 8;
    for (int k0 = 0; k0 < K; k0 += 32) {
        uint4 av = *(const uint4*)(A + (size_t)(m0 + lr) * lda + k0 + lc), bv = *(const uint4*)(Bt + (size_t)(n0 + lr) * ldb + k0 + lc);
        const bf16_t* ap = (const bf16_t*)&av; const bf16_t* bp = (const bf16_t*)&bv;
        for (int j = 0; j < 8; ++j) { As[lr][lc + j] = bf2f(ap[j]); Bs[lr][lc + j] = bf2f(bp[j]); }
        __syncthreads();
#pragma unroll 4
        for (int kk = 0; kk < 32; ++kk) { float a[4], bb[4];
#pragma unroll
            for (int i = 0; i < 4; ++i) { a[i] = As[ty * 4 + i][kk]; bb[i] = Bs[tx * 4 + i][kk]; }
#pragma unroll
            for (int i = 0; i < 4; ++i)
#pragma unroll
                for (int j = 0; j < 4; ++j) acc[i][j] += a[i] * bb[j]; }
        __syncthreads();
    }
#pragma unroll
    for (int i = 0; i < 4; ++i)
#pragma unroll
      for (int j = 0; j < 4; ++j) { int m = m0 + ty * 4 + i, n = n0 + tx * 4 + j; float v = acc[i][j];
        if (EPI == EPI_ROWSCALE) v *= rsqrtf(rsq[m] / QR + EPS);
        if (EPI == EPI_QSCALE) { if (n < 1024) v *= 0.125f * LOG2E; }
        C[(size_t)m * ldc + n] = f2bf(v); }
}
__global__ void k_rowstats0(const bf16_t* proj, const float* kvg, const float* kig, float* rsq, bf16_t* ckv, bf16_t* ki, float* wi) {
    __shared__ float red[4]; int row = blockIdx.x, t = threadIdx.x; const bf16_t* p = proj + (size_t)row * A_INP;
    float vq = bf2f(p[t]); float sq = block_sum(vq * vq, red);
    float vkv = t < 128 ? bf2f(p[256 + t]) : 0.f; float skv = block_sum(vkv * vkv, red);
    float vki = t < 64 ? bf2f(p[384 + t]) : 0.f; float ski = block_sum(vki * vki, red);
    if (t == 0) rsq[row] = sq;
    if (t < 128) ckv[(size_t)row * 128 + t] = f2bf(vkv * rsqrtf(skv / 128.f + EPS) * kvg[t]);
    if (t < 64) ki[(size_t)row * 64 + t] = f2bf(vki * rsqrtf(ski / 64.f + EPS) * kig[t]);
    if (t < 8) wi[(size_t)row * 8 + t] = bf2f(p[448 + t]) * (0.35355339059327373f * 0.125f);
}
__device__ __forceinline__ unsigned fkey(float f) { unsigned u = __float_as_uint(f); return (u & 0x80000000u) ? ~u : (u | 0x80000000u); }
__global__ void __launch_bounds__(256) k_topk(const bf16_t* qq, const bf16_t* ki, const float* wi, unsigned* sel) {
    __shared__ float qs[512]; __shared__ unsigned keys[2048]; __shared__ unsigned cnts[256]; __shared__ unsigned words[64]; __shared__ float ws[8];
    int row = blockIdx.x, b = row / L, t = row % L, tid = threadIdx.x;
    for (int i = tid; i < 512; i += 256) qs[i] = bf2f(qq[(size_t)row * NQQ + i]);
    if (tid < 8) ws[tid] = wi[(size_t)row * 8 + tid];
    if (tid < 64) words[tid] = 0u;
    __syncthreads();
    for (int s = tid; s < L; s += 256) {
        unsigned kk = 0u;
        if (s <= t) { const bf16_t* kr = ki + ((size_t)b * L + s) * 64; float a0 = 0.f, a1 = 0.f, a2 = 0.f, a3 = 0.f, a4 = 0.f, a5 = 0.f, a6 = 0.f, a7 = 0.f;
            for (int d = 0; d < 64; ++d) { float kf = bf2f(kr[d]); a0 += qs[d] * kf; a1 += qs[64 + d] * kf; a2 += qs[128 + d] * kf; a3 += qs[192 + d] * kf;
                a4 += qs[256 + d] * kf; a5 += qs[320 + d] * kf; a6 += qs[384 + d] * kf; a7 += qs[448 + d] * kf; }
            float sc = ws[0] * fmaxf(a0, 0.f); sc += ws[1] * fmaxf(a1, 0.f); sc += ws[2] * fmaxf(a2, 0.f); sc += ws[3] * fmaxf(a3, 0.f);
            sc += ws[4] * fmaxf(a4, 0.f); sc += ws[5] * fmaxf(a5, 0.f); sc += ws[6] * fmaxf(a6, 0.f); sc += ws[7] * fmaxf(a7, 0.f);
            kk = fkey(sc); }
        keys[s] = kk;
    }
    __syncthreads();
    int nvalid = t + 1;
    if (nvalid <= TOPK) { for (int s = tid; s <= t; s += 256) atomicOr(&words[s >> 5], 1u << (s & 31)); }
    else {
        unsigned prefix = 0u;
        for (int bit = 31; bit >= 0; --bit) {
            unsigned cand = prefix | (1u << bit); unsigned c = 0;
            for (int i = 0; i < 8; ++i) c += keys[tid * 8 + i] >= cand;
            cnts[tid] = c; __syncthreads();
            for (int o = 128; o > 0; o >>= 1) { if (tid < o) cnts[tid] += cnts[tid + o]; __syncthreads(); }
            unsigned tot = cnts[0]; __syncthreads();
            if (tot >= (unsigned)TOPK) prefix = cand;
        }
        unsigned cg = 0, ce = 0; for (int i = 0; i < 8; ++i) { unsigned k = keys[tid * 8 + i]; cg += k > prefix; ce += k == prefix; }
        cnts[tid] = cg; __syncthreads();
        for (int o = 128; o > 0; o >>= 1) { if (tid < o) cnts[tid] += cnts[tid + o]; __syncthreads(); }
        unsigned ngt = cnts[0]; __syncthreads();
        cnts[tid] = ce; __syncthreads();
        if (tid == 0) { unsigned run = 0; for (int i = 0; i < 256; ++i) { unsigned v = cnts[i]; cnts[i] = run; run += v; } }
        __syncthreads();
        unsigned need = TOPK - ngt, rank = cnts[tid];
        for (int i = 0; i < 8; ++i) { int s = tid * 8 + i; unsigned k = keys[s]; bool take = k > prefix; if (k == prefix) { take = rank < need; ++rank; }
            if (take) atomicOr(&words[s >> 5], 1u << (s & 31)); }
    }
    __syncthreads();
    if (tid < 64) sel[(size_t)row * 64 + tid] = words[tid];
}
__global__ void __launch_bounds__(256) k_sparse(const bf16_t* qq, const bf16_t* ckv, const unsigned* sel, const Misc* ms, bf16_t* olat) {
    __shared__ float qa[16 * 128]; __shared__ int idx[256]; __shared__ float lg[16 * 256]; __shared__ int nsel_s;
    int row = blockIdx.x, b = row / L, t = row % L, tid = threadIdx.x;
    for (int i = tid; i < 2048; i += 256) qa[i] = bf2f(qq[(size_t)row * NQQ + 512 + i]);
    if (tid == 0) { int n = 0; for (int w = 0; w < 64; ++w) { unsigned v = sel[(size_t)row * 64 + w]; while (v) { int bpos = __ffs(v) - 1; v &= v - 1; if (n < 256) idx[n] = w * 32 + bpos; ++n; } } nsel_s = n < 256 ? n : 256; }
    __syncthreads();
    int ns = nsel_s;
    for (int p = tid; p < 16 * 256; p += 256) { int h = p >> 8, k = p & 255; float v = -INFINITY;
        if (k < ns) { const bf16_t* kr = ckv + ((size_t)b * L + idx[k]) * 128; float a = 0.f; for (int r = 0; r < 128; ++r) a += qa[h * 128 + r] * bf2f(kr[r]);
            int dd = t - idx[k]; if (dd > 127) dd = 127; v = a + ms->btab[dd * 16 + h] * LOG2E; }
        lg[p] = v; }
    __syncthreads();
    if (tid < 16) { float mx = -INFINITY; for (int k = 0; k < ns; ++k) mx = fmaxf(mx, lg[tid * 256 + k]); float s = 0.f;
        for (int k = 0; k < ns; ++k) { float e = exp2f(lg[tid * 256 + k] - mx); lg[tid * 256 + k] = e; s += e; } float inv = 1.f / s; for (int k = 0; k < ns; ++k) lg[tid * 256 + k] *= inv; }
    __syncthreads();
    for (int o = tid; o < 2048; o += 256) { int h = o >> 7, r = o & 127; float a = 0.f;
        for (int k = 0; k < ns; ++k) a += lg[h * 256 + k] * bf2f(ckv[((size_t)b * L + idx[k]) * 128 + r]);
        olat[(size_t)row * 2048 + o] = f2bf(a); }
}
__global__ void k_uv_gate(const bf16_t* olat, const bf16_t* wuv, const bf16_t* proj, bf16_t* og) {
    __shared__ float ol[2048]; int row = blockIdx.x, tid = threadIdx.x;
    for (int i = tid; i < 2048; i += 256) ol[i] = bf2f(olat[(size_t)row * 2048 + i]);
    __syncthreads();
    for (int n = tid; n < 1024; n += 256) { int h = n / 64; const bf16_t* w = wuv + (size_t)n * 512 + ((n % 256) / 64) * 128; float a = 0.f;
        for (int r = 0; r < 128; ++r) a += ol[h * 128 + r] * bf2f(w[r]);
        float gte = bf2f(proj[(size_t)row * A_INP + 456 + n]);
        og[(size_t)row * 1024 + n] = f2bf(a * siluf(gte)); }
}
__global__ void k_post(const float* xin, const bf16_t* y, const float* postg, const float* mod_cur, const float* preg_next, const float* mod_next, float* xout, bf16_t* h) {
    __shared__ float red[4]; int row = blockIdx.x, b = row / L, t = threadIdx.x;
    float yv[4]; for (int j = 0; j < 4; ++j) yv[j] = bf2f(y[(size_t)row * D + 4 * t + j]);
    float ss = block_sum(yv[0] * yv[0] + yv[1] * yv[1] + yv[2] * yv[2] + yv[3] * yv[3], red);
    float rs = rsqrtf(ss / D + EPS); const float* rg = mod_cur + (size_t)b * 3072 + 2048;
    float4 xv = ((const float4*)(xin + (size_t)row * D))[t]; float x1[4] = {xv.x, xv.y, xv.z, xv.w};
    for (int j = 0; j < 4; ++j) { int cidx = 4 * t + j; x1[j] += rg[cidx] * (yv[j] * rs * postg[cidx]); }
    ((float4*)(xout + (size_t)row * D))[t] = make_float4(x1[0], x1[1], x1[2], x1[3]);
    if (h) { float s2 = block_sum(x1[0] * x1[0] + x1[1] * x1[1] + x1[2] * x1[2] + x1[3] * x1[3], red); float r2 = rsqrtf(s2 / D + EPS);
        const float* sh = mod_next + (size_t)b * 3072; const float* sc = sh + 1024;
        for (int j = 0; j < 4; ++j) { int cidx = 4 * t + j; h[(size_t)row * D + cidx] = f2bf(x1[j] * r2 * preg_next[cidx] * (1.f + sc[cidx]) + sh[cidx]); } }
}
__global__ void __launch_bounds__(256) k_diffattn(const bf16_t* proj, const Misc* ms, const float* subln, bf16_t* og) {
    __shared__ float q[2][64]; __shared__ float p[2][2048]; __shared__ float red[4]; __shared__ float part[2][128];
    int row = blockIdx.x, h = blockIdx.y, b = row / L, t = row % L, tid = threadIdx.x;
    if (tid < 128) q[tid >> 6][tid & 63] = bf2f(proj[(size_t)row * B_IN + (2 * h + (tid >> 6)) * 64 + (tid & 63)]);
    __syncthreads();
    float mx[2] = {-INFINITY, -INFINITY};
    for (int l = tid; l <= t; l += 256) { int dd = t - l; if (dd > 127) dd = 127;
        for (int j = 0; j < 2; ++j) { const bf16_t* kr = proj + ((size_t)b * L + l) * B_IN + 1024 + (2 * h + j) * 64; float a = 0.f;
            for (int d = 0; d < 64; ++d) a += q[j][d] * bf2f(kr[d]);
            a += ms->btab[dd * 16 + 2 * h + j] * LOG2E; p[j][l] = a; mx[j] = fmaxf(mx[j], a); } }
    float sm[2];
    for (int j = 0; j < 2; ++j) { float m = mx[j]; for (int o = 32; o > 0; o >>= 1) m = fmaxf(m, __shfl_xor(m, o));
        __syncthreads(); if ((tid & 63) == 0) red[tid >> 6] = m; __syncthreads(); m = fmaxf(fmaxf(red[0], red[1]), fmaxf(red[2], red[3]));
        float s = 0.f; for (int l = tid; l <= t; l += 256) { float e = exp2f(p[j][l] - m); p[j][l] = e; s += e; }
        sm[j] = block_sum(s, red); }
    __syncthreads();
    float lam = ms->lam, i0 = 1.f / sm[0], i1 = lam / sm[1];
    int e = tid & 127, half = tid >> 7; float a = 0.f;
    for (int l = half; l <= t; l += 2) a += (p[0][l] * i0 - p[1][l] * i1) * bf2f(proj[((size_t)b * L + l) * B_IN + 2048 + h * 128 + e]);
    part[half][e] = a; __syncthreads();
    float o = part[0][e] + part[1][e];
    float ss = block_sum(half == 0 ? o * o : 0.f, red);
    if (half == 0) { float v = o * rsqrtf(ss / 128.f + EPS) * subln[e] * (1.f - LAMBDA_INIT);
        float gte = bf2f(proj[(size_t)row * B_IN + 3072 + h * 128 + e]);
        og[(size_t)row * D + h * 128 + e] = f2bf(v * siluf(gte)); }
}

extern "C" void kernel_launch(void* const* d_in, const int* in_sizes, int n_in, void* d_out, int out_size, void* d_ws, size_t ws_size, hipStream_t stream) {
    (void)in_sizes; (void)n_in; (void)out_size; (void)ws_size;
    const float* const* in = (const float* const*)d_in; char* ws = (char*)d_ws; float* out = (float*)d_out;
    bf16_t *win0 = (bf16_t*)(ws + WS_WIN0), *wq2 = (bf16_t*)(ws + WS_WQ2), *wuv = (bf16_t*)(ws + WS_WUV), *wout0 = (bf16_t*)(ws + WS_WOUT0), *win1 = (bf16_t*)(ws + WS_WIN1), *wout1 = (bf16_t*)(ws + WS_WOUT1);
    float* mod = (float*)(ws + WS_MOD); Misc* ms = (Misc*)(ws + WS_MISC);
    bf16_t *ckv = (bf16_t*)(ws + WS_CKV), *ki = (bf16_t*)(ws + WS_KI); float *wi = (float*)(ws + WS_WI), *rsq = (float*)(ws + WS_RSQ); unsigned* sel = (unsigned*)(ws + WS_SEL);
    bf16_t *H = (bf16_t*)(ws + WS_H), *proj0 = (bf16_t*)(ws + WS_PROJ0), *qq = (bf16_t*)(ws + WS_QQ), *olat = (bf16_t*)(ws + WS_OLAT), *og0 = (bf16_t*)(ws + WS_OG0), *y0 = (bf16_t*)(ws + WS_Y0);
    bf16_t *proj1 = (bf16_t*)(ws + WS_PROJ1), *og1 = (bf16_t*)(ws + WS_OG1), *y1 = (bf16_t*)(ws + WS_Y1);
    auto nb = [](size_t n) { return dim3((unsigned)((n + 255) / 256)); };
    k_prep_w<<<nb((size_t)A_INP * D), 256, 0, stream>>>(in[I_AWIN], D, A_IN, A_INP, nullptr, 1.f, win0, D);
    k_prep_w<<<nb((size_t)512 * QR), 256, 0, stream>>>(in[I_AWQIDX], QR, 512, 512, in[I_AQN], 1.f, wq2, QR);
    k_prep_wqabs<<<nb(2048 * 256), 256, 0, stream>>>(in[I_AWUQ], in[I_AWUK], in[I_AQN], wq2);
    k_prep_wuv<<<nb(1024 * 512), 256, 0, stream>>>(in[I_AWUV], wuv);
    k_prep_w<<<nb((size_t)D * D), 256, 0, stream>>>(in[I_AWOUT], D, D, D, nullptr, 1.f, wout0, D);
    k_prep_w<<<nb((size_t)B_IN * D), 256, 0, stream>>>(in[I_BWIN], D, B_IN, B_IN, nullptr, 1.f, win1, D);
    k_prep_w<<<nb((size_t)D * D), 256, 0, stream>>>(in[I_BWOUT], D, D, D, nullptr, 1.f, wout1, D);
    k_mod<<<nb(2 * 3072), 256, 0, stream>>>(in[I_C], in[I_MODW], in[I_MODB], mod);
    k_misc<<<1, 128, 0, stream>>>(in[I_RELB], in[I_BLQ1], in[I_BLK1], in[I_BLQ2], in[I_BLK2], ms);
    k_prenorm<<<M, 256, 0, stream>>>(in[I_X], in[I_PREG], mod, H);
    k_gemm<EPI_PLAIN><<<dim3(A_INP / 64, M / 64), 256, 0, stream>>>(H, D, win0, D, proj0, A_INP, D, nullptr);
    k_rowstats0<<<M, 256, 0, stream>>>(proj0, in[I_AKVN], in[I_AKIN], rsq, ckv, ki, wi);
    k_gemm<EPI_ROWSCALE><<<dim3(NQQ / 64, M / 64), 256, 0, stream>>>(proj0, A_INP, wq2, QR, qq, NQQ, QR, rsq);
    k_topk<<<M, 256, 0, stream>>>(qq, ki, wi, sel);
    k_sparse<<<M, 256, 0, stream>>>(qq, ckv, sel, ms, olat);
    k_uv_gate<<<M, 256, 0, stream>>>(olat, wuv, proj0, og0);
    k_gemm<EPI_PLAIN><<<dim3(D / 64, M / 64), 256, 0, stream>>>(og0, D, wout0, D, y0, D, D, nullptr);
    k_post<<<M, 256, 0, stream>>>(in[I_X], y0, in[I_POSTG], mod, in[I_PREG] + D, mod + (size_t)NB * 3072, out, H);
    k_gemm<EPI_QSCALE><<<dim3(B_IN / 64, M / 64), 256, 0, stream>>>(H, D, win1, D, proj1, B_IN, D, nullptr);
    k_diffattn<<<dim3(M, BH), 256, 0, stream>>>(proj1, ms, in[I_BSUBLN], og1);
    k_gemm<EPI_PLAIN><<<dim3(D / 64, M / 64), 256, 0, stream>>>(og1, D, wout1, D, y1, D, D, nullptr);
    k_post<<<M, 256, 0, stream>>>(out, y1, in[I_POSTG] + D, mod + (size_t)NB * 3072, nullptr, nullptr, out, nullptr);
}
```

```cpp
#include <hip/hip_runtime.h>
#include <stdint.h>
#include <math.h>
#include <cstdio>
#include <hip/hip_bf16.h>

constexpr int NB = 8, L = 2048, D = 1024, M = NB * L;
constexpr int A_IN = 1480, A_INP = 1536, QR = 256, TOPK = 256;
constexpr int NQQ = 512 + 2048;
constexpr int B_IN = 4096, BH = 8;
constexpr float EPS = 1e-6f;
constexpr float LOG2E = 1.4426950408889634f;
constexpr float C2 = 0.125f * LOG2E;
constexpr float LAMBDA_INIT = 0.35550906759096934f;

constexpr size_t MiB = 1u << 20;
constexpr size_t WS_CTL = 0, CTL_ZERO_BYTES = 256 * 1024;
constexpr size_t WS_MOD = 512 * 1024;
constexpr size_t WS_MISC = 768 * 1024;
constexpr size_t WS_WIN0 = 1 * MiB;
constexpr size_t WS_WQ2 = 4 * MiB;
constexpr size_t WS_WUV = 6 * MiB;
constexpr size_t WS_WOUT0 = 7 * MiB;
constexpr size_t WS_WIN1 = 9 * MiB;
constexpr size_t WS_WOUT1 = 17 * MiB;
constexpr size_t WS_STATS = 19 * MiB;
constexpr size_t WS_CKV = 20 * MiB;
constexpr size_t WS_KI = 24 * MiB;
constexpr size_t WS_WI = 26 * MiB;
constexpr size_t WS_SEL = 28 * MiB;
constexpr size_t WS_H = 32 * MiB;
constexpr size_t WS_PROJ0 = 64 * MiB;
constexpr size_t WS_QQ = 112 * MiB;
constexpr size_t WS_OLAT = 192 * MiB;
constexpr size_t WS_OG0 = 112 * MiB;
constexpr size_t WS_Y0 = 144 * MiB;
constexpr size_t WS_PROJ1 = 64 * MiB;
constexpr size_t WS_OSCR = 192 * MiB;
constexpr size_t WS_OG1 = 32 * MiB;
constexpr size_t WS_Y1 = 64 * MiB;
constexpr int CW_BAR = 4096;

struct Misc { float lam; int pad[31]; int lut[128]; float btab[128 * 16]; };

enum { I_X = 0, I_C, I_RELB, I_MODW, I_MODB, I_PREG, I_POSTG, I_AWIN, I_AQN, I_AKVN, I_AKIN, I_AWUQ, I_AWQIDX, I_AWUK, I_AWUV, I_AWOUT,
       I_BWIN, I_BLQ1, I_BLK1, I_BLQ2, I_BLK2, I_BSUBLN, I_BWOUT, N_IN };

__device__ __forceinline__ float siluf(float v) { return v * __builtin_amdgcn_rcpf(1.f + __builtin_amdgcn_exp2f(-1.4426950408889634f * v)); }
__device__ __forceinline__ float bf2f(unsigned short v) { return __uint_as_float((unsigned)v << 16); }
__device__ __forceinline__ float xsum32(float v) { auto r = __builtin_amdgcn_permlane32_swap(__float_as_uint(v), __float_as_uint(v), false, false); return __uint_as_float(r[0]) + __uint_as_float(r[1]); }
__device__ __forceinline__ float xsum16(float v) { auto r = __builtin_amdgcn_permlane16_swap(__float_as_uint(v), __float_as_uint(v), false, false); return __uint_as_float(r[0]) + __uint_as_float(r[1]); }
template <int CTRL> __device__ __forceinline__ float dpp_f(float v) { return __uint_as_float((unsigned)__builtin_amdgcn_update_dpp(0, (int)__float_as_uint(v), CTRL, 0xF, 0xF, true)); }
__device__ __forceinline__ float wave_sum_all(float v) {
    v += dpp_f<0xB1>(v);
    v += dpp_f<0x4E>(v);
    v += dpp_f<0x141>(v);
    v += dpp_f<0x140>(v);
    v = xsum16(v); return xsum32(v);
}
typedef unsigned short bf16_t;
#define GAS __attribute__((address_space(1)))
#define LAS __attribute__((address_space(3)))
typedef unsigned short bf16;
typedef unsigned v4u __attribute__((ext_vector_type(4)));
typedef float f32x4 __attribute__((ext_vector_type(4)));
typedef short bf16x8 __attribute__((ext_vector_type(8)));
typedef GAS unsigned gu32;
typedef GAS unsigned long long gu64;
#define RLX_AGENT __ATOMIC_RELAXED, __HIP_MEMORY_SCOPE_AGENT
#define LDS_WAIT() asm volatile("s_waitcnt lgkmcnt(0)" ::: "memory")
#define VM_WAIT() asm volatile("s_waitcnt vmcnt(0)" ::: "memory")
__device__ __forceinline__ unsigned long long rt() { return __builtin_amdgcn_s_memrealtime(); }
__device__ __forceinline__ unsigned f2bf(float f) { unsigned u = __builtin_bit_cast(unsigned, f); return (u + 0x7fffu + ((u >> 16) & 1u)) >> 16; }
__device__ __forceinline__ unsigned pk2(float lo, float hi) { return f2bf(lo) | (f2bf(hi) << 16); }

#define XB_TMO      128
#define XB_XCNT(j)  (256  + 64 * (j))
#define XB_XSUB(j)  (1280 + 64 * (j))
#define XB_XGEN(j)  (2304 + 64 * (j))
#define XB_TOP      3328
#define XB_TOPGEN   3392
#define XCD_BAR_WORDS 3456
#define XB_SPIN_CAP (1u << 18)

__device__ __forceinline__ unsigned xb_ld(unsigned* p)              { return __hip_atomic_load(p, __ATOMIC_RELAXED, __HIP_MEMORY_SCOPE_AGENT); }
__device__ __forceinline__ unsigned xb_add(unsigned* p, unsigned v) { return __hip_atomic_fetch_add(p, v, __ATOMIC_RELAXED, __HIP_MEMORY_SCOPE_AGENT); }
__device__ __forceinline__ unsigned xb_xcc_id() { return (unsigned)__builtin_amdgcn_s_getreg((3 << 11) | 20) & 0xFu; }
#define XB_SPIN(cond, bar) do { unsigned _sp = 0; while (cond) { __builtin_amdgcn_s_sleep(1); \
    if ((++_sp & 255u) == 0u) { if (xb_ld(&(bar)[XB_TMO])) break; if (_sp > XB_SPIN_CAP) { atomicAdd(&(bar)[XB_TMO], 1u); break; } } } } while (0)

__device__ __forceinline__ int lane_now(int dep) { int l; asm volatile("v_mbcnt_lo_u32_b32 %0, -1, 0\n\tv_mbcnt_hi_u32_b32 %0, -1, %0 ; dep %1" : "=v"(l) : "s"(dep)); return l; }
struct XcdBarrier {
    unsigned* bar; unsigned x; int wave;
    volatile LAS unsigned* st;
};

__device__ __forceinline__ XcdBarrier xcd_barrier_post(unsigned* bar, volatile LAS unsigned* st, int wave) {
    XcdBarrier b; b.bar = bar; b.x = xb_xcc_id(); b.st = st; b.wave = wave;
    if (wave == 0 && lane_now(0) == 0) (void)xb_add(&bar[XB_XCNT(b.x)], 1u);
    return b;
}
__device__ __forceinline__ void xcd_barrier_complete(unsigned* bar, unsigned x, unsigned& nloc, unsigned& nx) {
    const unsigned G = gridDim.x * gridDim.y * gridDim.z;
    unsigned sum, cnt, mine, sp = 0u;
    for (;;) {
        sum = 0u; cnt = 0u; mine = 0u;
#pragma unroll
        for (unsigned j = 0; j < 16; ++j) { const unsigned c = xb_ld(&bar[XB_XCNT(j)]); sum += c; cnt += (c > 0u) ? 1u : 0u; mine = (j == x) ? c : mine; }
        if (sum == G) break;
        __builtin_amdgcn_s_sleep(1);
        if ((++sp & 255u) == 0u) { if (xb_ld(&bar[XB_TMO])) break; if (sp > XB_SPIN_CAP) { atomicAdd(&bar[XB_TMO], 1u); break; } }
    }
    nloc = mine > 0u ? mine : 1u; nx = cnt > 0u ? cnt : 1u;
}

__device__ __forceinline__ void xcd_barrier(const XcdBarrier& b) {
    asm volatile("s_waitcnt vmcnt(0)" ::: "memory");
    __syncthreads();
    if (b.wave == 0 && lane_now(1) == 0) {
        unsigned* bar = b.bar;
        __builtin_amdgcn_s_waitcnt(0);
        unsigned nloc = b.st[0], nx = b.st[1];
        if (nloc == 0u) { xcd_barrier_complete(bar, b.x, nloc, nx); b.st[0] = nloc; b.st[1] = nx; }
        const unsigned old = xb_add(&bar[XB_XSUB(b.x)], 1u);
        const unsigned gen = old / nloc;
        if (old + 1u == (gen + 1u) * nloc) {
            __builtin_amdgcn_fence(__ATOMIC_RELEASE, "agent");
            asm volatile("s_waitcnt vmcnt(0)" ::: "memory");
            const unsigned og = xb_add(&bar[XB_TOP], 1u);
            const unsigned tg = og / nx;
            if (og + 1u == (tg + 1u) * nx) xb_add(&bar[XB_TOPGEN], 1u);
            else XB_SPIN(xb_ld(&bar[XB_TOPGEN]) == tg, bar);
            __builtin_amdgcn_fence(__ATOMIC_ACQUIRE, "agent");
            xb_add(&bar[XB_XGEN(b.x)], 1u);
            asm volatile("s_waitcnt vmcnt(0)" ::: "memory");
        } else {
            XB_SPIN(xb_ld(&bar[XB_XGEN(b.x)]) == gen, bar);
            __builtin_amdgcn_fence(__ATOMIC_ACQUIRE, "agent");
            asm volatile("s_waitcnt vmcnt(0)" ::: "memory");
        }
    }
    __syncthreads();
}
namespace pg8 {
#define PG8_LAS __attribute__((address_space(3)))
typedef unsigned short bf16_t;
typedef short bf16x8 __attribute__((ext_vector_type(8)));
typedef float f32x4 __attribute__((ext_vector_type(4)));
typedef unsigned u32x4 __attribute__((ext_vector_type(4)));
constexpr int BM = 256, BK = 64, HALF = 128, HTB = HALF * BK * 2  , STAGE_BYTES = 8 * HTB, NXCD = 8, WGM = 8;

__host__ __device__ __forceinline__ int lds_byte(int r, int c) { const int st = (r >> 4) * 2 + (c >> 5), rr = r & 15, cc = c & 31, ob = rr * 64 + cc * 2; return st * 1024 + (ob ^ (((ob >> 9) & 1) << 5)); }
__host__ __device__ __forceinline__ void stage_rc(int b, int& R, int& C) { const int st = b / 1024, sb = b % 1024, swz = sb ^ (((sb >> 9) & 1) << 5); R = (st >> 1) * 16 + swz / 64; C = (st & 1) * 32 + (swz % 64) / 2; }
__host__ __device__ __forceinline__ int perm32(int rho) { const int n = rho >> 4, i = rho & 15; return 8 * (i >> 2) + 4 * n + (i & 3); }

struct Unit { int pm, pn; };
struct Gemm { const bf16_t* A; const bf16_t* Bt; int M, N, K, lda, ldb, a_koff_pn; };

struct StaticOrder {
    int nM, nN, nwg, G, c;
    __host__ __device__ void init(int M, int N, int G_, int c_) { nM = M / BM; nN = N / BM; nwg = nM * nN; G = G_; c = c_; }
    __host__ __device__ bool next(int i, Unit& u) const {
        const long L = (long)i * G + c; if (L >= nwg) return false;
        int wgid = (int)L; { const int q = nwg / NXCD, r = nwg % NXCD, xcd = wgid % NXCD, off = wgid / NXCD; wgid = (xcd < r ? xcd * (q + 1) : r * (q + 1) + (xcd - r) * q) + off; }
        const int nig = WGM * nN, gid = wgid / nig, fm = gid * WGM, gsz = (nM - fm) < WGM ? (nM - fm) : WGM;
        u.pm = fm + ((wgid % nig) % gsz); u.pn = (wgid % nig) / gsz; return true;
    }
    __device__ __forceinline__ void a_ready(const Unit&) const {}
    __device__ __forceinline__ void done(const Unit&) const {}
};
__device__ __forceinline__ unsigned cvt_pk_bf16(float lo, float hi) { unsigned r; asm volatile("v_cvt_pk_bf16_f32 %0, %1, %2" : "=v"(r) : "v"(lo), "v"(hi)); return r; }
typedef float f32x2 __attribute__((ext_vector_type(2)));
enum { EM_PLAIN = 0, EM_PROJ0 = 1, EM_ROWSCALE = 2, EM_UVGATE = 3, EM_PROJ1 = 4 };
template <int MODE> struct Epi {
    static constexpr bool PERM = true, AFTER_DRAIN = false;
    bf16_t* O; int ldc; float* stats; const bf16_t* gate; int ldg;
    __device__ __forceinline__ void operator()(const f32x4 (&acc)[2][2][4][2], const Unit& u, int wr, int wc, int fr, int fq) const {
        const int row0 = u.pm * BM + wr * 64 + fr, col0 = u.pn * BM + wc * 32 + 8 * fq;
#pragma unroll
        for (int ai = 0; ai < 2; ++ai)
#pragma unroll
            for (int m = 0; m < 4; ++m) {
                const int row = row0 + ai * HALF + m * 16;
                float rs = 1.f;
                if (MODE == EM_ROWSCALE) { const f32x4 s = *(const f32x4*)(stats + (size_t)row * 16); rs = rsqrtf(((s[0] + s[1]) + (s[2] + s[3])) * (1.f / 256.f) + 1e-6f); }
                if (MODE == EM_PROJ1) rs = (u.pn < 4) ? (0.125f * 1.4426950408889634f) : 1.f;
                float ss[2] = {0.f, 0.f};
#pragma unroll
                for (int bj = 0; bj < 2; ++bj) {
                    f32x4 v0 = acc[ai][bj][m][0] * rs, v1 = acc[ai][bj][m][1] * rs;
                    if (MODE == EM_PROJ0) ss[bj] = ((v0[0] * v0[0] + v0[1] * v0[1]) + (v0[2] * v0[2] + v0[3] * v0[3])) + ((v1[0] * v1[0] + v1[1] * v1[1]) + (v1[2] * v1[2] + v1[3] * v1[3]));
                    if (MODE == EM_UVGATE) { const u32x4 gw = *(const u32x4*)(gate + (size_t)row * ldg + col0 + bj * HALF);
#pragma unroll
                        for (int q = 0; q < 4; ++q) { const float g0 = __uint_as_float(gw[q] << 16), g1 = __uint_as_float(gw[q] & 0xffff0000u);
                            const float s0 = g0 * __builtin_amdgcn_rcpf(1.f + __builtin_amdgcn_exp2f(-1.4426950408889634f * g0)), s1 = g1 * __builtin_amdgcn_rcpf(1.f + __builtin_amdgcn_exp2f(-1.4426950408889634f * g1));
                            if (q < 2) { v0[2 * q] *= s0; v0[2 * q + 1] *= s1; } else { v1[2 * q - 4] *= s0; v1[2 * q - 3] *= s1; } } }
                    u32x4 w; w.x = cvt_pk_bf16(v0[0], v0[1]); w.y = cvt_pk_bf16(v0[2], v0[3]); w.z = cvt_pk_bf16(v1[0], v1[1]); w.w = cvt_pk_bf16(v1[2], v1[3]);
                    *(u32x4*)(O + (size_t)row * ldc + col0 + bj * HALF) = w; }
                if (MODE == EM_PROJ0) { if (u.pn < 2) {
                    float a = ss[0], b = ss[1];
                    a = xsum32(xsum16(a)); b = xsum32(xsum16(b));
                    if (fq == 0) { if (u.pn == 0) stats[(size_t)row * 16 + wc] = a + b; else { stats[(size_t)row * 16 + 4 + wc] = a; if (wc < 2) stats[(size_t)row * 16 + 8 + wc] = b; } } } }
            }
    }
};

template <class Epi, class Sched, bool ALIGN_EPI = false, bool SP2 = false>
__device__ __forceinline__ void gemm_phase(PG8_LAS unsigned char* lds, const Gemm g, const Sched& S, const Epi& E, const int wid) {
    const int lane = lane_now(g.N), tid = wid * 64 + lane, wr = wid >> 2, wc = wid & 3, fr = lane & 15, fq = lane >> 4;
    const int K = g.K, nt = K / BK;
    unsigned voffA[2], voffB[2];
#pragma unroll
    for (int i = 0; i < 2; ++i) { int R, C; stage_rc(tid * 16 + i * 8192, R, C); const int Rb = Epi::PERM ? ((R & ~31) + perm32(R & 31)) : R;
        voffA[i] = (unsigned)(R * g.lda + C) * 2u; voffB[i] = (unsigned)(Rb * g.ldb + C) * 2u; }
    const size_t kstep = (size_t)(BK * 2);
    const size_t hstepA = (size_t)HALF * g.lda * 2, hstepB = (size_t)HALF * g.ldb * 2;
    const size_t tstepA = 2 * hstepA, tstepB = 2 * hstepB, aoffpn = (size_t)g.a_koff_pn * 2;
    const unsigned ldsw = (unsigned)wid * 1024u;
    const int aoff = lds_byte(wr * 64 + fr, fq * 8), boff = lds_byte(wc * 32 + fr, fq * 8);
#define PG8_SA(b, h) (((b) * 2 + (h)) * HTB)
#define PG8_SB(b, h) ((4 + (b) * 2 + (h)) * HTB)
#define PG8_STAGE(bufoff, gbase, voff) do { _Pragma("unroll") for (int _i = 0; _i < 2; ++_i) \
        __builtin_amdgcn_global_load_lds((const unsigned*)((const char*)(gbase) + (voff)[_i]), (PG8_LAS unsigned*)(lds + (bufoff) + ldsw + _i * 8192), 16, 0, 0); } while (0)
#define PG8_LDA(dst, b, h) do { _Pragma("unroll") for (int m = 0; m < 4; ++m) _Pragma("unroll") for (int k = 0; k < 2; ++k) dst[m][k] = *(const PG8_LAS bf16x8*)(lds + PG8_SA(b, h) + aoff + m * 2048 + k * 1024); } while (0)
#define PG8_LDB(dst, b, h) do { _Pragma("unroll") for (int n = 0; n < 2; ++n) _Pragma("unroll") for (int k = 0; k < 2; ++k) dst[n][k] = *(const PG8_LAS bf16x8*)(lds + PG8_SB(b, h) + boff + n * 2048 + k * 1024); } while (0)
#define PG8_MMA(ai, bj, At, Bt) do { __builtin_amdgcn_s_setprio(1); _Pragma("unroll") for (int m = 0; m < 4; ++m) _Pragma("unroll") for (int n = 0; n < 2; ++n) _Pragma("unroll") for (int k = 0; k < 2; ++k) \
        acc[ai][bj][m][n] = __builtin_amdgcn_mfma_f32_16x16x32_bf16(Bt[n][k], At[m][k], acc[ai][bj][m][n], 0, 0, 0); __builtin_amdgcn_s_setprio(0); } while (0)
#define PG8_WAIT_V(n) asm volatile("s_waitcnt vmcnt(" #n ")" ::: "memory")
#define PG8_WAIT_L(n) asm volatile("s_waitcnt lgkmcnt(" #n ")" ::: "memory")
#define PG8_BAR __builtin_amdgcn_s_barrier()
#define PG8_SCHED __builtin_amdgcn_sched_barrier(0)
    Unit cur, nxt; int ui = 0;
    if (!S.next(0, cur)) return;
    f32x4 acc[2][2][4][2];
#pragma unroll
    for (int a = 0; a < 2; ++a)
#pragma unroll
        for (int b = 0; b < 2; ++b)
#pragma unroll
            for (int m = 0; m < 4; ++m)
#pragma unroll
                for (int n = 0; n < 2; ++n) acc[a][b][m][n] = (f32x4){0.f, 0.f, 0.f, 0.f};
    bf16x8 At[4][2], B0[2][2], B1[2][2];
    const char* cA = (const char*)g.A + (size_t)cur.pm * tstepA + (size_t)cur.pn * aoffpn; const char* cB = (const char*)g.Bt + (size_t)cur.pn * tstepB;
    S.a_ready(cur);
    if constexpr (SP2) {
        PG8_STAGE(PG8_SB(0, 0), cB, voffB); PG8_STAGE(PG8_SB(0, 1), cB + hstepB, voffB); PG8_STAGE(PG8_SA(0, 0), cA, voffA); PG8_STAGE(PG8_SA(0, 1), cA + hstepA, voffA);
        if (wr == 1) PG8_BAR;
        PG8_WAIT_V(2); PG8_BAR;
        PG8_STAGE(PG8_SB(1, 0), cB + kstep, voffB); PG8_STAGE(PG8_SA(1, 0), cA + kstep, voffA); PG8_STAGE(PG8_SB(1, 1), cB + hstepB + kstep, voffB);
        PG8_WAIT_V(6); PG8_BAR;
    } else {
        PG8_STAGE(PG8_SB(0, 0), cB, voffB); PG8_STAGE(PG8_SA(0, 0), cA, voffA); PG8_STAGE(PG8_SB(0, 1), cB + hstepB, voffB); PG8_STAGE(PG8_SA(0, 1), cA + hstepA, voffA);
        if (wr == 1) PG8_BAR;
        PG8_WAIT_V(4); PG8_BAR;
        PG8_STAGE(PG8_SB(1, 0), cB + kstep, voffB); PG8_STAGE(PG8_SA(1, 0), cA + kstep, voffA); PG8_STAGE(PG8_SB(1, 1), cB + hstepB + kstep, voffB);
        PG8_WAIT_V(6); PG8_BAR;
    }
    for (;;) {
        const bool has_next = S.next(ui + 1, nxt);
        const char* nA = has_next ? (const char*)g.A + (size_t)nxt.pm * tstepA + (size_t)nxt.pn * aoffpn : cA; const char* nB = has_next ? (const char*)g.Bt + (size_t)nxt.pn * tstepB : cB;
        for (int t = 0; t < nt; t += 2) {
            const bool last = (t == nt - 2);
            const char* a1 = cA + (size_t)(t + 1) * kstep;
            const char* a2 = last ? nA : cA + (size_t)(t + 2) * kstep; const char* b2 = last ? nB : cB + (size_t)(t + 2) * kstep;
            const char* a3 = a2 + kstep; const char* b3 = b2 + kstep;
            if (last && has_next) S.a_ready(nxt);
            if constexpr (SP2) {
            PG8_LDB(B0, 0, 0); PG8_LDB(B1, 0, 1); PG8_SCHED; PG8_LDA(At, 0, 0); PG8_STAGE(PG8_SA(1, 1), a1 + hstepA, voffA);
            PG8_WAIT_V(8); PG8_WAIT_L(0); PG8_BAR; PG8_MMA(0, 0, At, B0); PG8_MMA(0, 1, At, B1); PG8_BAR; PG8_SCHED;
            PG8_LDA(At, 0, 1); PG8_STAGE(PG8_SB(0, 0), b2, voffB); PG8_STAGE(PG8_SB(0, 1), b2 + hstepB, voffB); PG8_STAGE(PG8_SA(0, 0), a2, voffA);
            PG8_WAIT_V(8); PG8_WAIT_L(0); PG8_BAR; PG8_MMA(1, 0, At, B0); PG8_MMA(1, 1, At, B1); PG8_BAR; PG8_SCHED;
            PG8_LDB(B0, 1, 0); PG8_LDB(B1, 1, 1); PG8_SCHED; PG8_LDA(At, 1, 0); PG8_STAGE(PG8_SA(0, 1), a2 + hstepA, voffA);
            PG8_WAIT_V(8); PG8_WAIT_L(0); PG8_BAR; PG8_MMA(0, 0, At, B0); PG8_MMA(0, 1, At, B1); PG8_BAR; PG8_SCHED;
            PG8_LDA(At, 1, 1); PG8_STAGE(PG8_SB(1, 0), b3, voffB); PG8_STAGE(PG8_SB(1, 1), b3 + hstepB, voffB); PG8_STAGE(PG8_SA(1, 0), a3, voffA);
            PG8_WAIT_V(8); PG8_WAIT_L(0); PG8_BAR; PG8_MMA(1, 0, At, B0); PG8_MMA(1, 1, At, B1); PG8_BAR; PG8_SCHED;
            } else {
            PG8_LDB(B0, 0, 0); PG8_SCHED; PG8_LDA(At, 0, 0); PG8_STAGE(PG8_SA(1, 1), a1 + hstepA, voffA);
            PG8_WAIT_L(8); PG8_BAR; PG8_WAIT_L(0); PG8_MMA(0, 0, At, B0); PG8_BAR; PG8_SCHED;
            PG8_LDB(B1, 0, 1); PG8_STAGE(PG8_SB(0, 0), b2, voffB);
            PG8_BAR; PG8_WAIT_L(0); PG8_MMA(0, 1, At, B1); PG8_BAR;
            PG8_LDA(At, 0, 1); PG8_STAGE(PG8_SA(0, 0), a2, voffA);
            PG8_BAR; PG8_WAIT_L(0); PG8_MMA(1, 0, At, B0); PG8_BAR; PG8_SCHED;
            PG8_STAGE(PG8_SB(0, 1), b2 + hstepB, voffB);
            PG8_WAIT_V(6); PG8_BAR; PG8_MMA(1, 1, At, B1); PG8_BAR;
            PG8_LDB(B0, 1, 0); PG8_SCHED; PG8_LDA(At, 1, 0); PG8_STAGE(PG8_SA(0, 1), a2 + hstepA, voffA);
            PG8_WAIT_L(8); PG8_BAR; PG8_WAIT_L(0); PG8_MMA(0, 0, At, B0); PG8_BAR; PG8_SCHED;
            PG8_LDB(B1, 1, 1); PG8_STAGE(PG8_SB(1, 0), b3, voffB);
            PG8_BAR; PG8_WAIT_L(0); PG8_MMA(0, 1, At, B1); PG8_BAR;
            PG8_LDA(At, 1, 1); PG8_STAGE(PG8_SA(1, 0), a3, voffA);
            PG8_BAR; PG8_WAIT_L(0); PG8_MMA(1, 0, At, B0); PG8_BAR; PG8_SCHED;
            PG8_STAGE(PG8_SB(1, 1), b3 + hstepB, voffB);
            PG8_WAIT_V(6); PG8_BAR; PG8_MMA(1, 1, At, B1); PG8_BAR;
            }
        }
        if constexpr (ALIGN_EPI) { if (wr == 0) PG8_BAR; }
        if constexpr (!Epi::AFTER_DRAIN) { E(acc, cur, wr, wc, fr, fq); S.done(cur); }
        if (!has_next) break;
#pragma unroll
        for (int a = 0; a < 2; ++a)
#pragma unroll
            for (int b = 0; b < 2; ++b)
#pragma unroll
                for (int m = 0; m < 4; ++m)
#pragma unroll
                    for (int n = 0; n < 2; ++n) acc[a][b][m][n] = (f32x4){0.f, 0.f, 0.f, 0.f};
        cur = nxt; cA = nA; cB = nB; ++ui;
        if constexpr (ALIGN_EPI) { if (wr == 1) PG8_BAR; }
    }
    PG8_WAIT_V(0);
    if constexpr (!ALIGN_EPI) { if (wr == 0) PG8_BAR; }
    PG8_BAR;
    if constexpr (Epi::AFTER_DRAIN) { E.fused(acc, cur, wr, wc, fr, fq, lds, wid, lane); S.done(cur); }
#undef PG8_SA
#undef PG8_SB
#undef PG8_STAGE
#undef PG8_LDA
#undef PG8_LDB
#undef PG8_MMA
#undef PG8_WAIT_V
#undef PG8_WAIT_L
#undef PG8_BAR
#undef PG8_SCHED
}
}
namespace attn_body {
using bf16=__hip_bfloat16;
using bf16x8=__attribute__((ext_vector_type(8)))short;
using s16x4=__attribute__((ext_vector_type(4)))short;
using f32x16=__attribute__((ext_vector_type(16)))float;
using u32x4=__attribute__((ext_vector_type(4)))unsigned;
constexpr int SEQ=2048,D=64,DM=4096,OPITCH=256;
constexpr int NW=8,QBLK=32,QB=QBLK*NW,KVBLK=64,NQB=SEQ/QB;
constexpr int ATTN_UNIT_ROWS=QB;
__device__ __forceinline__ int crow(int r,int hi){return (r&3)+8*(r>>2)+4*hi;}
#define SBAR() __builtin_amdgcn_sched_barrier(0)
__device__ __forceinline__ void cmask(f32x16&p0,f32x16&p1,int jb,int qrel,int hi){
  const float NEG=-INFINITY; int kb=64*jb+4*hi;
  #pragma unroll
  for(int r=0;r<16;++r){int kv=kb+(r&3)+8*(r>>2); if(kv>qrel)p0[r]=NEG; if(kv+32>qrel)p1[r]=NEG;}
}

constexpr int NSLOT=3, SLOTB=8192;
constexpr int LDS_K=0, LDS_V=NSLOT*SLOTB, LDS_WS=2*NSLOT*SLOTB, LDS_OST=LDS_WS+NW*64*4, LDS_BT=LDS_OST+NW*4096, BT_N=704, LDS_BYTES=LDS_BT+BT_N*4;
constexpr float C2=0.125f*1.4426950408889634f;
__device__ __forceinline__ void glds16(const void*gsrc,unsigned lds_dst){unsigned keep;
  asm volatile("s_mov_b32 %0, m0\n\ts_mov_b32 m0, %2\n\ts_nop 0\n\tglobal_load_lds_dwordx4 %1, off\n\ts_mov_b32 m0, %0":"=&s"(keep):"v"(gsrc),"s"(lds_dst):"memory");}
__device__ __forceinline__ float max3f(float a,float b,float c){float r;asm("v_max3_f32 %0, %1, %2, %3":"=v"(r):"v"(a),"v"(b),"v"(c));return r;}
__device__ __forceinline__ float max2f(float a,float b){float r;asm("v_max_f32_e32 %0, %1, %2":"=v"(r):"v"(a),"v"(b));return r;}
__device__ __forceinline__ float fadd_s(float a,float b){float r;asm("v_add_f32_e32 %0, %1, %2":"=v"(r):"v"(a),"v"(b));return r;}
__device__ __forceinline__ float fsub_s(float a,float b){float r;asm("v_sub_f32_e32 %0, %1, %2":"=v"(r):"v"(a),"v"(b));return r;}
typedef float f32x2_t __attribute__((ext_vector_type(2))); typedef __bf16 bf16x2_t __attribute__((ext_vector_type(2)));
__device__ __forceinline__ unsigned cvtpk_s(float lo,float hi){f32x2_t v={lo,hi};bf16x2_t b=__builtin_convertvector(v,bf16x2_t);return __builtin_bit_cast(unsigned,b);}
#define WAIT_BAR(N) asm volatile("s_waitcnt vmcnt(" #N ") lgkmcnt(0)\n\ts_barrier":::"memory")

__device__ __forceinline__ void qkt(f32x16&p0,f32x16&p1,const char*Kslot,const bf16x8*qr,int r32,int hi){
  const char*kb=Kslot+hi*1024+r32*16;
  #pragma unroll
  for(int d0=0;d0<4;++d0){
    const bf16x8 b0=*reinterpret_cast<const bf16x8*>(kb+d0*2048);
    const bf16x8 b1=*reinterpret_cast<const bf16x8*>(kb+d0*2048+512);
    if(d0==0){p0=__builtin_amdgcn_mfma_f32_32x32x16_bf16(b0,qr[0],f32x16{},0,0,0);p1=__builtin_amdgcn_mfma_f32_32x32x16_bf16(b1,qr[0],f32x16{},0,0,0);}
    else{p0=__builtin_amdgcn_mfma_f32_32x32x16_bf16(b0,qr[d0],p0,0,0,0);p1=__builtin_amdgcn_mfma_f32_32x32x16_bf16(b1,qr[d0],p1,0,0,0);}}
}
typedef __attribute__((address_space(3))) const char* lds_cptr;
typedef short v4i16_t __attribute__((ext_vector_type(4)));
__device__ __forceinline__ void kload8(bf16x8*kf,lds_cptr kp){
  kf[0]=*(const __attribute__((address_space(3))) bf16x8*)(kp);      kf[1]=*(const __attribute__((address_space(3))) bf16x8*)(kp+512);
  kf[2]=*(const __attribute__((address_space(3))) bf16x8*)(kp+2048); kf[3]=*(const __attribute__((address_space(3))) bf16x8*)(kp+2560);
  kf[4]=*(const __attribute__((address_space(3))) bf16x8*)(kp+4096); kf[5]=*(const __attribute__((address_space(3))) bf16x8*)(kp+4608);
  kf[6]=*(const __attribute__((address_space(3))) bf16x8*)(kp+6144); kf[7]=*(const __attribute__((address_space(3))) bf16x8*)(kp+6656);
}
__device__ __forceinline__ void kload2(bf16x8*kf,lds_cptr kp,int j){ kf[2*j]=*(const __attribute__((address_space(3))) bf16x8*)(kp+j*2048); kf[2*j+1]=*(const __attribute__((address_space(3))) bf16x8*)(kp+j*2048+512); }
__device__ __forceinline__ s16x4 vtr(lds_cptr p){ return __builtin_bit_cast(s16x4,__builtin_amdgcn_ds_read_tr16_b64_v4i16((__attribute__((address_space(3))) v4i16_t*)p)); }
__device__ __forceinline__ float rowmax(const f32x16&p0,const f32x16&p1){
  float a=max3f(p0[0],p0[1],p1[0]),b=max3f(p0[2],p0[3],p1[1]);a=max3f(a,p1[2],p1[3]);
  #pragma unroll
  for(int r=4;r<16;r+=4){a=max3f(a,p0[r],p0[r+1]);b=max3f(b,p0[r+2],p0[r+3]);a=max3f(a,p1[r],p1[r+1]);b=max3f(b,p1[r+2],p1[r+3]);}
  const float m=max2f(a,b);
  auto rr=__builtin_amdgcn_permlane32_swap(__float_as_uint(m),__float_as_uint(m),false,false);
  return max2f(__uint_as_float(rr[0]),__uint_as_float(rr[1]));
}
__device__ __forceinline__ void pv(f32x16*o,int vb,bf16x8 pa0,bf16x8 pa1,bf16x8 pa2,bf16x8 pa3){
  #pragma unroll
  for(int d0=0;d0<2;++d0){s16x4 lo[4],hi[4];
    #pragma unroll
    for(int ks=0;ks<4;++ks){
      asm volatile("ds_read_b64_tr_b16 %0,%1 offset:%c2":"=&v"(lo[ks]):"v"(vb),"i"(d0*4096+ks*1024):"memory");
      asm volatile("ds_read_b64_tr_b16 %0,%1 offset:%c2":"=&v"(hi[ks]):"v"(vb),"i"(d0*4096+ks*1024+512):"memory");}
    asm volatile("s_waitcnt lgkmcnt(0)":::"memory");SBAR();
    #define PK(k) (bf16x8){lo[k][0],lo[k][1],lo[k][2],lo[k][3],hi[k][0],hi[k][1],hi[k][2],hi[k][3]}
    o[d0]=__builtin_amdgcn_mfma_f32_32x32x16_bf16(pa0,PK(0),o[d0],0,0,0);
    o[d0]=__builtin_amdgcn_mfma_f32_32x32x16_bf16(pa1,PK(1),o[d0],0,0,0);
    o[d0]=__builtin_amdgcn_mfma_f32_32x32x16_bf16(pa2,PK(2),o[d0],0,0,0);
    o[d0]=__builtin_amdgcn_mfma_f32_32x32x16_bf16(pa3,PK(3),o[d0],0,0,0);
    #undef PK
  }
}

#ifndef ATTN_STORE16
#define ATTN_STORE16(p,v) (*(u32x4*)(p)=(v))
#endif
template<int THRL> __device__ __forceinline__ void attn_unit(const int wid,int b,int qb,const bf16*Qc,const bf16*__restrict__ Kc,const bf16*__restrict__ Vc,bf16*Oc,const float*btabm,char*shm){
  int lane; asm volatile("v_mbcnt_lo_u32_b32 %0, -1, 0\n\tv_mbcnt_hi_u32_b32 %0, -1, %0 ; dep %1":"=v"(lane):"s"(qb));
  const int tid=wid*64+lane,r32=lane&31,hi=lane>>5;
  const long rowbase=(long)b*SEQ; const int q0=qb*QB;
  const bf16*Qw=Qc+(rowbase+q0+wid*QBLK)*DM;
  const bf16*Kh=Kc+rowbase*DM,*Vh=Vc+rowbase*DM;
  const unsigned lds0=(unsigned)(uintptr_t)shm;
  float*wsf=(float*)(shm+LDS_WS)+wid*64;
  const float b31n=btabm[127*16]; const float b31l=b31n*1.4426950408889634f;
  { float*R=(float*)(shm+LDS_BT); for(int j=tid;j<BT_N;j+=NW*64){ int d=447-j; float v=0.f; if(d>=0&&d<127) v=(btabm[d*16]-b31n)*1.4426950408889634f; R[j]=v; } }
  const bf16*ksrc=Kh+(long)lane*DM+wid*8;
  const bf16*vsrc=Vh+(long)(16*(wid&3)+(lane>>2))*DM+(wid>>2)*32+(lane&3)*8;
  const unsigned kdst=lds0+LDS_K+wid*1024, vdst=lds0+LDS_V+wid*1024;
  #define DMA_K(t,slot) glds16(ksrc+(long)(t)*KVBLK*DM,(unsigned)__builtin_amdgcn_readfirstlane(kdst+(slot)))
  #define DMA_V(t,slot) glds16(vsrc+(long)(t)*KVBLK*DM,(unsigned)__builtin_amdgcn_readfirstlane(vdst+(slot)))
  const int vb0=(int)(lds0+LDS_V)+((lane>>4)&1)*32+(lane&3)*8+(4*hi+((lane&15)>>2))*64;
  const char*Kbase=shm+LDS_K; bf16x8 kf[8];
  const lds_cptr shm3=(lds_cptr)shm; const lds_cptr kp0=shm3+LDS_K+hi*1024+r32*16; const lds_cptr vp0=shm3+LDS_V+((lane>>4)&1)*32+(lane&3)*8+(4*hi+((lane&15)>>2))*64;
  const int NT=(q0+QB)/KVBLK;
  DMA_K(0,0);DMA_V(0,0);DMA_K(1,SLOTB);
  bf16x8 qr[4];
  #pragma unroll
  for(int d0=0;d0<4;++d0)qr[d0]=*reinterpret_cast<const bf16x8*>(&Qw[(long)r32*DM+d0*16+hi*8]);
  float mhat=0.f,l_reg=0.f;f32x16 o[2];o[0]=f32x16{};o[1]=f32x16{};
  const int qrel=wid*QBLK+r32;
  typedef __attribute__((address_space(3))) const float* lds_fptr;
  const lds_fptr Rl=(lds_fptr)((lds_cptr)shm+LDS_BT)+(447-(q0+qrel-4*hi));
  #define CBIAS(P0,P1,t) do{ const lds_fptr rp_=Rl+64*(t); \
    _Pragma("unroll") for(int g_=0;g_<4;++g_){ SBAR(); _Pragma("unroll") for(int r=4*g_;r<4*g_+4;++r){ P0[r]+=rp_[(r&3)+8*(r>>2)]; P1[r]+=rp_[32+(r&3)+8*(r>>2)]; } } SBAR(); }while(0)
  #define CMASK(P0,P1,t) do{ if((t)>=NT-7){ CBIAS(P0,P1,t); } int jb_=(t)-(NT-4); if(jb_>=0)cmask(P0,P1,jb_,qrel,hi);}while(0)
  bool resc=false;
  #define START(P0,P1) do{ const float rm=rowmax(P0,P1); resc=false; \
    { const float dl=rm; mhat=fadd_s(mhat,dl); \
      _Pragma("unroll") for(int r=0;r<16;++r){P0[r]=fsub_s(P0[r],dl);P1[r]=fsub_s(P1[r],dl);} \
      } \
    _Pragma("unroll") for(int r=0;r<16;++r)P0[r]=__builtin_amdgcn_exp2f(P0[r]); }while(0)
  #define RESC() do{ if(resc){ asm volatile("s_waitcnt lgkmcnt(0)":::"memory"); \
      _Pragma("unroll") for(int d_=0;d_<2;++d_) _Pragma("unroll") for(int r=0;r<16;++r)o[d_][r]*=wsf[crow(r,hi)]; } }while(0)
  f32x16 pA0,pA1,pB0,pB1;
  int sl_prev=0,sl_cur=0,sl_next=SLOTB;
  #define ROT() do{sl_prev=sl_cur;sl_cur=sl_next;sl_next=(sl_next==(NSLOT-1)*SLOTB)?0:sl_next+SLOTB;}while(0)
  DMA_K(2,2*SLOTB);
  WAIT_BAR(3);
  qkt(pA0,pA1,Kbase,qr,r32,hi);asm volatile("s_nop 15\n\ts_nop 7":"+v"(pA0),"+v"(pA1));
  #pragma unroll
  for(int r=0;r<16;++r){pA0[r]+=b31l;pA1[r]+=b31l;}
  CMASK(pA0,pA1,0);
  START(pA0,pA1);
  _Pragma("unroll") for(int r=0;r<16;++r)pA1[r]=__builtin_amdgcn_exp2f(pA1[r]);
  WAIT_BAR(0);
  DMA_K(3,0);DMA_V(1,SLOTB);
  ROT();
  kload8(kf,kp0+sl_cur);
  WAIT_BAR(2);
  s16x4 vlo[8],vhi[8]; u32x4 pw0,pw1,pw2,pw3;
  #define PKW(P,B) cvtpk_s(P[B],P[B+1])
  #define PAF(k) __builtin_bit_cast(bf16x8,pw##k)
  #define VFR(i) (bf16x8){vlo[i][0],vlo[i][1],vlo[i][2],vlo[i][3],vhi[i][0],vhi[i][1],vhi[i][2],vhi[i][3]}
  #define PIN(x) asm volatile("":"+v"(x))
  #define MX3(a,b,c) __builtin_fmaxf(__builtin_fmaxf((a),(b)),(c))
  #define GAPA(MF,A0,A1,A2,A3,W0,W1,PW) do{ MF; sacc+=A0; sacc+=A1; sacc+=A2; sacc+=A3; PIN(sacc); W0; W1; PIN(PW); SBAR(); }while(0)
  #define EX(v) __builtin_amdgcn_exp2f(v)
  #define GAPB(MF,X,B) do{ MF; X[B]=EX(X[B]); X[B+1]=EX(X[B+1]); X[B+2]=EX(X[B+2]); X[B+3]=EX(X[B+3]); PIN(X); SBAR(); }while(0)
  #define VRD(i) do{ vlo[i]=vtr(vp_+(((i)>>2)*4096+((i)&3)*1024)); vhi[i]=vtr(vp_+(((i)>>2)*4096+((i)&3)*1024+512)); }while(0)
  #define KRD(G,j) do{ if(G){ kload2(kf,kp0+sl_next,j); SBAR(); } }while(0)
  #define STEP(C0,C1,P0,P1,t,GK,GV,GL) do{ SBAR(); \
    const lds_cptr vp_=vp0+sl_prev; \
    VRD(0); SBAR(); float sacc=(P0[0]+P0[1]); \
    GAPA(C0=__builtin_amdgcn_mfma_f32_32x32x16_bf16(kf[0],qr[0],f32x16{},0,0,0), P0[2],P0[3],P0[4],P0[5],     pw0[0]=PKW(P0,0), pw0[1]=PKW(P0,2), pw0); \
    VRD(4); SBAR(); GAPA(C1=__builtin_amdgcn_mfma_f32_32x32x16_bf16(kf[1],qr[0],f32x16{},0,0,0), P0[6],P0[7],P0[8],P0[9],     pw0[2]=PKW(P0,4), pw0[3]=PKW(P0,6), pw0); \
    VRD(1); SBAR(); GAPA(C0=__builtin_amdgcn_mfma_f32_32x32x16_bf16(kf[2],qr[1],C0,0,0,0),   P0[10],P0[11],P0[12],P0[13], pw1[0]=PKW(P0,8), pw1[1]=PKW(P0,10), pw1); \
    VRD(5); SBAR(); GAPA(C1=__builtin_amdgcn_mfma_f32_32x32x16_bf16(kf[3],qr[1],C1,0,0,0),   P0[14],P0[15],P1[0],P1[1],   pw1[2]=PKW(P0,12),pw1[3]=PKW(P0,14), pw1); \
    VRD(2); SBAR(); GAPA(C0=__builtin_amdgcn_mfma_f32_32x32x16_bf16(kf[4],qr[2],C0,0,0,0),   P1[2],P1[3],P1[4],P1[5],     pw2[0]=PKW(P1,0), pw2[1]=PKW(P1,2), pw2); \
    VRD(6); SBAR(); GAPA(C1=__builtin_amdgcn_mfma_f32_32x32x16_bf16(kf[5],qr[2],C1,0,0,0),   P1[6],P1[7],P1[8],P1[9],     pw2[2]=PKW(P1,4), pw2[3]=PKW(P1,6), pw2); \
    VRD(3); SBAR(); GAPA(C0=__builtin_amdgcn_mfma_f32_32x32x16_bf16(kf[6],qr[3],C0,0,0,0),   P1[10],P1[11],P1[12],P1[13], pw3[0]=PKW(P1,8), pw3[1]=PKW(P1,10), pw3); \
    VRD(7); SBAR(); GAPA(C1=__builtin_amdgcn_mfma_f32_32x32x16_bf16(kf[7],qr[3],C1,0,0,0),   P1[14],P1[15],0.f,0.f,       pw3[2]=PKW(P1,12),pw3[3]=PKW(P1,14), pw3); \
    l_reg+=sacc; \
    if(GK){DMA_K((t)+3,sl_cur);} if(GV){DMA_V((t)+1,sl_next);} \
    { const float nb_=b31l-mhat; _Pragma("unroll") for(int r=0;r<16;++r){C0[r]+=nb_;C1[r]+=nb_;} } \
    CMASK(C0,C1,t); \
    { float a=MX3(C0[0],C0[1],C1[0]),b=MX3(C0[2],C0[3],C1[1]); a=MX3(a,C1[2],C1[3]); \
      _Pragma("unroll") for(int r=4;r<16;r+=4){a=MX3(a,C0[r],C0[r+1]);b=MX3(b,C0[r+2],C0[r+3]);a=MX3(a,C1[r],C1[r+1]);b=MX3(b,C1[r+2],C1[r+3]);} \
      float rm=__builtin_fmaxf(a,b); { auto rr=__builtin_amdgcn_permlane32_swap(__float_as_uint(rm),__float_as_uint(rm),false,false); rm=__builtin_fmaxf(__uint_as_float(rr[0]),__uint_as_float(rr[1])); } \
      resc=false; \
      if(__builtin_expect(__any(rm>(float)THRL),0)){ const float dl=__builtin_fmaxf(rm,0.f); mhat+=dl; \
        _Pragma("unroll") for(int r=0;r<16;++r){C0[r]-=dl;C1[r]-=dl;} \
        const float f=__builtin_amdgcn_exp2f(-dl); l_reg*=f; { int r32b_=r32; asm volatile("":"+v"(r32b_)); if(hi==0)wsf[r32b_]=f; } resc=true; } } \
    SBAR(); \
    GAPB(o[0]=__builtin_amdgcn_mfma_f32_32x32x16_bf16(PAF(0),VFR(0),o[0],0,0,0), C0,0); \
    GAPB(o[1]=__builtin_amdgcn_mfma_f32_32x32x16_bf16(PAF(0),VFR(4),o[1],0,0,0), C0,4); \
    KRD(GL,0); GAPB(o[0]=__builtin_amdgcn_mfma_f32_32x32x16_bf16(PAF(1),VFR(1),o[0],0,0,0), C0,8); \
    KRD(GL,1); GAPB(o[1]=__builtin_amdgcn_mfma_f32_32x32x16_bf16(PAF(1),VFR(5),o[1],0,0,0), C0,12); \
    KRD(GL,2); GAPB(o[0]=__builtin_amdgcn_mfma_f32_32x32x16_bf16(PAF(2),VFR(2),o[0],0,0,0), C1,0); \
    KRD(GL,3); GAPB(o[1]=__builtin_amdgcn_mfma_f32_32x32x16_bf16(PAF(2),VFR(6),o[1],0,0,0), C1,4); \
    GAPB(o[0]=__builtin_amdgcn_mfma_f32_32x32x16_bf16(PAF(3),VFR(3),o[0],0,0,0), C1,8); \
    GAPB(o[1]=__builtin_amdgcn_mfma_f32_32x32x16_bf16(PAF(3),VFR(7),o[1],0,0,0), C1,12); \
    }while(0)
  int t=1;
  #undef CMASK
  #define CMASK(P0,P1,t) do{}while(0)
  for(;t+7<NT;t+=2){
    STEP(pB0,pB1,pA0,pA1,t,true,true,true);     WAIT_BAR(2); RESC(); ROT();
    STEP(pA0,pA1,pB0,pB1,t+1,true,true,true);   WAIT_BAR(2); RESC(); ROT();
  }
  #undef CMASK
  #define CMASK(P0,P1,t) do{ CBIAS(P0,P1,t); int jb_=(t)-(NT-4); if(jb_>=0)cmask(P0,P1,jb_,qrel,hi);}while(0)
  #define ENDW(tt) do{ if((tt)+3<NT){WAIT_BAR(2);} else if((tt)+2<NT){WAIT_BAR(1);} else {WAIT_BAR(0);} }while(0)
  for(;t+1<NT;t+=2){
    STEP(pB0,pB1,pA0,pA1,t,(t+3<NT),(t+1<NT),(t+1<NT));       ENDW(t);   RESC(); ROT();
    STEP(pA0,pA1,pB0,pB1,t+1,(t+4<NT),(t+2<NT),(t+2<NT));     ENDW(t+1); RESC(); ROT();
  }
  STEP(pB0,pB1,pA0,pA1,NT-1,false,false,false); RESC();
  { float sacc=pB0[0]+pB0[1]; _Pragma("unroll") for(int r=2;r<16;++r)sacc+=pB0[r]; _Pragma("unroll") for(int r=0;r<16;++r)sacc+=pB1[r]; l_reg+=sacc;
    pw0=(u32x4){PKW(pB0,0),PKW(pB0,2),PKW(pB0,4),PKW(pB0,6)};pw1=(u32x4){PKW(pB0,8),PKW(pB0,10),PKW(pB0,12),PKW(pB0,14)};pw2=(u32x4){PKW(pB1,0),PKW(pB1,2),PKW(pB1,4),PKW(pB1,6)};pw3=(u32x4){PKW(pB1,8),PKW(pB1,10),PKW(pB1,12),PKW(pB1,14)};
    SBAR(); pv(o,vb0+sl_cur,PAF(0),PAF(1),PAF(2),PAF(3)); }
  #undef PKW
  #undef PAF
  #undef VFR
  #undef PIN
  #undef MX3
  #undef GAPA
  #undef GAPB
  #undef EX
  #undef VRD
  #undef KRD
  #undef STEP
  #undef ENDW
  {auto rr=__builtin_amdgcn_permlane32_swap(__float_as_uint(l_reg),__float_as_uint(l_reg),false,false);l_reg=__uint_as_float(rr[0])+__uint_as_float(rr[1]);}
  if(hi==0)wsf[32+r32]=l_reg;asm volatile("s_waitcnt lgkmcnt(0)":::"memory");
  float rli[16];
  #pragma unroll
  for(int r=0;r<16;++r)rli[r]=__builtin_amdgcn_rcpf(wsf[32+crow(r,hi)]);
  bf16*Ow=Oc+(long)(wid*QBLK)*OPITCH;
  { bf16*stg=(bf16*)(shm+LDS_OST)+wid*2048;
    #pragma unroll
    for(int r=0;r<16;++r){const int orow=crow(r,hi);
      #pragma unroll
      for(int d0=0;d0<2;++d0)stg[orow*64+d0*32+r32]=__float2bfloat16(o[d0][r]*rli[r]);}
    asm volatile("s_waitcnt lgkmcnt(0)":::"memory");
    #pragma unroll
    for(int i=0;i<4;++i){const int row=i*8+(lane>>3),ch=lane&7; const u32x4 v=*(const u32x4*)(stg+row*64+ch*8); ATTN_STORE16(Ow+(long)row*OPITCH+ch*8,v);} }
  asm volatile("s_waitcnt lgkmcnt(0)\n\ts_barrier":::"memory");
  #undef DMA_K
  #undef DMA_V
  #undef CMASK
  #undef CBIAS
  #undef START
  #undef RESC
  #undef ROT
}
constexpr int ATTN_LDS_BYTES=LDS_BYTES;
#undef SBAR
#undef WAIT_BAR
}

namespace topk {
typedef short bf16x8 __attribute__((ext_vector_type(8)));
typedef float f32x16 __attribute__((ext_vector_type(16)));
#define TK_WL4(wa_, wb_, a0_, a1_, b0_, b1_, j0) asm volatile("s_nop 3\n\tv_writelane_b32 %0, %2, %6\n\tv_writelane_b32 %0, %3, %7\n\tv_writelane_b32 %1, %4, %6\n\tv_writelane_b32 %1, %5, %7" : "+v"(wa_), "+v"(wb_) : "s"(a0_), "s"(a1_), "s"(b0_), "s"(b1_), "n"(j0), "n"((j0) + 1))
__device__ __forceinline__ unsigned fkey(float f) { const unsigned u = __float_as_uint(f); return (u & 0x80000000u) ? ~u : (u | 0x80000000u); }
template <int CTRL> __device__ __forceinline__ unsigned dpp_u(unsigned v) { return (unsigned)__builtin_amdgcn_update_dpp(0, (int)v, CTRL, 0xF, 0xF, true); }
__device__ __forceinline__ unsigned wsum_u(unsigned v) {
    v += dpp_u<0xB1>(v); v += dpp_u<0x4E>(v); v += dpp_u<0x141>(v); v += dpp_u<0x140>(v);
    auto r = __builtin_amdgcn_permlane16_swap(v, v, false, false); v = r[0] + r[1];
    auto r2 = __builtin_amdgcn_permlane32_swap(v, v, false, false); return r2[0] + r2[1];
}
__device__ __forceinline__ void unit(const bf16* __restrict__ qq, const bf16* __restrict__ ki, const float* __restrict__ wi, unsigned* __restrict__ sel, int b, int t0, LAS unsigned* keys, int wave, int lane) {
    if (t0 + 15 < TOPK) {
#pragma unroll
        for (int q = 0; q < 2; ++q) { const int t = t0 + 2 * wave + q, lo = 32 * lane; unsigned w = 0u; if (lo + 31 <= t) w = 0xffffffffu; else if (lo <= t) w = (2u << (t - lo)) - 1u;
            sel[((size_t)b * L + t) * 64 + lane] = w; }
        return;
    }
    const int jd = (t0 + 15) >> 5;
    {
        const int c = lane & 31, hf = lane >> 5, rg = wave & 3, kh = wave >> 2, tq = t0 + 4 * rg;
        const int qa = ((c >> 4) << 1) | ((c >> 2) & 1), ha = (c & 3) | (((c >> 3) & 1) << 2);
        const bf16* ap = qq + ((size_t)b * L + tq + qa) * NQQ + ha * 64 + 32 * hf;
        bf16x8 af[4];
#pragma unroll
        for (int s = 0; s < 4; ++s) af[s] = *(const bf16x8*)(ap + 8 * s);
        float wA[8], wB[8];
        { const f32x4* wp = (const f32x4*)(wi + ((size_t)b * L + tq + hf) * 8); const f32x4 w0 = wp[0], w1 = wp[1], w2 = wp[4], w3 = wp[5];
#pragma unroll
          for (int k = 0; k < 4; ++k) { wA[k] = w0[k]; wA[4 + k] = w1[k]; wB[k] = w2[k]; wB[4 + k] = w3[k]; } }
        const int tA = tq + hf, tB = tq + 2 + hf;
        LAS unsigned* kA = keys + (4 * rg + hf) * 2048 + c; LAS unsigned* kB = kA + 2 * 2048;
        const bf16* kp = ki + ((size_t)b * L + c) * 64 + 32 * hf;
        bf16x8 bn[4];
        if (kh <= jd) {
#pragma unroll
            for (int s = 0; s < 4; ++s) bn[s] = *(const bf16x8*)(kp + (size_t)kh * 32 * 64 + 8 * s);
        }
        for (int j = kh; j <= jd; j += 2) {
            f32x16 acc = {};
#pragma unroll
            for (int s = 0; s < 4; ++s) acc = __builtin_amdgcn_mfma_f32_32x32x16_bf16(af[s], bn[s], acc, 0, 0, 0);
            if (j + 2 <= jd) {
#pragma unroll
                for (int s = 0; s < 4; ++s) bn[s] = *(const bf16x8*)(kp + (size_t)(j + 2) * 32 * 64 + 8 * s);
            }
            float sa = 0.f, sb = 0.f;
#pragma unroll
            for (int h = 0; h < 8; ++h) { sa += wA[h] * fmaxf(acc[h], 0.f); sb += wB[h] * fmaxf(acc[8 + h], 0.f); }
            const int key = 32 * j + c;
            kA[32 * j] = key > tA ? 0u : fkey(sa); kB[32 * j] = key > tB ? 0u : fkey(sb);
        }
    }
    __syncthreads();
    {
        const int nvalid = 32 * (jd + 1);
        unsigned kA[32], kB[32];
        const LAS unsigned* pa = keys + (2 * wave) * 2048 + lane; const LAS unsigned* pb = pa + 2048;
#pragma unroll
        for (int i = 0; i < 32; ++i) { const bool ok = 64 * i + lane < nvalid; kA[i] = ok ? pa[64 * i] : 0u; kB[i] = ok ? pb[64 * i] : 0u; }
        const int ilim = (nvalid + 63) >> 6;
        unsigned pA = 0u, pB = 0u;
        for (int bit = 31; bit >= 0; --bit) {
            const unsigned cA = pA | (1u << bit), cB = pB | (1u << bit); unsigned cnt = 0u;
#pragma unroll
            for (int g4 = 0; g4 < 8; ++g4) { if (4 * g4 < ilim) {
#pragma unroll
                for (int i = 4 * g4; i < 4 * g4 + 4; ++i) { cnt += (kA[i] >= cA) ? 1u : 0u; cnt += (kB[i] >= cB) ? 0x10000u : 0u; } __builtin_amdgcn_sched_barrier(0); } }
            cnt = wsum_u(cnt);
            const unsigned nA = cnt & 0xffffu, nB = cnt >> 16;
            if (nA >= (unsigned)TOPK) pA = cA;
            if (nB >= (unsigned)TOPK) pB = cB;
            if (nA == (unsigned)TOPK && nB == (unsigned)TOPK) break;
        }
        unsigned cge = 0u, cgt = 0u;
#pragma unroll
        for (int i = 0; i < 32; ++i) { cge += (kA[i] >= pA) ? 1u : 0u; cge += (kB[i] >= pB) ? 0x10000u : 0u; cgt += (kA[i] > pA) ? 1u : 0u; cgt += (kB[i] > pB) ? 0x10000u : 0u; if ((i & 3) == 3) __builtin_amdgcn_sched_barrier(0); }
        cge = wsum_u(cge); cgt = wsum_u(cgt);
        asm volatile("" : "+v"(pA), "+v"(pB));
        const bool tie = (cge & 0xffffu) != (unsigned)TOPK || (cge >> 16) != (unsigned)TOPK;
        unsigned wa = 0u, wb = 0u;
        if (!tie) {
#pragma unroll
            for (int i = 0; i < 32; ++i) {
                const unsigned long long mA = __builtin_amdgcn_ballot_w64(kA[i] >= pA), mB = __builtin_amdgcn_ballot_w64(kB[i] >= pB);
                const unsigned a0 = (unsigned)mA, a1 = (unsigned)(mA >> 32), b0 = (unsigned)mB, b1 = (unsigned)(mB >> 32);
                TK_WL4(wa, wb, a0, a1, b0, b1, 2 * i); __builtin_amdgcn_sched_barrier(0);
            }
        } else {
            const unsigned needA = (unsigned)TOPK - (cgt & 0xffffu), needB = (unsigned)TOPK - (cgt >> 16); unsigned runA = 0u, runB = 0u;
            const unsigned long long below = (1ull << lane) - 1ull;
#pragma unroll
            for (int i = 0; i < 32; ++i) {
                const unsigned long long eA = __builtin_amdgcn_ballot_w64(kA[i] == pA), eB = __builtin_amdgcn_ballot_w64(kB[i] == pB);
                const bool tkA = kA[i] > pA || (kA[i] == pA && runA + (unsigned)__builtin_popcountll(eA & below) < needA);
                const bool tkB = kB[i] > pB || (kB[i] == pB && runB + (unsigned)__builtin_popcountll(eB & below) < needB);
                runA += (unsigned)__builtin_popcountll(eA); runB += (unsigned)__builtin_popcountll(eB);
                const unsigned long long mA = __builtin_amdgcn_ballot_w64(tkA), mB = __builtin_amdgcn_ballot_w64(tkB);
                const unsigned a0 = (unsigned)mA, a1 = (unsigned)(mA >> 32), b0 = (unsigned)mB, b1 = (unsigned)(mB >> 32);
                TK_WL4(wa, wb, a0, a1, b0, b1, 2 * i); __builtin_amdgcn_sched_barrier(0);
            }
        }
        unsigned* so = sel + ((size_t)b * L + t0 + 2 * wave) * 64 + lane;
        so[0] = wa; so[64] = wb;
    }
    __syncthreads();
}
#undef TK_WL4
}

namespace sparse {
typedef short bf16x8 __attribute__((ext_vector_type(8)));
typedef short s16x4 __attribute__((ext_vector_type(4)));
typedef float f32x4 __attribute__((ext_vector_type(4)));
typedef int i32x4 __attribute__((ext_vector_type(4)));
typedef __attribute__((address_space(3))) const char* lds_cptr;
typedef short v4i16_t __attribute__((ext_vector_type(4)));
constexpr int BUF = 8192, WAVE_LDS = 2 * BUF + 1024, BT_OFF = 8 * WAVE_LDS, LDS_NEED = BT_OFF + 8192;
__device__ __forceinline__ int fsw(int r) { return ((((r & 7) ^ ((r >> 3) << 2))) << 1) | (r >> 3); }
__device__ __forceinline__ void glds16(const void* gsrc, unsigned lds_dst) { unsigned keep;
    asm volatile("s_mov_b32 %0, m0\n\ts_mov_b32 m0, %2\n\ts_nop 0\n\tglobal_load_lds_dwordx4 %1, off\n\ts_mov_b32 m0, %0" : "=&s"(keep) : "v"(gsrc), "s"(lds_dst) : "memory"); }
__device__ __forceinline__ s16x4 vtr(lds_cptr p) { return __builtin_bit_cast(s16x4, __builtin_amdgcn_ds_read_tr16_b64_v4i16((__attribute__((address_space(3))) v4i16_t*)p)); }
__device__ __forceinline__ float xmax16(float v) { auto r = __builtin_amdgcn_permlane16_swap(__float_as_uint(v), __float_as_uint(v), false, false); return fmaxf(__uint_as_float(r[0]), __uint_as_float(r[1])); }
__device__ __forceinline__ float xmax32(float v) { auto r = __builtin_amdgcn_permlane32_swap(__float_as_uint(v), __float_as_uint(v), false, false); return fmaxf(__uint_as_float(r[0]), __uint_as_float(r[1])); }
__device__ __forceinline__ unsigned cvtpk(float lo, float hi) { typedef float f2 __attribute__((ext_vector_type(2))); typedef __bf16 b2 __attribute__((ext_vector_type(2))); f2 v = {lo, hi}; b2 b = __builtin_convertvector(v, b2); return __builtin_bit_cast(unsigned, b); }

__device__ __forceinline__ void query(const bf16* __restrict__ qq, const bf16* __restrict__ ckv, const unsigned* __restrict__ sel, bf16* __restrict__ olat, int b, int t, char* wl, const float* btl, int lane) {
    const int hd = lane & 15, quad = lane >> 4; const size_t row = (size_t)b * L + t;
    int* idx = (int*)(wl + 2 * BUF);
    const unsigned word = sel[row * 64 + lane];
    { const int z = -1; *(i32x4*)(idx + 4 * lane) = (i32x4){z, z, z, z}; }
    asm volatile("s_waitcnt lgkmcnt(0)" ::: "memory");
    int base = 0;
#pragma unroll 4
    for (int p = 0; p < 32; ++p) {
        const bool on = (word >> p) & 1u; const unsigned long long m = __builtin_amdgcn_ballot_w64(on);
        const int slot = base + (int)__builtin_amdgcn_mbcnt_hi((unsigned)(m >> 32), __builtin_amdgcn_mbcnt_lo((unsigned)m, 0u));
        if (on && slot < 256) idx[slot] = 32 * lane + p;
        base += __builtin_popcountll(m);
    }
    const int n = base < 256 ? base : 256, nch = (n + 31) >> 5;
    asm volatile("s_waitcnt lgkmcnt(0)" ::: "memory");
    bf16x8 qf[4];
    { const bf16* qp = qq + row * NQQ + 512 + hd * 128 + 8 * quad;
#pragma unroll
      for (int s = 0; s < 4; ++s) qf[s] = *(const bf16x8*)(qp + 32 * s); }
    const unsigned lds0 = (unsigned)(uintptr_t)wl;
    const bf16* gbase = ckv + (size_t)b * L * 128;
    const lds_cptr wl3 = (lds_cptr)wl;
    const int fk = fsw(hd);
    const int qp_ = hd >> 2, pp_ = hd & 3, rv = 4 * quad + qp_, fv = fsw(rv);
#define SP_DMA(ch, bufoff) do { _Pragma("unroll") for (int i_ = 0; i_ < 8; ++i_) { const int R_ = 4 * i_ + quad; int key_ = idx[32 * (ch) + R_]; key_ = key_ < 0 ? 0 : key_; \
        glds16(gbase + (size_t)key_ * 128 + 8 * (hd ^ fsw(R_ & 15)), (unsigned)__builtin_amdgcn_readfirstlane(lds0 + (bufoff) + 1024 * i_)); } } while (0)
    f32x4 o[8];
#pragma unroll
    for (int rb = 0; rb < 8; ++rb) o[rb] = (f32x4){0.f, 0.f, 0.f, 0.f};
    float mref = -INFINITY, lsum = 0.f;
    SP_DMA(0, 0);
    for (int ch = 0; ch < nch; ++ch) {
        const int bo = (ch & 1) * BUF;
        if (ch + 1 < nch) { SP_DMA(ch + 1, BUF - bo); asm volatile("s_waitcnt vmcnt(8)" ::: "memory"); }
        else asm volatile("s_waitcnt vmcnt(0)" ::: "memory");
        f32x4 sc[2];
#pragma unroll
        for (int T = 0; T < 2; ++T) { f32x4 acc = {0.f, 0.f, 0.f, 0.f}; const lds_cptr kr = wl3 + bo + 256 * (16 * T + hd);
#pragma unroll
            for (int s = 0; s < 4; ++s) { const bf16x8 kf = *(const __attribute__((address_space(3))) bf16x8*)(kr + 16 * ((4 * s + quad) ^ fk));
                acc = __builtin_amdgcn_mfma_f32_16x16x32_bf16(kf, qf[s], acc, 0, 0, 0); }
            sc[T] = acc; }
        float mloc = -INFINITY;
#pragma unroll
        for (int T = 0; T < 2; ++T) { const i32x4 kx = *(const i32x4*)(idx + 32 * ch + 16 * T + 4 * quad);
#pragma unroll
            for (int r = 0; r < 4; ++r) { int d = t - kx[r]; d = d > 127 ? 127 : d; const float bv = btl[(d < 0 ? 0 : d) * 16 + hd];
                const float v = kx[r] < 0 ? -INFINITY : sc[T][r] + bv; sc[T][r] = v; mloc = fmaxf(mloc, v); } }
        mloc = xmax32(xmax16(mloc));
        if (__builtin_amdgcn_ballot_w64(mloc > mref + 8.f) != 0ull) {
            const float mn = fmaxf(mref, mloc), f = __builtin_amdgcn_exp2f(mref - mn); mref = mn; lsum *= f;
#pragma unroll
            for (int rb = 0; rb < 8; ++rb) o[rb] = o[rb] * f;
        }
        float p0[4], p1[4];
#pragma unroll
        for (int r = 0; r < 4; ++r) { p0[r] = __builtin_amdgcn_exp2f(sc[0][r] - mref); p1[r] = __builtin_amdgcn_exp2f(sc[1][r] - mref); lsum += p0[r] + p1[r]; }
        typedef unsigned u32x4v __attribute__((ext_vector_type(4)));
        const u32x4v pw = {cvtpk(p0[0], p0[1]), cvtpk(p0[2], p0[3]), cvtpk(p1[0], p1[1]), cvtpk(p1[2], p1[3])};
        const bf16x8 pb = __builtin_bit_cast(bf16x8, pw);
        const lds_cptr v0p = wl3 + bo + 256 * rv + 8 * (pp_ & 1), v1p = v0p + 256 * 16;
#pragma unroll
        for (int rb = 0; rb < 8; ++rb) { const int pos = 16 * ((2 * rb + (pp_ >> 1)) ^ fv);
            const s16x4 a0 = vtr(v0p + pos), a1 = vtr(v1p + pos);
            const bf16x8 va = {a0[0], a0[1], a0[2], a0[3], a1[0], a1[1], a1[2], a1[3]};
            o[rb] = __builtin_amdgcn_mfma_f32_16x16x32_bf16(va, pb, o[rb], 0, 0, 0); }
    }
#undef SP_DMA
    lsum = xsum32(xsum16(lsum));
    const float inv = __builtin_amdgcn_rcpf(lsum);
    bf16* op = olat + row * 2048 + hd * 128 + 4 * quad;
#pragma unroll
    for (int rb = 0; rb < 8; ++rb) { typedef unsigned u32x2v __attribute__((ext_vector_type(2)));
        const u32x2v w = {cvtpk(o[rb][0] * inv, o[rb][1] * inv), cvtpk(o[rb][2] * inv, o[rb][3] * inv)};
        *(u32x2v*)(op + 16 * rb) = w; }
    asm volatile("s_waitcnt lgkmcnt(0)" ::: "memory");
}
}

constexpr int NWAVES = 8;
constexpr int RING_OFF = 0, RING_BYTES = 131072;
constexpr int LDSCTL_OFF = 162816, MISC_OFF = LDSCTL_OFF + 320;
constexpr int LDS_BYTES = 163840;
static_assert(sparse::LDS_NEED <= LDSCTL_OFF, "sparse phase LDS");
enum { PH_PRO = 0, PH_PRE0, PH_INPROJ0, PH_QGEMM, PH_TOPK, PH_SPARSE, PH_UV, PH_OUT0, PH_POST0, PH_INPROJ1, PH_ATTN1, PH_OUT1, PH_FINAL, N_PHASES };

struct Args { const float* in[N_IN]; float* out; unsigned char* ws; int ph_lo, ph_hi, li, pad; };

__device__ __forceinline__ int fresh_lane(int dep = 0) { int l; asm volatile("v_mbcnt_lo_u32_b32 %0, -1, 0\n\tv_mbcnt_hi_u32_b32 %0, -1, %0 ; dep %1" : "=v"(l) : "s"(dep)); return l; }
__device__ __forceinline__ float wave_sum(float v) { return wave_sum_all(v); }
__device__ __forceinline__ void p0_transpose_item(const float* W, int K, int N, int Npad, const float* g, bf16* WT, LAS float* scr, int item, int lane) {
    const int nblk = Npad / 32, kb = item / nblk, nb = item % nblk, k0 = 64 * kb, n0 = 32 * nb;
    const bool ok = (n0 + (lane & 31)) < N;
#pragma unroll 8
    for (int i = 0; i < 32; ++i) { const int kk = 2 * i + (lane >> 5); float v = 0.f; if (ok) { v = W[(size_t)(k0 + kk) * N + n0 + (lane & 31)]; if (g) v *= g[k0 + kk]; } scr[kk * 33 + (lane & 31)] = v; }
    LDS_WAIT(); asm volatile("" ::: "memory");
    const int c = lane & 7;
#pragma unroll
    for (int j = 0; j < 4; ++j) { const int n = (lane >> 3) + 8 * j; const LAS float* s = scr + (8 * c) * 33 + n;
        v4u o; o.x = pk2(s[0 * 33], s[1 * 33]); o.y = pk2(s[2 * 33], s[3 * 33]); o.z = pk2(s[4 * 33], s[5 * 33]); o.w = pk2(s[6 * 33], s[7 * 33]);
        *(GAS v4u*)(WT + (size_t)(n0 + n) * K + k0 + 8 * c) = o; }
    LDS_WAIT(); asm volatile("" ::: "memory");
}
typedef const __attribute__((address_space(4))) Args CArgs;
__device__ __forceinline__ CArgs* kargs(int dep) { CArgs* p = (CArgs*)__builtin_amdgcn_kernarg_segment_ptr(); asm volatile("; kargs %1" : "+s"(p) : "s"(dep)); return p; }
__device__ __forceinline__ void p0_prologue(CArgs* ap, LAS unsigned char* lds, int tid, int lane, int wave, int vcu, int G) {
    unsigned char* ws = ap->ws;
    float* mod = (float*)(ws + WS_MOD); Misc* ms = (Misc*)(ws + WS_MISC);
    if (vcu < 96) {
        LAS float* cact = (LAS float*)lds;
        LAS float* red = (LAS float*)(lds + 32768);
        const float* c = ap->in[I_C];
        for (int i = tid; i < NB * D; i += NWAVES * 64) cact[i] = siluf(c[i]);
        __syncthreads();
        const int li = vcu / 48, n = (vcu % 48) * 64 + lane; const float* mw = ap->in[I_MODW] + ((size_t)li * D + wave * 128) * 3072 + n;
        float acc[NB];
#pragma unroll
        for (int b = 0; b < NB; ++b) acc[b] = 0.f;
#pragma unroll 8
        for (int k = 0; k < 128; ++k) { const float w = mw[(size_t)k * 3072];
#pragma unroll
            for (int b = 0; b < NB; ++b) acc[b] += cact[b * D + wave * 128 + k] * w; }
#pragma unroll
        for (int b = 0; b < NB; ++b) red[(wave * NB + b) * 64 + lane] = acc[b];
        __syncthreads();
        { const int b = tid >> 6; float s = 0.f;
#pragma unroll
          for (int w = 0; w < NWAVES; ++w) s += red[(w * NB + b) * 64 + lane];
          mod[((size_t)li * NB + b) * 3072 + n] = s + ap->in[I_MODB][li * 3072 + n]; }
        __syncthreads();
    }
    if (vcu == 96 && tid < 128) {
        const int t = tid;
        if (t == 0) { float s1 = 0.f, s2 = 0.f; for (int i = 0; i < 64; ++i) { s1 += ap->in[I_BLQ1][i] * ap->in[I_BLK1][i]; s2 += ap->in[I_BLQ2][i] * ap->in[I_BLK2][i]; } ms->lam = expf(s1) - expf(s2) + LAMBDA_INIT; }
        int bk; if (t < 16) bk = t; else { bk = 16 + (int)(logf((float)t / 16.f) / 2.0794415416798357f * 16.f); if (bk > 31) bk = 31; } ms->lut[t] = bk;
        for (int cix = 0; cix < 16; ++cix) ms->btab[t * 16 + cix] = ap->in[I_RELB][bk * 16 + cix];
    }
    LAS float* scr = (LAS float*)(lds + RING_OFF + wave * 16384);
    const int gw = vcu * NWAVES + wave, NGW = G * NWAVES;
    bf16 *win0 = (bf16*)(ws + WS_WIN0), *wq2 = (bf16*)(ws + WS_WQ2), *wuv = (bf16*)(ws + WS_WUV), *wout0 = (bf16*)(ws + WS_WOUT0), *win1 = (bf16*)(ws + WS_WIN1), *wout1 = (bf16*)(ws + WS_WOUT1);
    constexpr int I_A = 16 * 48, I_QI = 4 * 16, I_O0 = 16 * 32, I_B = 16 * 128, I_O1 = 16 * 32, NITEMS = I_A + I_QI + I_O0 + I_B + I_O1;
    for (int it = gw; it < NITEMS; it += NGW) {
        int r = it;
        if (r < I_B) { p0_transpose_item(ap->in[I_BWIN], D, B_IN, B_IN, nullptr, win1, scr, r, lane); continue; } r -= I_B;
        if (r < I_A) { p0_transpose_item(ap->in[I_AWIN], D, A_IN, A_INP, nullptr, win0, scr, r, lane); continue; } r -= I_A;
        if (r < I_O0) { p0_transpose_item(ap->in[I_AWOUT], D, D, D, nullptr, wout0, scr, r, lane); continue; } r -= I_O0;
        if (r < I_O1) { p0_transpose_item(ap->in[I_BWOUT], D, D, D, nullptr, wout1, scr, r, lane); continue; } r -= I_O1;
        p0_transpose_item(ap->in[I_AWQIDX], QR, 512, 512, ap->in[I_AQN], wq2, scr, r, lane);
    }
    for (int it = gw; it < 16 * 4 * 4; it += NGW) {
        const int h = it >> 4, kt = (it >> 2) & 3, rq = it & 3, k = kt * 64 + lane;
        const float* uq = ap->in[I_AWUQ] + (size_t)k * 1024 + h * 64; float av[64];
#pragma unroll
        for (int d4 = 0; d4 < 16; ++d4) { const f32x4 t4 = *(const f32x4*)(uq + 4 * d4); av[4 * d4] = t4[0]; av[4 * d4 + 1] = t4[1]; av[4 * d4 + 2] = t4[2]; av[4 * d4 + 3] = t4[3]; }
        const float gk = ap->in[I_AQN][k] * C2;
        for (int r = rq * 32; r < rq * 32 + 32; ++r) { const float* uk = ap->in[I_AWUK] + ((size_t)h * 128 + r) * 64; float s = 0.f;
#pragma unroll
            for (int d = 0; d < 64; ++d) s += av[d] * uk[d];
            wq2[(size_t)(512 + h * 128 + r) * 256 + k] = (bf16)f2bf(s * gk); }
    }
    for (int i = gw * 64 + lane; i < 1024 * 512; i += NGW * 64) {
        const int n = i >> 9, kp = i & 511, h = n >> 6, d = n & 63; float v = 0.f;
        if ((kp >> 7) == ((n & 255) >> 6)) v = ap->in[I_AWUV][((size_t)h * 128 + (kp & 127)) * 64 + d];
        wuv[i] = (bf16)f2bf(v);
    }
}
__device__ __forceinline__ void prenorm_rows(const float* x, const float* g, const float* modl, bf16* H, int gw, int NGW, int lane) {
    for (int row = gw; row < M; row += NGW) {
        const int b = row / L; const GAS f32x4* xr = (const GAS f32x4*)(x + (size_t)row * D) + lane;
        f32x4 v[4]; float s = 0.f;
#pragma unroll
        for (int j = 0; j < 4; ++j) { v[j] = xr[64 * j]; s += (v[j].x * v[j].x + v[j].y * v[j].y) + (v[j].z * v[j].z + v[j].w * v[j].w); }
        const float rs = rsqrtf(wave_sum(s) * (1.f / D) + EPS);
        const f32x4* g4 = (const f32x4*)g + lane; const f32x4* sh4 = (const f32x4*)(modl + (size_t)b * 3072) + lane; const f32x4* sc4 = sh4 + 256;
        GAS unsigned long long* o8 = (GAS unsigned long long*)(H + (size_t)row * D) + lane;
#pragma unroll
        for (int j = 0; j < 4; ++j) { const f32x4 o = v[j] * rs * g4[64 * j] * (sc4[64 * j] + 1.f) + sh4[64 * j];
            o8[64 * j] = (unsigned long long)pk2(o.x, o.y) | ((unsigned long long)pk2(o.z, o.w) << 32); }
    }
}
__device__ __forceinline__ void post_rows(const float* xin, const bf16* Y, const float* postg, const float* modc, const float* pregn, const float* modn, float* xout, bf16* H, int gw, int NGW, int lane) {
    for (int row = gw; row < M; row += NGW) {
        const int b = row / L; const GAS unsigned long long* y8 = (const GAS unsigned long long*)(Y + (size_t)row * D) + lane;
        f32x4 yv[4]; float s = 0.f;
#pragma unroll
        for (int j = 0; j < 4; ++j) { const unsigned long long w = y8[64 * j]; const unsigned lo = (unsigned)w, hi = (unsigned)(w >> 32);
            yv[j].x = __uint_as_float(lo << 16); yv[j].y = __uint_as_float(lo & 0xffff0000u); yv[j].z = __uint_as_float(hi << 16); yv[j].w = __uint_as_float(hi & 0xffff0000u);
            s += (yv[j].x * yv[j].x + yv[j].y * yv[j].y) + (yv[j].z * yv[j].z + yv[j].w * yv[j].w); }
        const float rs = rsqrtf(wave_sum(s) * (1.f / D) + EPS);
        const GAS f32x4* xr = (const GAS f32x4*)(xin + (size_t)row * D) + lane; GAS f32x4* xo = (GAS f32x4*)(xout + (size_t)row * D) + lane;
        const f32x4* pg4 = (const f32x4*)postg + lane; const f32x4* rg4 = (const f32x4*)(modc + (size_t)b * 3072 + 2048) + lane;
        f32x4 x1[4]; float s2 = 0.f;
#pragma unroll
        for (int j = 0; j < 4; ++j) { x1[j] = xr[64 * j] + rg4[64 * j] * (yv[j] * rs * pg4[64 * j]); xo[64 * j] = x1[j];
            s2 += (x1[j].x * x1[j].x + x1[j].y * x1[j].y) + (x1[j].z * x1[j].z + x1[j].w * x1[j].w); }
        if (H) { const float r2 = rsqrtf(wave_sum(s2) * (1.f / D) + EPS);
            const f32x4* g4 = (const f32x4*)pregn + lane; const f32x4* sh4 = (const f32x4*)(modn + (size_t)b * 3072) + lane; const f32x4* sc4 = sh4 + 256;
            GAS unsigned long long* o8 = (GAS unsigned long long*)(H + (size_t)row * D) + lane;
#pragma unroll
            for (int j = 0; j < 4; ++j) { const f32x4 o = x1[j] * r2 * g4[64 * j] * (sc4[64 * j] + 1.f) + sh4[64 * j];
                o8[64 * j] = (unsigned long long)pk2(o.x, o.y) | ((unsigned long long)pk2(o.z, o.w) << 32); } }
    }
}
__device__ __forceinline__ void norm_kv_rows(const bf16* proj0, const float* stats, const float* kvg, const float* kig, bf16* ckv, bf16* ki, float* wi, int gw, int NGW, int lane) {
    for (int row = gw; row < M; row += NGW) {
        const float* st = stats + (size_t)row * 16; const bf16* p = proj0 + (size_t)row * A_INP;
        const float rkv = rsqrtf(((st[4] + st[5]) + (st[6] + st[7])) * (1.f / 128.f) + EPS), rki = rsqrtf((st[8] + st[9]) * (1.f / 64.f) + EPS);
        const unsigned w = *(const unsigned*)(p + 256 + 2 * lane);
        const float a0 = __uint_as_float(w << 16) * rkv * kvg[2 * lane], a1 = __uint_as_float(w & 0xffff0000u) * rkv * kvg[2 * lane + 1];
        *(unsigned*)(ckv + (size_t)row * 128 + 2 * lane) = pk2(a0, a1);
        ki[(size_t)row * 64 + lane] = (bf16)f2bf(bf2f(p[384 + lane]) * rki * kig[lane]);
        if (lane < 8) wi[(size_t)row * 8 + lane] = bf2f(p[448 + lane]) * (0.35355339059327373f * 0.125f);
    }
}

__global__ void __launch_bounds__(NWAVES * 64, 2) mk_fwd(Args args) {
    extern __shared__ __attribute__((aligned(16))) unsigned char lds_raw[];
    LAS unsigned char* lds = (LAS unsigned char*)lds_raw;
    const int wave = __builtin_amdgcn_readfirstlane(threadIdx.x >> 6);
    const int G = gridDim.x; const int bx = blockIdx.x; const int vcu = (G % 8 == 0) ? (bx % 8) * (G / 8) + bx / 8 : bx;
    for (int u = wave * 64 + lane_now(0); u < (LDS_BYTES - LDSCTL_OFF) / 4; u += NWAVES * 64) ((LAS unsigned*)(lds + LDSCTL_OFF))[u] = 0u;
    __syncthreads();
    XcdBarrier bar = xcd_barrier_post((unsigned*)((gu32*)(args.ws + WS_CTL) + CW_BAR) + args.li * XCD_BAR_WORDS, (volatile LAS unsigned*)(lds + MISC_OFF) + 8, wave);
    const int lo = args.ph_lo, hi = args.ph_hi;
#define IN(k) (lo <= (k) && (k) < hi)
#define SEAM(k) do { if (IN(k) && IN((k) + 1)) xcd_barrier(bar); } while (0)
    const int gw = vcu * NWAVES + wave, NGW = G * NWAVES;

    if (IN(PH_PRO)) { const int lane = fresh_lane(); p0_prologue(kargs(PH_PRO), lds, wave * 64 + lane, lane, wave, vcu, G); } SEAM(PH_PRO);
    if (IN(PH_PRE0)) { CArgs* A = kargs(PH_PRE0); unsigned char* ws = A->ws; prenorm_rows(A->in[I_X], A->in[I_PREG], (const float*)(ws + WS_MOD), (bf16*)(ws + WS_H), gw, NGW, fresh_lane()); } SEAM(PH_PRE0);
    if (IN(PH_INPROJ0)) {
        CArgs* A = kargs(PH_INPROJ0); unsigned char* ws = A->ws;
        pg8::Gemm g{(const bf16*)(ws + WS_H), (const bf16*)(ws + WS_WIN0), M, A_INP, D, D, D, 0}; pg8::StaticOrder S; S.init(M, A_INP, G, bx);
        pg8::Epi<pg8::EM_PROJ0> E{(bf16*)(ws + WS_PROJ0), A_INP, (float*)(ws + WS_STATS), nullptr, 0};
        pg8::gemm_phase<pg8::Epi<pg8::EM_PROJ0>, pg8::StaticOrder, true, true>(lds + RING_OFF, g, S, E, wave);
    } SEAM(PH_INPROJ0);
    if (IN(PH_QGEMM)) {
        CArgs* A = kargs(PH_QGEMM); unsigned char* ws = A->ws;
        pg8::Gemm g{(const bf16*)(ws + WS_PROJ0), (const bf16*)(ws + WS_WQ2), M, NQQ, QR, A_INP, QR, 0}; pg8::StaticOrder S; S.init(M, NQQ, G, bx);
        pg8::Epi<pg8::EM_ROWSCALE> E{(bf16*)(ws + WS_QQ), NQQ, (float*)(ws + WS_STATS), nullptr, 0};
        pg8::gemm_phase<pg8::Epi<pg8::EM_ROWSCALE>, pg8::StaticOrder, true, true>(lds + RING_OFF, g, S, E, wave);
        norm_kv_rows((const bf16*)(ws + WS_PROJ0), (const float*)(ws + WS_STATS), A->in[I_AKVN], A->in[I_AKIN], (bf16*)(ws + WS_CKV), (bf16*)(ws + WS_KI), (float*)(ws + WS_WI), gw, NGW, fresh_lane());
    } SEAM(PH_QGEMM);
    if (IN(PH_TOPK)) {
        CArgs* A = kargs(PH_TOPK); unsigned char* ws = A->ws;
        unsigned* sel = (unsigned*)(ws + WS_SEL); const int lane = fresh_lane();
        const bf16* qq = (const bf16*)(ws + WS_QQ); const bf16* ki = (const bf16*)(ws + WS_KI); const float* wi = (const float*)(ws + WS_WI);
        for (int p = vcu; p < NB * 64; p += G) {
            const int b = p >> 6, u = p & 63;
            topk::unit(qq, ki, wi, sel, b, 16 * u, (LAS unsigned*)(lds + RING_OFF), wave, lane);
            topk::unit(qq, ki, wi, sel, b, 16 * (127 - u), (LAS unsigned*)(lds + RING_OFF), wave, lane);
        }
    } SEAM(PH_TOPK);
    if (IN(PH_SPARSE)) {
        CArgs* A = kargs(PH_SPARSE); unsigned char* ws = A->ws; const Misc* ms = (const Misc*)(ws + WS_MISC);
        const int lane = fresh_lane(); float* btl = (float*)((char*)lds_raw + sparse::BT_OFF);
        for (int i = wave * 64 + lane; i < 128 * 16; i += NWAVES * 64) btl[i] = ms->btab[i] * LOG2E;
        __syncthreads();
        const int per = M / NGW;
        char* wl = (char*)lds_raw + wave * sparse::WAVE_LDS;
        for (int k = 0; k < per; ++k) { const int q = gw * per + k;
            sparse::query((const bf16*)(ws + WS_QQ), (const bf16*)(ws + WS_CKV), (const unsigned*)(ws + WS_SEL), (bf16*)(ws + WS_OLAT), q / L, q % L, wl, btl, lane); }
        for (int q = NGW * per + gw; q < M; q += NGW)
            sparse::query((const bf16*)(ws + WS_QQ), (const bf16*)(ws + WS_CKV), (const unsigned*)(ws + WS_SEL), (bf16*)(ws + WS_OLAT), q / L, q % L, wl, btl, lane);
        __syncthreads();
    } SEAM(PH_SPARSE);
    if (IN(PH_UV)) {
        CArgs* A = kargs(PH_UV); unsigned char* ws = A->ws;
        pg8::Gemm g{(const bf16*)(ws + WS_OLAT), (const bf16*)(ws + WS_WUV), M, D, 512, 2048, 512, 512}; pg8::StaticOrder S; S.init(M, D, G, bx);
        pg8::Epi<pg8::EM_UVGATE> E{(bf16*)(ws + WS_OG0), D, nullptr, (const bf16*)(ws + WS_PROJ0) + 456, A_INP};
        pg8::gemm_phase<pg8::Epi<pg8::EM_UVGATE>, pg8::StaticOrder, true, true>(lds + RING_OFF, g, S, E, wave);
    } SEAM(PH_UV);
    if (IN(PH_OUT0)) {
        CArgs* A = kargs(PH_OUT0); unsigned char* ws = A->ws;
        pg8::Gemm g{(const bf16*)(ws + WS_OG0), (const bf16*)(ws + WS_WOUT0), M, D, D, D, D, 0}; pg8::StaticOrder S; S.init(M, D, G, bx);
        pg8::Epi<pg8::EM_PLAIN> E{(bf16*)(ws + WS_Y0), D, nullptr, nullptr, 0};
        pg8::gemm_phase<pg8::Epi<pg8::EM_PLAIN>, pg8::StaticOrder, true, true>(lds + RING_OFF, g, S, E, wave);
    } SEAM(PH_OUT0);
    if (IN(PH_POST0)) { CArgs* A = kargs(PH_POST0); unsigned char* ws = A->ws; const float* mod = (const float*)(ws + WS_MOD);
        post_rows(A->in[I_X], (const bf16*)(ws + WS_Y0), A->in[I_POSTG], mod, A->in[I_PREG] + D, mod + (size_t)NB * 3072, A->out, (bf16*)(ws + WS_H), gw, NGW, fresh_lane()); } SEAM(PH_POST0);
    if (IN(PH_INPROJ1)) {
        CArgs* A = kargs(PH_INPROJ1); unsigned char* ws = A->ws;
        pg8::Gemm g{(const bf16*)(ws + WS_H), (const bf16*)(ws + WS_WIN1), M, B_IN, D, D, D, 0}; pg8::StaticOrder S; S.init(M, B_IN, G, bx);
        pg8::Epi<pg8::EM_PROJ1> E{(bf16*)(ws + WS_PROJ1), B_IN, nullptr, nullptr, 0};
        pg8::gemm_phase<pg8::Epi<pg8::EM_PROJ1>, pg8::StaticOrder, true, true>(lds + RING_OFF, g, S, E, wave);
    } SEAM(PH_INPROJ1);
    if (IN(PH_ATTN1)) {
        CArgs* A = kargs(PH_ATTN1); unsigned char* ws = A->ws; const Misc* ms = (const Misc*)(ws + WS_MISC);
        const bf16* proj1 = (const bf16*)(ws + WS_PROJ1); bf16* og1 = (bf16*)(ws + WS_OG1); const float* subln = A->in[I_BSUBLN];
        attn_body::bf16* oscr = (attn_body::bf16*)(ws + WS_OSCR);
        const attn_body::bf16* pj = (const attn_body::bf16*)proj1;
        char* shm = (char*)lds_raw + RING_OFF;
        for (int p = vcu; p < 256; p += G) {
            const int bh = p >> 2, s4 = p & 3, b = bh >> 3, h = bh & 7;
            for (int ui = 0; ui < 2; ++ui) {
                const int qb = ui == 0 ? s4 : 7 - s4;
                attn_body::bf16* ob = oscr + ((size_t)bh * L + qb * 256) * attn_body::OPITCH;
                for (int vi = 0; vi < 4; ++vi) {
                    const int mp = 2 * h + (vi >> 1);
                    attn_body::attn_unit<8>(wave, b, qb, pj + mp * 64, pj + 1024 + mp * 64, pj + 2048 + h * 128 + (vi & 1) * 64, ob + vi * 64, ms->btab + mp, shm);
                }
                asm volatile("s_waitcnt vmcnt(0)" ::: "memory");
                const int lane2 = fresh_lane(qb);
                const int r = wave * 32 + (lane2 & 31), eh = lane2 >> 5, t = qb * 256 + r; const size_t grow = (size_t)b * L + t;
                const v4u* o1p = (const v4u*)((const bf16*)ob + (size_t)r * 256 + eh * 64); const v4u* o2p = o1p + 16;
                const float lam = ms->lam; float o[64]; float ss = 0.f;
#pragma unroll
                for (int c8 = 0; c8 < 8; ++c8) { const v4u a1 = __builtin_nontemporal_load(o1p + c8), a2 = __builtin_nontemporal_load(o2p + c8);
#pragma unroll
                    for (int q = 0; q < 4; ++q) { const float x0 = __uint_as_float(a1[q] << 16) - lam * __uint_as_float(a2[q] << 16), x1 = __uint_as_float(a1[q] & 0xffff0000u) - lam * __uint_as_float(a2[q] & 0xffff0000u);
                        o[c8 * 8 + 2 * q] = x0; o[c8 * 8 + 2 * q + 1] = x1; ss += x0 * x0 + x1 * x1; } }
                ss = xsum32(ss);
                const float rs = rsqrtf(ss * (1.f / 128.f) + EPS) * (1.f - LAMBDA_INIT);
                const v4u* gp = (const v4u*)(proj1 + grow * B_IN + 3072 + h * 128 + eh * 64); const f32x4* sl = (const f32x4*)(subln + eh * 64);
                v4u* op = (v4u*)(og1 + grow * D + h * 128 + eh * 64);
#pragma unroll
                for (int c8 = 0; c8 < 8; ++c8) { const v4u gq = gp[c8]; const f32x4 s0 = sl[2 * c8], s1 = sl[2 * c8 + 1]; v4u w;
#pragma unroll
                    for (int q = 0; q < 4; ++q) { const float g0 = __uint_as_float(gq[q] << 16), g1 = __uint_as_float(gq[q] & 0xffff0000u);
                        const float sa = q < 2 ? s0[2 * q] : s1[2 * q - 4], sb = q < 2 ? s0[2 * q + 1] : s1[2 * q - 3];
                        w[q] = pk2(o[c8 * 8 + 2 * q] * rs * sa * siluf(g0), o[c8 * 8 + 2 * q + 1] * rs * sb * siluf(g1)); }
                    op[c8] = w; }
            }
        }
    } SEAM(PH_ATTN1);
    if (IN(PH_OUT1)) {
        CArgs* A = kargs(PH_OUT1); unsigned char* ws = A->ws;
        pg8::Gemm g{(const bf16*)(ws + WS_OG1), (const bf16*)(ws + WS_WOUT1), M, D, D, D, D, 0}; pg8::StaticOrder S; S.init(M, D, G, bx);
        pg8::Epi<pg8::EM_PLAIN> E{(bf16*)(ws + WS_Y1), D, nullptr, nullptr, 0};
        pg8::gemm_phase<pg8::Epi<pg8::EM_PLAIN>, pg8::StaticOrder, true, true>(lds + RING_OFF, g, S, E, wave);
    } SEAM(PH_OUT1);
    if (IN(PH_FINAL)) { CArgs* A = kargs(PH_FINAL); unsigned char* ws = A->ws;
        post_rows(A->out, (const bf16*)(ws + WS_Y1), A->in[I_POSTG] + D, (const float*)(ws + WS_MOD) + (size_t)NB * 3072, nullptr, nullptr, A->out, nullptr, gw, NGW, fresh_lane()); }
#undef IN
#undef SEAM
}

__device__ __forceinline__ float block_sum(float v, float* red) {
    for (int o = 32; o > 0; o >>= 1) v += __shfl_xor(v, o);
    __syncthreads(); if ((threadIdx.x & 63) == 0) red[threadIdx.x >> 6] = v; __syncthreads();
    return red[0] + red[1] + red[2] + red[3];
}
__device__ __forceinline__ unsigned fkey(float f) { unsigned u = __float_as_uint(f); return (u & 0x80000000u) ? ~u : (u | 0x80000000u); }
__global__ void __launch_bounds__(256) k_topk(const bf16_t* qq, const bf16_t* ki, const float* wi, unsigned* sel) {
    __shared__ float qs[512]; __shared__ unsigned keys[2048]; __shared__ unsigned cnts[256]; __shared__ unsigned words[64]; __shared__ float ws[8];
    int row = blockIdx.x, b = row / L, t = row % L, tid = threadIdx.x;
    for (int i = tid; i < 512; i += 256) qs[i] = bf2f(qq[(size_t)row * NQQ + i]);
    if (tid < 8) ws[tid] = wi[(size_t)row * 8 + tid];
    if (tid < 64) words[tid] = 0u;
    __syncthreads();
    for (int s = tid; s < L; s += 256) {
        unsigned kk = 0u;
        if (s <= t) { const bf16_t* kr = ki + ((size_t)b * L + s) * 64; float a0 = 0.f, a1 = 0.f, a2 = 0.f, a3 = 0.f, a4 = 0.f, a5 = 0.f, a6 = 0.f, a7 = 0.f;
            for (int d = 0; d < 64; ++d) { float kf = bf2f(kr[d]); a0 += qs[d] * kf; a1 += qs[64 + d] * kf; a2 += qs[128 + d] * kf; a3 += qs[192 + d] * kf;
                a4 += qs[256 + d] * kf; a5 += qs[320 + d] * kf; a6 += qs[384 + d] * kf; a7 += qs[448 + d] * kf; }
            float sc = ws[0] * fmaxf(a0, 0.f); sc += ws[1] * fmaxf(a1, 0.f); sc += ws[2] * fmaxf(a2, 0.f); sc += ws[3] * fmaxf(a3, 0.f);
            sc += ws[4] * fmaxf(a4, 0.f); sc += ws[5] * fmaxf(a5, 0.f); sc += ws[6] * fmaxf(a6, 0.f); sc += ws[7] * fmaxf(a7, 0.f);
            kk = fkey(sc); }
        keys[s] = kk;
    }
    __syncthreads();
    int nvalid = t + 1;
    if (nvalid <= TOPK) { for (int s = tid; s <= t; s += 256) atomicOr(&words[s >> 5], 1u << (s & 31)); }
    else {
        unsigned prefix = 0u;
        for (int bit = 31; bit >= 0; --bit) {
            unsigned cand = prefix | (1u << bit); unsigned c = 0;
            for (int i = 0; i < 8; ++i) c += keys[tid * 8 + i] >= cand;
            cnts[tid] = c; __syncthreads();
            for (int o = 128; o > 0; o >>= 1) { if (tid < o) cnts[tid] += cnts[tid + o]; __syncthreads(); }
            unsigned tot = cnts[0]; __syncthreads();
            if (tot >= (unsigned)TOPK) prefix = cand;
        }
        unsigned cg = 0, ce = 0; for (int i = 0; i < 8; ++i) { unsigned k = keys[tid * 8 + i]; cg += k > prefix; ce += k == prefix; }
        cnts[tid] = cg; __syncthreads();
        for (int o = 128; o > 0; o >>= 1) { if (tid < o) cnts[tid] += cnts[tid + o]; __syncthreads(); }
        unsigned ngt = cnts[0]; __syncthreads();
        cnts[tid] = ce; __syncthreads();
        if (tid == 0) { unsigned run = 0; for (int i = 0; i < 256; ++i) { unsigned v = cnts[i]; cnts[i] = run; run += v; } }
        __syncthreads();
        unsigned need = TOPK - ngt, rank = cnts[tid];
        for (int i = 0; i < 8; ++i) { int s = tid * 8 + i; unsigned k = keys[s]; bool take = k > prefix; if (k == prefix) { take = rank < need; ++rank; }
            if (take) atomicOr(&words[s >> 5], 1u << (s & 31)); }
    }
    __syncthreads();
    if (tid < 64) sel[(size_t)row * 64 + tid] = words[tid];
}
__global__ void __launch_bounds__(256) k_sparse(const bf16_t* qq, const bf16_t* ckv, const unsigned* sel, const Misc* ms, bf16_t* olat) {
    __shared__ float qa[16 * 128]; __shared__ int idx[256]; __shared__ float lg[16 * 256]; __shared__ int nsel_s;
    int row = blockIdx.x, b = row / L, t = row % L, tid = threadIdx.x;
    for (int i = tid; i < 2048; i += 256) qa[i] = bf2f(qq[(size_t)row * NQQ + 512 + i]);
    if (tid == 0) { int n = 0; for (int w = 0; w < 64; ++w) { unsigned v = sel[(size_t)row * 64 + w]; while (v) { int bpos = __ffs(v) - 1; v &= v - 1; if (n < 256) idx[n] = w * 32 + bpos; ++n; } } nsel_s = n < 256 ? n : 256; }
    __syncthreads();
    int ns = nsel_s;
    for (int p = tid; p < 16 * 256; p += 256) { int h = p >> 8, k = p & 255; float v = -INFINITY;
        if (k < ns) { const bf16_t* kr = ckv + ((size_t)b * L + idx[k]) * 128; float a = 0.f; for (int r = 0; r < 128; ++r) a += qa[h * 128 + r] * bf2f(kr[r]);
            int dd = t - idx[k]; if (dd > 127) dd = 127; v = a + ms->btab[dd * 16 + h] * LOG2E; }
        lg[p] = v; }
    __syncthreads();
    if (tid < 16) { float mx = -INFINITY; for (int k = 0; k < ns; ++k) mx = fmaxf(mx, lg[tid * 256 + k]); float s = 0.f;
        for (int k = 0; k < ns; ++k) { float e = exp2f(lg[tid * 256 + k] - mx); lg[tid * 256 + k] = e; s += e; } float inv = 1.f / s; for (int k = 0; k < ns; ++k) lg[tid * 256 + k] *= inv; }
    __syncthreads();
    for (int o = tid; o < 2048; o += 256) { int h = o >> 7, r = o & 127; float a = 0.f;
        for (int k = 0; k < ns; ++k) a += lg[h * 256 + k] * bf2f(ckv[((size_t)b * L + idx[k]) * 128 + r]);
        olat[(size_t)row * 2048 + o] = f2bf(a); }
}
__global__ void __launch_bounds__(256) k_diffattn(const bf16_t* proj, const Misc* ms, const float* subln, bf16_t* og) {
    __shared__ float q[2][64]; __shared__ float p[2][2048]; __shared__ float red[4]; __shared__ float part[2][128];
    int row = blockIdx.x, h = blockIdx.y, b = row / L, t = row % L, tid = threadIdx.x;
    if (tid < 128) q[tid >> 6][tid & 63] = bf2f(proj[(size_t)row * B_IN + (2 * h + (tid >> 6)) * 64 + (tid & 63)]);
    __syncthreads();
    float mx[2] = {-INFINITY, -INFINITY};
    for (int l = tid; l <= t; l += 256) { int dd = t - l; if (dd > 127) dd = 127;
        for (int j = 0; j < 2; ++j) { const bf16_t* kr = proj + ((size_t)b * L + l) * B_IN + 1024 + (2 * h + j) * 64; float a = 0.f;
            for (int d = 0; d < 64; ++d) a += q[j][d] * bf2f(kr[d]);
            a += ms->btab[dd * 16 + 2 * h + j] * LOG2E; p[j][l] = a; mx[j] = fmaxf(mx[j], a); } }
    float sm[2];
    for (int j = 0; j < 2; ++j) { float m = mx[j]; for (int o = 32; o > 0; o >>= 1) m = fmaxf(m, __shfl_xor(m, o));
        __syncthreads(); if ((tid & 63) == 0) red[tid >> 6] = m; __syncthreads(); m = fmaxf(fmaxf(red[0], red[1]), fmaxf(red[2], red[3]));
        float s = 0.f; for (int l = tid; l <= t; l += 256) { float e = exp2f(p[j][l] - m); p[j][l] = e; s += e; }
        sm[j] = block_sum(s, red); }
    __syncthreads();
    float lam = ms->lam, i0 = 1.f / sm[0], i1 = lam / sm[1];
    int e = tid & 127, half = tid >> 7; float a = 0.f;
    for (int l = half; l <= t; l += 2) a += (p[0][l] * i0 - p[1][l] * i1) * bf2f(proj[((size_t)b * L + l) * B_IN + 2048 + h * 128 + e]);
    part[half][e] = a; __syncthreads();
    float o = part[0][e] + part[1][e];
    float ss = block_sum(half == 0 ? o * o : 0.f, red);
    if (half == 0) { float v = o * rsqrtf(ss / 128.f + EPS) * subln[e] * (1.f - LAMBDA_INIT);
        float gte = bf2f(proj[(size_t)row * B_IN + 3072 + h * 128 + e]);
        og[(size_t)row * D + h * 128 + e] = f2bf(v * siluf(gte)); }
}


extern "C" void kernel_launch(void* const* d_in, const int* in_sizes, int n_in, void* d_out, int out_size, void* d_ws, size_t ws_size, hipStream_t stream) {
    (void)in_sizes; (void)out_size; (void)ws_size;
    static int grid = 0;
    if (grid == 0) {
        int dev = 0, cus = 0;
        if (n_in != N_IN || hipGetDevice(&dev) != hipSuccess || hipDeviceGetAttribute(&cus, hipDeviceAttributeMultiprocessorCount, dev) != hipSuccess) { grid = -1; return; }
        if (hipFuncSetAttribute((const void*)mk_fwd, hipFuncAttributeMaxDynamicSharedMemorySize, LDS_BYTES) != hipSuccess) { grid = -1; return; }
        grid = cus;
    }
    if (grid < 0) return;
    char* ws = (char*)d_ws;
    hipMemsetAsync(ws + WS_CTL, 0, CTL_ZERO_BYTES, stream);
    Args a{};
    for (int i = 0; i < N_IN; ++i) a.in[i] = (const float*)d_in[i];
    a.out = (float*)d_out; a.ws = (unsigned char*)d_ws;
    int li = 0;
    auto run = [&](int lo, int hi) { a.ph_lo = lo; a.ph_hi = hi; a.li = li++; hipLaunchKernelGGL(mk_fwd, dim3(grid), dim3(NWAVES * 64), LDS_BYTES, stream, a); };
    Misc* ms = (Misc*)(ws + WS_MISC);
    bf16_t *ckv = (bf16_t*)(ws + WS_CKV), *ki = (bf16_t*)(ws + WS_KI); float* wi = (float*)(ws + WS_WI); unsigned* sel = (unsigned*)(ws + WS_SEL);
    bf16_t *qq = (bf16_t*)(ws + WS_QQ), *olat = (bf16_t*)(ws + WS_OLAT), *proj1 = (bf16_t*)(ws + WS_PROJ1), *og1 = (bf16_t*)(ws + WS_OG1);
    run(PH_PRO, PH_FINAL + 1);
}
```

```cpp
#include <hip/hip_runtime.h>
#include <stdint.h>
#include <math.h>
#include <cstdio>
#include <hip/hip_bf16.h>

constexpr int NB = 8, L = 2048, D = 1024, M = NB * L;
constexpr int A_IN = 1480, A_INP = 1536, QR = 256, TOPK = 256;
constexpr int NQQ = 512 + 2048;
constexpr int B_IN = 4096, BH = 8;
constexpr float EPS = 1e-6f;
constexpr float LOG2E = 1.4426950408889634f;
constexpr float C2 = 0.125f * LOG2E;
constexpr float LAMBDA_INIT = 0.35550906759096934f;

constexpr size_t MiB = 1u << 20;
constexpr size_t WS_CTL = 0, CTL_ZERO_BYTES = 256 * 1024;
constexpr size_t WS_MOD = 512 * 1024;
constexpr size_t WS_MISC = 768 * 1024;
constexpr size_t WS_WIN0 = 1 * MiB;
constexpr size_t WS_WQ2 = 4 * MiB;
constexpr size_t WS_WUV = 6 * MiB;
constexpr size_t WS_WOUT0 = 7 * MiB;
constexpr size_t WS_WIN1 = 9 * MiB;
constexpr size_t WS_WOUT1 = 17 * MiB;
constexpr size_t WS_STATS = 19 * MiB;
constexpr size_t WS_CKV = 20 * MiB;
constexpr size_t WS_KI = 24 * MiB;
constexpr size_t WS_WI = 26 * MiB;
constexpr size_t WS_SEL = 28 * MiB;
constexpr size_t WS_H = 32 * MiB;
constexpr size_t WS_PROJ0 = 64 * MiB;
constexpr size_t WS_QQ = 112 * MiB;
constexpr size_t WS_OLAT = 192 * MiB;
constexpr size_t WS_OG0 = 112 * MiB;
constexpr size_t WS_Y0 = 144 * MiB;
constexpr size_t WS_PROJ1 = 64 * MiB;
constexpr size_t WS_OSCR = 192 * MiB;
constexpr size_t WS_OG1 = 32 * MiB;
constexpr size_t WS_Y1 = 64 * MiB;
constexpr int CW_BAR = 4096;

struct Misc { float lam; int pad[31]; int lut[128]; float btab[128 * 16]; };

enum { I_X = 0, I_C, I_RELB, I_MODW, I_MODB, I_PREG, I_POSTG, I_AWIN, I_AQN, I_AKVN, I_AKIN, I_AWUQ, I_AWQIDX, I_AWUK, I_AWUV, I_AWOUT,
       I_BWIN, I_BLQ1, I_BLK1, I_BLQ2, I_BLK2, I_BSUBLN, I_BWOUT, N_IN };

__device__ __forceinline__ float siluf(float v) { return v * __builtin_amdgcn_rcpf(1.f + __builtin_amdgcn_exp2f(-1.4426950408889634f * v)); }
__device__ __forceinline__ float bf2f(unsigned short v) { return __uint_as_float((unsigned)v << 16); }
__device__ __forceinline__ float xsum32(float v) { auto r = __builtin_amdgcn_permlane32_swap(__float_as_uint(v), __float_as_uint(v), false, false); return __uint_as_float(r[0]) + __uint_as_float(r[1]); }
__device__ __forceinline__ float xsum16(float v) { auto r = __builtin_amdgcn_permlane16_swap(__float_as_uint(v), __float_as_uint(v), false, false); return __uint_as_float(r[0]) + __uint_as_float(r[1]); }
template <int CTRL> __device__ __forceinline__ float dpp_f(float v) { return __uint_as_float((unsigned)__builtin_amdgcn_update_dpp(0, (int)__float_as_uint(v), CTRL, 0xF, 0xF, true)); }
__device__ __forceinline__ float wave_sum_all(float v) {
    v += dpp_f<0xB1>(v);
    v += dpp_f<0x4E>(v);
    v += dpp_f<0x141>(v);
    v += dpp_f<0x140>(v);
    v = xsum16(v); return xsum32(v);
}
typedef unsigned short bf16_t;
#define GAS __attribute__((address_space(1)))
#define LAS __attribute__((address_space(3)))
typedef unsigned short bf16;
typedef unsigned v4u __attribute__((ext_vector_type(4)));
typedef float f32x4 __attribute__((ext_vector_type(4)));
typedef short bf16x8 __attribute__((ext_vector_type(8)));
typedef GAS unsigned gu32;
typedef GAS unsigned long long gu64;
#define RLX_AGENT __ATOMIC_RELAXED, __HIP_MEMORY_SCOPE_AGENT
#define LDS_WAIT() asm volatile("s_waitcnt lgkmcnt(0)" ::: "memory")
#define VM_WAIT() asm volatile("s_waitcnt vmcnt(0)" ::: "memory")
__device__ __forceinline__ unsigned long long rt() { return __builtin_amdgcn_s_memrealtime(); }
__device__ __forceinline__ unsigned f2bf(float f) { unsigned u = __builtin_bit_cast(unsigned, f); return (u + 0x7fffu + ((u >> 16) & 1u)) >> 16; }
__device__ __forceinline__ unsigned pk2(float lo, float hi) { return f2bf(lo) | (f2bf(hi) << 16); }

#define XB_TMO      128
#define XB_XCNT(j)  (256  + 64 * (j))
#define XB_XSUB(j)  (1280 + 64 * (j))
#define XB_XGEN(j)  (2304 + 64 * (j))
#define XB_TOP      3328
#define XB_TOPGEN   3392
#define XCD_BAR_WORDS 3456
#define XB_SPIN_CAP (1u << 18)

__device__ __forceinline__ unsigned xb_ld(unsigned* p)              { return __hip_atomic_load(p, __ATOMIC_RELAXED, __HIP_MEMORY_SCOPE_AGENT); }
__device__ __forceinline__ unsigned xb_add(unsigned* p, unsigned v) { return __hip_atomic_fetch_add(p, v, __ATOMIC_RELAXED, __HIP_MEMORY_SCOPE_AGENT); }
__device__ __forceinline__ unsigned xb_xcc_id() { return (unsigned)__builtin_amdgcn_s_getreg((3 << 11) | 20) & 0xFu; }
#define XB_SPIN(cond, bar) do { unsigned _sp = 0; while (cond) { __builtin_amdgcn_s_sleep(1); \
    if ((++_sp & 255u) == 0u) { if (xb_ld(&(bar)[XB_TMO])) break; if (_sp > XB_SPIN_CAP) { atomicAdd(&(bar)[XB_TMO], 1u); break; } } } } while (0)

__device__ __forceinline__ int lane_now(int dep) { int l; asm volatile("v_mbcnt_lo_u32_b32 %0, -1, 0\n\tv_mbcnt_hi_u32_b32 %0, -1, %0 ; dep %1" : "=v"(l) : "s"(dep)); return l; }
struct XcdBarrier {
    unsigned* bar; unsigned x; int wave;
    volatile LAS unsigned* st;
};

__device__ __forceinline__ XcdBarrier xcd_barrier_post(unsigned* bar, volatile LAS unsigned* st, int wave) {
    XcdBarrier b; b.bar = bar; b.x = xb_xcc_id(); b.st = st; b.wave = wave;
    if (wave == 0 && lane_now(0) == 0) (void)xb_add(&bar[XB_XCNT(b.x)], 1u);
    return b;
}
__device__ __forceinline__ void xcd_barrier_complete(unsigned* bar, unsigned x, unsigned& nloc, unsigned& nx) {
    const unsigned G = gridDim.x * gridDim.y * gridDim.z;
    unsigned sum, cnt, mine, sp = 0u;
    for (;;) {
        sum = 0u; cnt = 0u; mine = 0u;
#pragma unroll
        for (unsigned j = 0; j < 16; ++j) { const unsigned c = xb_ld(&bar[XB_XCNT(j)]); sum += c; cnt += (c > 0u) ? 1u : 0u; mine = (j == x) ? c : mine; }
        if (sum == G) break;
        __builtin_amdgcn_s_sleep(1);
        if ((++sp & 255u) == 0u) { if (xb_ld(&bar[XB_TMO])) break; if (sp > XB_SPIN_CAP) { atomicAdd(&bar[XB_TMO], 1u); break; } }
    }
    nloc = mine > 0u ? mine : 1u; nx = cnt > 0u ? cnt : 1u;
}

__device__ __forceinline__ void xcd_barrier(const XcdBarrier& b) {
    asm volatile("s_waitcnt vmcnt(0)" ::: "memory");
    __syncthreads();
    if (b.wave == 0 && lane_now(1) == 0) {
        unsigned* bar = b.bar;
        __builtin_amdgcn_s_waitcnt(0);
        unsigned nloc = b.st[0], nx = b.st[1];
        if (nloc == 0u) { xcd_barrier_complete(bar, b.x, nloc, nx); b.st[0] = nloc; b.st[1] = nx; }
        const unsigned old = xb_add(&bar[XB_XSUB(b.x)], 1u);
        const unsigned gen = old / nloc;
        if (old + 1u == (gen + 1u) * nloc) {
            __builtin_amdgcn_fence(__ATOMIC_RELEASE, "agent");
            asm volatile("s_waitcnt vmcnt(0)" ::: "memory");
            const unsigned og = xb_add(&bar[XB_TOP], 1u);
            const unsigned tg = og / nx;
            if (og + 1u == (tg + 1u) * nx) xb_add(&bar[XB_TOPGEN], 1u);
            else XB_SPIN(xb_ld(&bar[XB_TOPGEN]) == tg, bar);
            __builtin_amdgcn_fence(__ATOMIC_ACQUIRE, "agent");
            xb_add(&bar[XB_XGEN(b.x)], 1u);
            asm volatile("s_waitcnt vmcnt(0)" ::: "memory");
        } else {
            XB_SPIN(xb_ld(&bar[XB_XGEN(b.x)]) == gen, bar);
            __builtin_amdgcn_fence(__ATOMIC_ACQUIRE, "agent");
            asm volatile("s_waitcnt vmcnt(0)" ::: "memory");
        }
    }
    __syncthreads();
}
namespace pg8 {
#define PG8_LAS __attribute__((address_space(3)))
typedef unsigned short bf16_t;
typedef short bf16x8 __attribute__((ext_vector_type(8)));
typedef float f32x4 __attribute__((ext_vector_type(4)));
typedef unsigned u32x4 __attribute__((ext_vector_type(4)));
constexpr int BM = 256, BK = 64, HALF = 128, HTB = HALF * BK * 2  , STAGE_BYTES = 8 * HTB, NXCD = 8, WGM = 8;

__host__ __device__ __forceinline__ int lds_byte(int r, int c) { const int st = (r >> 4) * 2 + (c >> 5), rr = r & 15, cc = c & 31, ob = rr * 64 + cc * 2; return st * 1024 + (ob ^ (((ob >> 9) & 1) << 5)); }
__host__ __device__ __forceinline__ void stage_rc(int b, int& R, int& C) { const int st = b / 1024, sb = b % 1024, swz = sb ^ (((sb >> 9) & 1) << 5); R = (st >> 1) * 16 + swz / 64; C = (st & 1) * 32 + (swz % 64) / 2; }
__host__ __device__ __forceinline__ int perm32(int rho) { const int n = rho >> 4, i = rho & 15; return 8 * (i >> 2) + 4 * n + (i & 3); }

struct Unit { int pm, pn; };
struct Gemm { const bf16_t* A; const bf16_t* Bt; int M, N, K, lda, ldb, a_koff_pn; };

struct StaticOrder {
    int nM, nN, nwg, G, c;
    __host__ __device__ void init(int M, int N, int G_, int c_) { nM = M / BM; nN = N / BM; nwg = nM * nN; G = G_; c = c_; }
    __host__ __device__ bool next(int i, Unit& u) const {
        const long L = (long)i * G + c; if (L >= nwg) return false;
        int wgid = (int)L; { const int q = nwg / NXCD, r = nwg % NXCD, xcd = wgid % NXCD, off = wgid / NXCD; wgid = (xcd < r ? xcd * (q + 1) : r * (q + 1) + (xcd - r) * q) + off; }
        const int nig = WGM * nN, gid = wgid / nig, fm = gid * WGM, gsz = (nM - fm) < WGM ? (nM - fm) : WGM;
        u.pm = fm + ((wgid % nig) % gsz); u.pn = (wgid % nig) / gsz; return true;
    }
    __device__ __forceinline__ void a_ready(const Unit&) const {}
    __device__ __forceinline__ void done(const Unit&) const {}
};
__device__ __forceinline__ unsigned cvt_pk_bf16(float lo, float hi) { unsigned r; asm volatile("v_cvt_pk_bf16_f32 %0, %1, %2" : "=v"(r) : "v"(lo), "v"(hi)); return r; }
typedef float f32x2 __attribute__((ext_vector_type(2)));
enum { EM_PLAIN = 0, EM_PROJ0 = 1, EM_ROWSCALE = 2, EM_UVGATE = 3, EM_PROJ1 = 4 };
template <int MODE> struct Epi {
    static constexpr bool PERM = true, AFTER_DRAIN = false;
    bf16_t* O; int ldc; float* stats; const bf16_t* gate; int ldg;
    __device__ __forceinline__ void operator()(const f32x4 (&acc)[2][2][4][2], const Unit& u, int wr, int wc, int fr, int fq) const {
        const int row0 = u.pm * BM + wr * 64 + fr, col0 = u.pn * BM + wc * 32 + 8 * fq;
#pragma unroll
        for (int ai = 0; ai < 2; ++ai)
#pragma unroll
            for (int m = 0; m < 4; ++m) {
                const int row = row0 + ai * HALF + m * 16;
                float rs = 1.f;
                if (MODE == EM_ROWSCALE) { const f32x4 s = *(const f32x4*)(stats + (size_t)row * 16); rs = rsqrtf(((s[0] + s[1]) + (s[2] + s[3])) * (1.f / 256.f) + 1e-6f); }
                if (MODE == EM_PROJ1) rs = (u.pn < 4) ? (0.125f * 1.4426950408889634f) : 1.f;
                float ss[2] = {0.f, 0.f};
#pragma unroll
                for (int bj = 0; bj < 2; ++bj) {
                    f32x4 v0 = acc[ai][bj][m][0] * rs, v1 = acc[ai][bj][m][1] * rs;
                    if (MODE == EM_PROJ0) ss[bj] = ((v0[0] * v0[0] + v0[1] * v0[1]) + (v0[2] * v0[2] + v0[3] * v0[3])) + ((v1[0] * v1[0] + v1[1] * v1[1]) + (v1[2] * v1[2] + v1[3] * v1[3]));
                    if (MODE == EM_UVGATE) { const u32x4 gw = *(const u32x4*)(gate + (size_t)row * ldg + col0 + bj * HALF);
#pragma unroll
                        for (int q = 0; q < 4; ++q) { const float g0 = __uint_as_float(gw[q] << 16), g1 = __uint_as_float(gw[q] & 0xffff0000u);
                            const float s0 = g0 * __builtin_amdgcn_rcpf(1.f + __builtin_amdgcn_exp2f(-1.4426950408889634f * g0)), s1 = g1 * __builtin_amdgcn_rcpf(1.f + __builtin_amdgcn_exp2f(-1.4426950408889634f * g1));
                            if (q < 2) { v0[2 * q] *= s0; v0[2 * q + 1] *= s1; } else { v1[2 * q - 4] *= s0; v1[2 * q - 3] *= s1; } } }
                    u32x4 w; w.x = cvt_pk_bf16(v0[0], v0[1]); w.y = cvt_pk_bf16(v0[2], v0[3]); w.z = cvt_pk_bf16(v1[0], v1[1]); w.w = cvt_pk_bf16(v1[2], v1[3]);
                    *(u32x4*)(O + (size_t)row * ldc + col0 + bj * HALF) = w; }
                if (MODE == EM_PROJ0) { if (u.pn < 2) {
                    float a = ss[0], b = ss[1];
                    a = xsum32(xsum16(a)); b = xsum32(xsum16(b));
                    if (fq == 0) { if (u.pn == 0) stats[(size_t)row * 16 + wc] = a + b; else { stats[(size_t)row * 16 + 4 + wc] = a; if (wc < 2) stats[(size_t)row * 16 + 8 + wc] = b; } } } }
            }
    }
};

template <class Epi, class Sched, bool ALIGN_EPI = false, bool SP2 = false>
__device__ __forceinline__ void gemm_phase(PG8_LAS unsigned char* lds, const Gemm g, const Sched& S, const Epi& E, const int wid) {
    const int lane = lane_now(g.N), tid = wid * 64 + lane, wr = wid >> 2, wc = wid & 3, fr = lane & 15, fq = lane >> 4;
    const int K = g.K, nt = K / BK;
    unsigned voffA[2], voffB[2];
#pragma unroll
    for (int i = 0; i < 2; ++i) { int R, C; stage_rc(tid * 16 + i * 8192, R, C); const int Rb = Epi::PERM ? ((R & ~31) + perm32(R & 31)) : R;
        voffA[i] = (unsigned)(R * g.lda + C) * 2u; voffB[i] = (unsigned)(Rb * g.ldb + C) * 2u; }
    const size_t kstep = (size_t)(BK * 2);
    const size_t hstepA = (size_t)HALF * g.lda * 2, hstepB = (size_t)HALF * g.ldb * 2;
    const size_t tstepA = 2 * hstepA, tstepB = 2 * hstepB, aoffpn = (size_t)g.a_koff_pn * 2;
    const unsigned ldsw = (unsigned)wid * 1024u;
    const int aoff = lds_byte(wr * 64 + fr, fq * 8), boff = lds_byte(wc * 32 + fr, fq * 8);
#define PG8_SA(b, h) (((b) * 2 + (h)) * HTB)
#define PG8_SB(b, h) ((4 + (b) * 2 + (h)) * HTB)
#define PG8_STAGE(bufoff, gbase, voff) do { _Pragma("unroll") for (int _i = 0; _i < 2; ++_i) \
        __builtin_amdgcn_global_load_lds((const unsigned*)((const char*)(gbase) + (voff)[_i]), (PG8_LAS unsigned*)(lds + (bufoff) + ldsw + _i * 8192), 16, 0, 0); } while (0)
#define PG8_LDA(dst, b, h) do { _Pragma("unroll") for (int m = 0; m < 4; ++m) _Pragma("unroll") for (int k = 0; k < 2; ++k) dst[m][k] = *(const PG8_LAS bf16x8*)(lds + PG8_SA(b, h) + aoff + m * 2048 + k * 1024); } while (0)
#define PG8_LDB(dst, b, h) do { _Pragma("unroll") for (int n = 0; n < 2; ++n) _Pragma("unroll") for (int k = 0; k < 2; ++k) dst[n][k] = *(const PG8_LAS bf16x8*)(lds + PG8_SB(b, h) + boff + n * 2048 + k * 1024); } while (0)
#define PG8_MMA(ai, bj, At, Bt) do { __builtin_amdgcn_s_setprio(1); _Pragma("unroll") for (int m = 0; m < 4; ++m) _Pragma("unroll") for (int n = 0; n < 2; ++n) _Pragma("unroll") for (int k = 0; k < 2; ++k) \
        acc[ai][bj][m][n] = __builtin_amdgcn_mfma_f32_16x16x32_bf16(Bt[n][k], At[m][k], acc[ai][bj][m][n], 0, 0, 0); __builtin_amdgcn_s_setprio(0); } while (0)
#define PG8_WAIT_V(n) asm volatile("s_waitcnt vmcnt(" #n ")" ::: "memory")
#define PG8_WAIT_L(n) asm volatile("s_waitcnt lgkmcnt(" #n ")" ::: "memory")
#define PG8_BAR __builtin_amdgcn_s_barrier()
#define PG8_SCHED __builtin_amdgcn_sched_barrier(0)
    Unit cur, nxt; int ui = 0;
    if (!S.next(0, cur)) return;
    f32x4 acc[2][2][4][2];
#pragma unroll
    for (int a = 0; a < 2; ++a)
#pragma unroll
        for (int b = 0; b < 2; ++b)
#pragma unroll
            for (int m = 0; m < 4; ++m)
#pragma unroll
                for (int n = 0; n < 2; ++n) acc[a][b][m][n] = (f32x4){0.f, 0.f, 0.f, 0.f};
    bf16x8 At[4][2], B0[2][2], B1[2][2];
    const char* cA = (const char*)g.A + (size_t)cur.pm * tstepA + (size_t)cur.pn * aoffpn; const char* cB = (const char*)g.Bt + (size_t)cur.pn * tstepB;
    S.a_ready(cur);
    if constexpr (SP2) {
        PG8_STAGE(PG8_SB(0, 0), cB, voffB); PG8_STAGE(PG8_SB(0, 1), cB + hstepB, voffB); PG8_STAGE(PG8_SA(0, 0), cA, voffA); PG8_STAGE(PG8_SA(0, 1), cA + hstepA, voffA);
        if (wr == 1) PG8_BAR;
        PG8_WAIT_V(2); PG8_BAR;
        PG8_STAGE(PG8_SB(1, 0), cB + kstep, voffB); PG8_STAGE(PG8_SA(1, 0), cA + kstep, voffA); PG8_STAGE(PG8_SB(1, 1), cB + hstepB + kstep, voffB);
        PG8_WAIT_V(6); PG8_BAR;
    } else {
        PG8_STAGE(PG8_SB(0, 0), cB, voffB); PG8_STAGE(PG8_SA(0, 0), cA, voffA); PG8_STAGE(PG8_SB(0, 1), cB + hstepB, voffB); PG8_STAGE(PG8_SA(0, 1), cA + hstepA, voffA);
        if (wr == 1) PG8_BAR;
        PG8_WAIT_V(4); PG8_BAR;
        PG8_STAGE(PG8_SB(1, 0), cB + kstep, voffB); PG8_STAGE(PG8_SA(1, 0), cA + kstep, voffA); PG8_STAGE(PG8_SB(1, 1), cB + hstepB + kstep, voffB);
        PG8_WAIT_V(6); PG8_BAR;
    }
    for (;;) {
        const bool has_next = S.next(ui + 1, nxt);
        const char* nA = has_next ? (const char*)g.A + (size_t)nxt.pm * tstepA + (size_t)nxt.pn * aoffpn : cA; const char* nB = has_next ? (const char*)g.Bt + (size_t)nxt.pn * tstepB : cB;
        for (int t = 0; t < nt; t += 2) {
            const bool last = (t == nt - 2);
            const char* a1 = cA + (size_t)(t + 1) * kstep;
            const char* a2 = last ? nA : cA + (size_t)(t + 2) * kstep; const char* b2 = last ? nB : cB + (size_t)(t + 2) * kstep;
            const char* a3 = a2 + kstep; const char* b3 = b2 + kstep;
            if (last && has_next) S.a_ready(nxt);
            if constexpr (SP2) {
            PG8_LDB(B0, 0, 0); PG8_LDB(B1, 0, 1); PG8_SCHED; PG8_LDA(At, 0, 0); PG8_STAGE(PG8_SA(1, 1), a1 + hstepA, voffA);
            PG8_WAIT_V(8); PG8_WAIT_L(0); PG8_BAR; PG8_MMA(0, 0, At, B0); PG8_MMA(0, 1, At, B1); PG8_BAR; PG8_SCHED;
            PG8_LDA(At, 0, 1); PG8_STAGE(PG8_SB(0, 0), b2, voffB); PG8_STAGE(PG8_SB(0, 1), b2 + hstepB, voffB); PG8_STAGE(PG8_SA(0, 0), a2, voffA);
            PG8_WAIT_V(8); PG8_WAIT_L(0); PG8_BAR; PG8_MMA(1, 0, At, B0); PG8_MMA(1, 1, At, B1); PG8_BAR; PG8_SCHED;
            PG8_LDB(B0, 1, 0); PG8_LDB(B1, 1, 1); PG8_SCHED; PG8_LDA(At, 1, 0); PG8_STAGE(PG8_SA(0, 1), a2 + hstepA, voffA);
            PG8_WAIT_V(8); PG8_WAIT_L(0); PG8_BAR; PG8_MMA(0, 0, At, B0); PG8_MMA(0, 1, At, B1); PG8_BAR; PG8_SCHED;
            PG8_LDA(At, 1, 1); PG8_STAGE(PG8_SB(1, 0), b3, voffB); PG8_STAGE(PG8_SB(1, 1), b3 + hstepB, voffB); PG8_STAGE(PG8_SA(1, 0), a3, voffA);
            PG8_WAIT_V(8); PG8_WAIT_L(0); PG8_BAR; PG8_MMA(1, 0, At, B0); PG8_MMA(1, 1, At, B1); PG8_BAR; PG8_SCHED;
            } else {
            PG8_LDB(B0, 0, 0); PG8_SCHED; PG8_LDA(At, 0, 0); PG8_STAGE(PG8_SA(1, 1), a1 + hstepA, voffA);
            PG8_WAIT_L(8); PG8_BAR; PG8_WAIT_L(0); PG8_MMA(0, 0, At, B0); PG8_BAR; PG8_SCHED;
            PG8_LDB(B1, 0, 1); PG8_STAGE(PG8_SB(0, 0), b2, voffB);
            PG8_BAR; PG8_WAIT_L(0); PG8_MMA(0, 1, At, B1); PG8_BAR;
            PG8_LDA(At, 0, 1); PG8_STAGE(PG8_SA(0, 0), a2, voffA);
            PG8_BAR; PG8_WAIT_L(0); PG8_MMA(1, 0, At, B0); PG8_BAR; PG8_SCHED;
            PG8_STAGE(PG8_SB(0, 1), b2 + hstepB, voffB);
            PG8_WAIT_V(6); PG8_BAR; PG8_MMA(1, 1, At, B1); PG8_BAR;
            PG8_LDB(B0, 1, 0); PG8_SCHED; PG8_LDA(At, 1, 0); PG8_STAGE(PG8_SA(0, 1), a2 + hstepA, voffA);
            PG8_WAIT_L(8); PG8_BAR; PG8_WAIT_L(0); PG8_MMA(0, 0, At, B0); PG8_BAR; PG8_SCHED;
            PG8_LDB(B1, 1, 1); PG8_STAGE(PG8_SB(1, 0), b3, voffB);
            PG8_BAR; PG8_WAIT_L(0); PG8_MMA(0, 1, At, B1); PG8_BAR;
            PG8_LDA(At, 1, 1); PG8_STAGE(PG8_SA(1, 0), a3, voffA);
            PG8_BAR; PG8_WAIT_L(0); PG8_MMA(1, 0, At, B0); PG8_BAR; PG8_SCHED;
            PG8_STAGE(PG8_SB(1, 1), b3 + hstepB, voffB);
            PG8_WAIT_V(6); PG8_BAR; PG8_MMA(1, 1, At, B1); PG8_BAR;
            }
        }
        if constexpr (ALIGN_EPI) { if (wr == 0) PG8_BAR; }
        if constexpr (!Epi::AFTER_DRAIN) { E(acc, cur, wr, wc, fr, fq); S.done(cur); }
        if (!has_next) break;
#pragma unroll
        for (int a = 0; a < 2; ++a)
#pragma unroll
            for (int b = 0; b < 2; ++b)
#pragma unroll
                for (int m = 0; m < 4; ++m)
#pragma unroll
                    for (int n = 0; n < 2; ++n) acc[a][b][m][n] = (f32x4){0.f, 0.f, 0.f, 0.f};
        cur = nxt; cA = nA; cB = nB; ++ui;
        if constexpr (ALIGN_EPI) { if (wr == 1) PG8_BAR; }
    }
    PG8_WAIT_V(0);
    if constexpr (!ALIGN_EPI) { if (wr == 0) PG8_BAR; }
    PG8_BAR;
    if constexpr (Epi::AFTER_DRAIN) { E.fused(acc, cur, wr, wc, fr, fq, lds, wid, lane); S.done(cur); }
#undef PG8_SA
#undef PG8_SB
#undef PG8_STAGE
#undef PG8_LDA
#undef PG8_LDB
#undef PG8_MMA
#undef PG8_WAIT_V
#undef PG8_WAIT_L
#undef PG8_BAR
#undef PG8_SCHED
}
}
namespace attn_body {
using bf16=__hip_bfloat16;
using bf16x8=__attribute__((ext_vector_type(8)))short;
using s16x4=__attribute__((ext_vector_type(4)))short;
using f32x16=__attribute__((ext_vector_type(16)))float;
using u32x4=__attribute__((ext_vector_type(4)))unsigned;
constexpr int SEQ=2048,D=64,DM=4096,OPITCH=256;
constexpr int NW=8,QBLK=32,QB=QBLK*NW,KVBLK=64,NQB=SEQ/QB;
constexpr int ATTN_UNIT_ROWS=QB;
__device__ __forceinline__ int crow(int r,int hi){return (r&3)+8*(r>>2)+4*hi;}
#define SBAR() __builtin_amdgcn_sched_barrier(0)
__device__ __forceinline__ void cmask(f32x16&p0,f32x16&p1,int jb,int qrel,int hi){
  const float NEG=-INFINITY; int kb=64*jb+4*hi;
  #pragma unroll
  for(int r=0;r<16;++r){int kv=kb+(r&3)+8*(r>>2); if(kv>qrel)p0[r]=NEG; if(kv+32>qrel)p1[r]=NEG;}
}

constexpr int NSLOT=3, SLOTB=8192;
constexpr int LDS_K=0, LDS_V=NSLOT*SLOTB, LDS_WS=2*NSLOT*SLOTB, LDS_OST=LDS_WS+NW*64*4, LDS_BT=LDS_OST+NW*4096, BT_N=704, LDS_BYTES=LDS_BT+BT_N*4;
constexpr float C2=0.125f*1.4426950408889634f;
__device__ __forceinline__ void glds16(const void*gsrc,unsigned lds_dst){unsigned keep;
  asm volatile("s_mov_b32 %0, m0\n\ts_mov_b32 m0, %2\n\ts_nop 0\n\tglobal_load_lds_dwordx4 %1, off\n\ts_mov_b32 m0, %0":"=&s"(keep):"v"(gsrc),"s"(lds_dst):"memory");}
__device__ __forceinline__ float max3f(float a,float b,float c){float r;asm("v_max3_f32 %0, %1, %2, %3":"=v"(r):"v"(a),"v"(b),"v"(c));return r;}
__device__ __forceinline__ float max2f(float a,float b){float r;asm("v_max_f32_e32 %0, %1, %2":"=v"(r):"v"(a),"v"(b));return r;}
__device__ __forceinline__ float fadd_s(float a,float b){float r;asm("v_add_f32_e32 %0, %1, %2":"=v"(r):"v"(a),"v"(b));return r;}
__device__ __forceinline__ float fsub_s(float a,float b){float r;asm("v_sub_f32_e32 %0, %1, %2":"=v"(r):"v"(a),"v"(b));return r;}
typedef float f32x2_t __attribute__((ext_vector_type(2))); typedef __bf16 bf16x2_t __attribute__((ext_vector_type(2)));
__device__ __forceinline__ unsigned cvtpk_s(float lo,float hi){f32x2_t v={lo,hi};bf16x2_t b=__builtin_convertvector(v,bf16x2_t);return __builtin_bit_cast(unsigned,b);}
#define WAIT_BAR(N) asm volatile("s_waitcnt vmcnt(" #N ") lgkmcnt(0)\n\ts_barrier":::"memory")

__device__ __forceinline__ void qkt(f32x16&p0,f32x16&p1,const char*Kslot,const bf16x8*qr,int r32,int hi){
  const char*kb=Kslot+hi*1024+r32*16;
  #pragma unroll
  for(int d0=0;d0<4;++d0){
    const bf16x8 b0=*reinterpret_cast<const bf16x8*>(kb+d0*2048);
    const bf16x8 b1=*reinterpret_cast<const bf16x8*>(kb+d0*2048+512);
    if(d0==0){p0=__builtin_amdgcn_mfma_f32_32x32x16_bf16(b0,qr[0],f32x16{},0,0,0);p1=__builtin_amdgcn_mfma_f32_32x32x16_bf16(b1,qr[0],f32x16{},0,0,0);}
    else{p0=__builtin_amdgcn_mfma_f32_32x32x16_bf16(b0,qr[d0],p0,0,0,0);p1=__builtin_amdgcn_mfma_f32_32x32x16_bf16(b1,qr[d0],p1,0,0,0);}}
}
typedef __attribute__((address_space(3))) const char* lds_cptr;
typedef short v4i16_t __attribute__((ext_vector_type(4)));
__device__ __forceinline__ void kload8(bf16x8*kf,lds_cptr kp){
  kf[0]=*(const __attribute__((address_space(3))) bf16x8*)(kp);      kf[1]=*(const __attribute__((address_space(3))) bf16x8*)(kp+512);
  kf[2]=*(const __attribute__((address_space(3))) bf16x8*)(kp+2048); kf[3]=*(const __attribute__((address_space(3))) bf16x8*)(kp+2560);
  kf[4]=*(const __attribute__((address_space(3))) bf16x8*)(kp+4096); kf[5]=*(const __attribute__((address_space(3))) bf16x8*)(kp+4608);
  kf[6]=*(const __attribute__((address_space(3))) bf16x8*)(kp+6144); kf[7]=*(const __attribute__((address_space(3))) bf16x8*)(kp+6656);
}
__device__ __forceinline__ void kload2(bf16x8*kf,lds_cptr kp,int j){ kf[2*j]=*(const __attribute__((address_space(3))) bf16x8*)(kp+j*2048); kf[2*j+1]=*(const __attribute__((address_space(3))) bf16x8*)(kp+j*2048+512); }
__device__ __forceinline__ s16x4 vtr(lds_cptr p){ return __builtin_bit_cast(s16x4,__builtin_amdgcn_ds_read_tr16_b64_v4i16((__attribute__((address_space(3))) v4i16_t*)p)); }
__device__ __forceinline__ float rowmax(const f32x16&p0,const f32x16&p1){
  float a=max3f(p0[0],p0[1],p1[0]),b=max3f(p0[2],p0[3],p1[1]);a=max3f(a,p1[2],p1[3]);
  #pragma unroll
  for(int r=4;r<16;r+=4){a=max3f(a,p0[r],p0[r+1]);b=max3f(b,p0[r+2],p0[r+3]);a=max3f(a,p1[r],p1[r+1]);b=max3f(b,p1[r+2],p1[r+3]);}
  const float m=max2f(a,b);
  auto rr=__builtin_amdgcn_permlane32_swap(__float_as_uint(m),__float_as_uint(m),false,false);
  return max2f(__uint_as_float(rr[0]),__uint_as_float(rr[1]));
}
__device__ __forceinline__ void pv(f32x16*o,int vb,bf16x8 pa0,bf16x8 pa1,bf16x8 pa2,bf16x8 pa3){
  #pragma unroll
  for(int d0=0;d0<2;++d0){s16x4 lo[4],hi[4];
    #pragma unroll
    for(int ks=0;ks<4;++ks){
      asm volatile("ds_read_b64_tr_b16 %0,%1 offset:%c2":"=&v"(lo[ks]):"v"(vb),"i"(d0*4096+ks*1024):"memory");
      asm volatile("ds_read_b64_tr_b16 %0,%1 offset:%c2":"=&v"(hi[ks]):"v"(vb),"i"(d0*4096+ks*1024+512):"memory");}
    asm volatile("s_waitcnt lgkmcnt(0)":::"memory");SBAR();
    #define PK(k) (bf16x8){lo[k][0],lo[k][1],lo[k][2],lo[k][3],hi[k][0],hi[k][1],hi[k][2],hi[k][3]}
    o[d0]=__builtin_amdgcn_mfma_f32_32x32x16_bf16(pa0,PK(0),o[d0],0,0,0);
    o[d0]=__builtin_amdgcn_mfma_f32_32x32x16_bf16(pa1,PK(1),o[d0],0,0,0);
    o[d0]=__builtin_amdgcn_mfma_f32_32x32x16_bf16(pa2,PK(2),o[d0],0,0,0);
    o[d0]=__builtin_amdgcn_mfma_f32_32x32x16_bf16(pa3,PK(3),o[d0],0,0,0);
    #undef PK
  }
}

#ifndef ATTN_STORE16
#define ATTN_STORE16(p,v) (*(u32x4*)(p)=(v))
#endif
template<int THRL> __device__ __forceinline__ void attn_unit(const int wid,int b,int qb,const bf16*Qc,const bf16*__restrict__ Kc,const bf16*__restrict__ Vc,bf16*Oc,const float*btabm,char*shm){
  int lane; asm volatile("v_mbcnt_lo_u32_b32 %0, -1, 0\n\tv_mbcnt_hi_u32_b32 %0, -1, %0 ; dep %1":"=v"(lane):"s"(qb));
  const int tid=wid*64+lane,r32=lane&31,hi=lane>>5;
  const long rowbase=(long)b*SEQ; const int q0=qb*QB;
  const bf16*Qw=Qc+(rowbase+q0+wid*QBLK)*DM;
  const bf16*Kh=Kc+rowbase*DM,*Vh=Vc+rowbase*DM;
  const unsigned lds0=(unsigned)(uintptr_t)shm;
  float*wsf=(float*)(shm+LDS_WS)+wid*64;
  const float b31n=btabm[127*16]; const float b31l=b31n*1.4426950408889634f;
  { float*R=(float*)(shm+LDS_BT); for(int j=tid;j<BT_N;j+=NW*64){ int d=447-j; float v=0.f; if(d>=0&&d<127) v=(btabm[d*16]-b31n)*1.4426950408889634f; R[j]=v; } }
  const bf16*ksrc=Kh+(long)lane*DM+wid*8;
  const bf16*vsrc=Vh+(long)(16*(wid&3)+(lane>>2))*DM+(wid>>2)*32+(lane&3)*8;
  const unsigned kdst=lds0+LDS_K+wid*1024, vdst=lds0+LDS_V+wid*1024;
  #define DMA_K(t,slot) glds16(ksrc+(long)(t)*KVBLK*DM,(unsigned)__builtin_amdgcn_readfirstlane(kdst+(slot)))
  #define DMA_V(t,slot) glds16(vsrc+(long)(t)*KVBLK*DM,(unsigned)__builtin_amdgcn_readfirstlane(vdst+(slot)))
  const int vb0=(int)(lds0+LDS_V)+((lane>>4)&1)*32+(lane&3)*8+(4*hi+((lane&15)>>2))*64;
  const char*Kbase=shm+LDS_K; bf16x8 kf[8];
  const lds_cptr shm3=(lds_cptr)shm; const lds_cptr kp0=shm3+LDS_K+hi*1024+r32*16; const lds_cptr vp0=shm3+LDS_V+((lane>>4)&1)*32+(lane&3)*8+(4*hi+((lane&15)>>2))*64;
  const int NT=(q0+QB)/KVBLK;
  DMA_K(0,0);DMA_V(0,0);DMA_K(1,SLOTB);
  bf16x8 qr[4];
  #pragma unroll
  for(int d0=0;d0<4;++d0)qr[d0]=*reinterpret_cast<const bf16x8*>(&Qw[(long)r32*DM+d0*16+hi*8]);
  float mhat=0.f,l_reg=0.f;f32x16 o[2];o[0]=f32x16{};o[1]=f32x16{};
  const int qrel=wid*QBLK+r32;
  typedef __attribute__((address_space(3))) const float* lds_fptr;
  const lds_fptr Rl=(lds_fptr)((lds_cptr)shm+LDS_BT)+(447-(q0+qrel-4*hi));
  #define CBIAS(P0,P1,t) do{ const lds_fptr rp_=Rl+64*(t); \
    _Pragma("unroll") for(int g_=0;g_<4;++g_){ SBAR(); _Pragma("unroll") for(int r=4*g_;r<4*g_+4;++r){ P0[r]+=rp_[(r&3)+8*(r>>2)]; P1[r]+=rp_[32+(r&3)+8*(r>>2)]; } } SBAR(); }while(0)
  #define CMASK(P0,P1,t) do{ if((t)>=NT-7){ CBIAS(P0,P1,t); } int jb_=(t)-(NT-4); if(jb_>=0)cmask(P0,P1,jb_,qrel,hi);}while(0)
  bool resc=false;
  #define START(P0,P1) do{ const float rm=rowmax(P0,P1); resc=false; \
    { const float dl=rm; mhat=fadd_s(mhat,dl); \
      _Pragma("unroll") for(int r=0;r<16;++r){P0[r]=fsub_s(P0[r],dl);P1[r]=fsub_s(P1[r],dl);} \
      } \
    _Pragma("unroll") for(int r=0;r<16;++r)P0[r]=__builtin_amdgcn_exp2f(P0[r]); }while(0)
  #define RESC() do{ if(resc){ asm volatile("s_waitcnt lgkmcnt(0)":::"memory"); \
      _Pragma("unroll") for(int d_=0;d_<2;++d_) _Pragma("unroll") for(int r=0;r<16;++r)o[d_][r]*=wsf[crow(r,hi)]; } }while(0)
  f32x16 pA0,pA1,pB0,pB1;
  int sl_prev=0,sl_cur=0,sl_next=SLOTB;
  #define ROT() do{sl_prev=sl_cur;sl_cur=sl_next;sl_next=(sl_next==(NSLOT-1)*SLOTB)?0:sl_next+SLOTB;}while(0)
  DMA_K(2,2*SLOTB);
  WAIT_BAR(3);
  qkt(pA0,pA1,Kbase,qr,r32,hi);asm volatile("s_nop 15\n\ts_nop 7":"+v"(pA0),"+v"(pA1));
  #pragma unroll
  for(int r=0;r<16;++r){pA0[r]+=b31l;pA1[r]+=b31l;}
  CMASK(pA0,pA1,0);
  START(pA0,pA1);
  _Pragma("unroll") for(int r=0;r<16;++r)pA1[r]=__builtin_amdgcn_exp2f(pA1[r]);
  WAIT_BAR(0);
  DMA_K(3,0);DMA_V(1,SLOTB);
  ROT();
  kload8(kf,kp0+sl_cur);
  WAIT_BAR(2);
  s16x4 vlo[8],vhi[8]; u32x4 pw0,pw1,pw2,pw3;
  #define PKW(P,B) cvtpk_s(P[B],P[B+1])
  #define PAF(k) __builtin_bit_cast(bf16x8,pw##k)
  #define VFR(i) (bf16x8){vlo[i][0],vlo[i][1],vlo[i][2],vlo[i][3],vhi[i][0],vhi[i][1],vhi[i][2],vhi[i][3]}
  #define PIN(x) asm volatile("":"+v"(x))
  #define MX3(a,b,c) __builtin_fmaxf(__builtin_fmaxf((a),(b)),(c))
  #define GAPA(MF,A0,A1,A2,A3,W0,W1,PW) do{ MF; sacc+=A0; sacc+=A1; sacc+=A2; sacc+=A3; PIN(sacc); W0; W1; PIN(PW); SBAR(); }while(0)
  #define EX(v) __builtin_amdgcn_exp2f(v)
  #define GAPB(MF,X,B) do{ MF; X[B]=EX(X[B]); X[B+1]=EX(X[B+1]); X[B+2]=EX(X[B+2]); X[B+3]=EX(X[B+3]); PIN(X); SBAR(); }while(0)
  #define VRD(i) do{ vlo[i]=vtr(vp_+(((i)>>2)*4096+((i)&3)*1024)); vhi[i]=vtr(vp_+(((i)>>2)*4096+((i)&3)*1024+512)); }while(0)
  #define KRD(G,j) do{ if(G){ kload2(kf,kp0+sl_next,j); SBAR(); } }while(0)
  #define STEP(C0,C1,P0,P1,t,GK,GV,GL) do{ SBAR(); \
    const lds_cptr vp_=vp0+sl_prev; \
    VRD(0); SBAR(); float sacc=(P0[0]+P0[1]); \
    GAPA(C0=__builtin_amdgcn_mfma_f32_32x32x16_bf16(kf[0],qr[0],f32x16{},0,0,0), P0[2],P0[3],P0[4],P0[5],     pw0[0]=PKW(P0,0), pw0[1]=PKW(P0,2), pw0); \
    VRD(4); SBAR(); GAPA(C1=__builtin_amdgcn_mfma_f32_32x32x16_bf16(kf[1],qr[0],f32x16{},0,0,0), P0[6],P0[7],P0[8],P0[9],     pw0[2]=PKW(P0,4), pw0[3]=PKW(P0,6), pw0); \
    VRD(1); SBAR(); GAPA(C0=__builtin_amdgcn_mfma_f32_32x32x16_bf16(kf[2],qr[1],C0,0,0,0),   P0[10],P0[11],P0[12],P0[13], pw1[0]=PKW(P0,8), pw1[1]=PKW(P0,10), pw1); \
    VRD(5); SBAR(); GAPA(C1=__builtin_amdgcn_mfma_f32_32x32x16_bf16(kf[3],qr[1],C1,0,0,0),   P0[14],P0[15],P1[0],P1[1],   pw1[2]=PKW(P0,12),pw1[3]=PKW(P0,14), pw1); \
    VRD(2); SBAR(); GAPA(C0=__builtin_amdgcn_mfma_f32_32x32x16_bf16(kf[4],qr[2],C0,0,0,0),   P1[2],P1[3],P1[4],P1[5],     pw2[0]=PKW(P1,0), pw2[1]=PKW(P1,2), pw2); \
    VRD(6); SBAR(); GAPA(C1=__builtin_amdgcn_mfma_f32_32x32x16_bf16(kf[5],qr[2],C1,0,0,0),   P1[6],P1[7],P1[8],P1[9],     pw2[2]=PKW(P1,4), pw2[3]=PKW(P1,6), pw2); \
    VRD(3); SBAR(); GAPA(C0=__builtin_amdgcn_mfma_f32_32x32x16_bf16(kf[6],qr[3],C0,0,0,0),   P1[10],P1[11],P1[12],P1[13], pw3[0]=PKW(P1,8), pw3[1]=PKW(P1,10), pw3); \
    VRD(7); SBAR(); GAPA(C1=__builtin_amdgcn_mfma_f32_32x32x16_bf16(kf[7],qr[3],C1,0,0,0),   P1[14],P1[15],0.f,0.f,       pw3[2]=PKW(P1,12),pw3[3]=PKW(P1,14), pw3); \
    l_reg+=sacc; \
    if(GK){DMA_K((t)+3,sl_cur);} if(GV){DMA_V((t)+1,sl_next);} \
    { const float nb_=b31l-mhat; _Pragma("unroll") for(int r=0;r<16;++r){C0[r]+=nb_;C1[r]+=nb_;} } \
    CMASK(C0,C1,t); \
    { float a=MX3(C0[0],C0[1],C1[0]),b=MX3(C0[2],C0[3],C1[1]); a=MX3(a,C1[2],C1[3]); \
      _Pragma("unroll") for(int r=4;r<16;r+=4){a=MX3(a,C0[r],C0[r+1]);b=MX3(b,C0[r+2],C0[r+3]);a=MX3(a,C1[r],C1[r+1]);b=MX3(b,C1[r+2],C1[r+3]);} \
      float rm=__builtin_fmaxf(a,b); { auto rr=__builtin_amdgcn_permlane32_swap(__float_as_uint(rm),__float_as_uint(rm),false,false); rm=__builtin_fmaxf(__uint_as_float(rr[0]),__uint_as_float(rr[1])); } \
      resc=false; \
      if(__builtin_expect(__any(rm>(float)THRL),0)){ const float dl=__builtin_fmaxf(rm,0.f); mhat+=dl; \
        _Pragma("unroll") for(int r=0;r<16;++r){C0[r]-=dl;C1[r]-=dl;} \
        const float f=__builtin_amdgcn_exp2f(-dl); l_reg*=f; { int r32b_=r32; asm volatile("":"+v"(r32b_)); if(hi==0)wsf[r32b_]=f; } resc=true; } } \
    SBAR(); \
    GAPB(o[0]=__builtin_amdgcn_mfma_f32_32x32x16_bf16(PAF(0),VFR(0),o[0],0,0,0), C0,0); \
    GAPB(o[1]=__builtin_amdgcn_mfma_f32_32x32x16_bf16(PAF(0),VFR(4),o[1],0,0,0), C0,4); \
    KRD(GL,0); GAPB(o[0]=__builtin_amdgcn_mfma_f32_32x32x16_bf16(PAF(1),VFR(1),o[0],0,0,0), C0,8); \
    KRD(GL,1); GAPB(o[1]=__builtin_amdgcn_mfma_f32_32x32x16_bf16(PAF(1),VFR(5),o[1],0,0,0), C0,12); \
    KRD(GL,2); GAPB(o[0]=__builtin_amdgcn_mfma_f32_32x32x16_bf16(PAF(2),VFR(2),o[0],0,0,0), C1,0); \
    KRD(GL,3); GAPB(o[1]=__builtin_amdgcn_mfma_f32_32x32x16_bf16(PAF(2),VFR(6),o[1],0,0,0), C1,4); \
    GAPB(o[0]=__builtin_amdgcn_mfma_f32_32x32x16_bf16(PAF(3),VFR(3),o[0],0,0,0), C1,8); \
    GAPB(o[1]=__builtin_amdgcn_mfma_f32_32x32x16_bf16(PAF(3),VFR(7),o[1],0,0,0), C1,12); \
    }while(0)
  int t=1;
  #undef CMASK
  #define CMASK(P0,P1,t) do{}while(0)
  for(;t+7<NT;t+=2){
    STEP(pB0,pB1,pA0,pA1,t,true,true,true);     WAIT_BAR(2); RESC(); ROT();
    STEP(pA0,pA1,pB0,pB1,t+1,true,true,true);   WAIT_BAR(2); RESC(); ROT();
  }
  #undef CMASK
  #define CMASK(P0,P1,t) do{ CBIAS(P0,P1,t); int jb_=(t)-(NT-4); if(jb_>=0)cmask(P0,P1,jb_,qrel,hi);}while(0)
  #define ENDW(tt) do{ if((tt)+3<NT){WAIT_BAR(2);} else if((tt)+2<NT){WAIT_BAR(1);} else {WAIT_BAR(0);} }while(0)
  for(;t+1<NT;t+=2){
    STEP(pB0,pB1,pA0,pA1,t,(t+3<NT),(t+1<NT),(t+1<NT));       ENDW(t);   RESC(); ROT();
    STEP(pA0,pA1,pB0,pB1,t+1,(t+4<NT),(t+2<NT),(t+2<NT));     ENDW(t+1); RESC(); ROT();
  }
  STEP(pB0,pB1,pA0,pA1,NT-1,false,false,false); RESC();
  { float sacc=pB0[0]+pB0[1]; _Pragma("unroll") for(int r=2;r<16;++r)sacc+=pB0[r]; _Pragma("unroll") for(int r=0;r<16;++r)sacc+=pB1[r]; l_reg+=sacc;
    pw0=(u32x4){PKW(pB0,0),PKW(pB0,2),PKW(pB0,4),PKW(pB0,6)};pw1=(u32x4){PKW(pB0,8),PKW(pB0,10),PKW(pB0,12),PKW(pB0,14)};pw2=(u32x4){PKW(pB1,0),PKW(pB1,2),PKW(pB1,4),PKW(pB1,6)};pw3=(u32x4){PKW(pB1,8),PKW(pB1,10),PKW(pB1,12),PKW(pB1,14)};
    SBAR(); pv(o,vb0+sl_cur,PAF(0),PAF(1),PAF(2),PAF(3)); }
  #undef PKW
  #undef PAF
  #undef VFR
  #undef PIN
  #undef MX3
  #undef GAPA
  #undef GAPB
  #undef EX
  #undef VRD
  #undef KRD
  #undef STEP
  #undef ENDW
  {auto rr=__builtin_amdgcn_permlane32_swap(__float_as_uint(l_reg),__float_as_uint(l_reg),false,false);l_reg=__uint_as_float(rr[0])+__uint_as_float(rr[1]);}
  if(hi==0)wsf[32+r32]=l_reg;asm volatile("s_waitcnt lgkmcnt(0)":::"memory");
  float rli[16];
  #pragma unroll
  for(int r=0;r<16;++r)rli[r]=__builtin_amdgcn_rcpf(wsf[32+crow(r,hi)]);
  bf16*Ow=Oc+(long)(wid*QBLK)*OPITCH;
  { bf16*stg=(bf16*)(shm+LDS_OST)+wid*2048;
    #pragma unroll
    for(int r=0;r<16;++r){const int orow=crow(r,hi);
      #pragma unroll
      for(int d0=0;d0<2;++d0)stg[orow*64+d0*32+r32]=__float2bfloat16(o[d0][r]*rli[r]);}
    asm volatile("s_waitcnt lgkmcnt(0)":::"memory");
    #pragma unroll
    for(int i=0;i<4;++i){const int row=i*8+(lane>>3),ch=lane&7; const u32x4 v=*(const u32x4*)(stg+row*64+ch*8); ATTN_STORE16(Ow+(long)row*OPITCH+ch*8,v);} }
  asm volatile("s_waitcnt lgkmcnt(0)\n\ts_barrier":::"memory");
  #undef DMA_K
  #undef DMA_V
  #undef CMASK
  #undef CBIAS
  #undef START
  #undef RESC
  #undef ROT
}
constexpr int ATTN_LDS_BYTES=LDS_BYTES;
#undef SBAR
#undef WAIT_BAR
}

namespace topk {
typedef short bf16x8 __attribute__((ext_vector_type(8)));
typedef float f32x16 __attribute__((ext_vector_type(16)));
#define TK_WL4(wa_, wb_, a0_, a1_, b0_, b1_, j0) asm volatile("s_nop 3\n\tv_writelane_b32 %0, %2, %6\n\tv_writelane_b32 %0, %3, %7\n\tv_writelane_b32 %1, %4, %6\n\tv_writelane_b32 %1, %5, %7" : "+v"(wa_), "+v"(wb_) : "s"(a0_), "s"(a1_), "s"(b0_), "s"(b1_), "n"(j0), "n"((j0) + 1))
__device__ __forceinline__ unsigned fkey(float f) { const unsigned u = __float_as_uint(f); return (u & 0x80000000u) ? ~u : (u | 0x80000000u); }
template <int CTRL> __device__ __forceinline__ unsigned dpp_u(unsigned v) { return (unsigned)__builtin_amdgcn_update_dpp(0, (int)v, CTRL, 0xF, 0xF, true); }
__device__ __forceinline__ unsigned wsum_u(unsigned v) {
    v += dpp_u<0xB1>(v); v += dpp_u<0x4E>(v); v += dpp_u<0x141>(v); v += dpp_u<0x140>(v);
    auto r = __builtin_amdgcn_permlane16_swap(v, v, false, false); v = r[0] + r[1];
    auto r2 = __builtin_amdgcn_permlane32_swap(v, v, false, false); return r2[0] + r2[1];
}
__device__ __forceinline__ void unit(const bf16* __restrict__ qq, const bf16* __restrict__ ki, const float* __restrict__ wi, unsigned* __restrict__ sel, int b, int t0, LAS unsigned* keys, int wave, int lane) {
    if (t0 + 15 < TOPK) {
#pragma unroll
        for (int q = 0; q < 2; ++q) { const int t = t0 + 2 * wave + q, lo = 32 * lane; unsigned w = 0u; if (lo + 31 <= t) w = 0xffffffffu; else if (lo <= t) w = (2u << (t - lo)) - 1u;
            sel[((size_t)b * L + t) * 64 + lane] = w; }
        return;
    }
    const int jd = (t0 + 15) >> 5;
#ifndef TK_REP_SCORE
#define TK_REP_SCORE 1
#endif
#ifndef TK_REP_SEL
#define TK_REP_SEL 1
#endif
    for (int rs_ = 0; rs_ < TK_REP_SCORE; ++rs_) {
        const int c = lane & 31, hf = lane >> 5;
        const int qa = ((c >> 4) << 1) | ((c >> 2) & 1), ha = (c & 3) | (((c >> 3) & 1) << 2);
        bf16x8 af[4][4]; float wA[4][8], wB[4][8];
#pragma unroll
        for (int rg = 0; rg < 4; ++rg) {
            const bf16* ap = qq + ((size_t)b * L + t0 + 4 * rg + qa) * NQQ + ha * 64 + 32 * hf;
#pragma unroll
            for (int s = 0; s < 4; ++s) af[rg][s] = *(const bf16x8*)(ap + 8 * s);
            const f32x4* wp = (const f32x4*)(wi + ((size_t)b * L + t0 + 4 * rg + hf) * 8); const f32x4 w0 = wp[0], w1 = wp[1], w2 = wp[4], w3 = wp[5];
#pragma unroll
            for (int k = 0; k < 4; ++k) { wA[rg][k] = w0[k]; wA[rg][4 + k] = w1[k]; wB[rg][k] = w2[k]; wB[rg][4 + k] = w3[k]; }
        }
        const bf16* kp = ki + ((size_t)b * L + c) * 64 + 32 * hf;
        bf16x8 bn[4];
        if (wave <= jd) {
#pragma unroll
            for (int s = 0; s < 4; ++s) bn[s] = *(const bf16x8*)(kp + (size_t)wave * 32 * 64 + 8 * s);
        }
        for (int j = wave; j <= jd; j += 8) {
            bf16x8 bc[4];
#pragma unroll
            for (int s = 0; s < 4; ++s) bc[s] = bn[s];
            if (j + 8 <= jd) {
#pragma unroll
                for (int s = 0; s < 4; ++s) bn[s] = *(const bf16x8*)(kp + (size_t)(j + 8) * 32 * 64 + 8 * s);
            }
            const int key = 32 * j + c;
#pragma unroll
            for (int rg = 0; rg < 4; ++rg) {
                f32x16 acc = {};
#pragma unroll
                for (int s = 0; s < 4; ++s) acc = __builtin_amdgcn_mfma_f32_32x32x16_bf16(af[rg][s], bc[s], acc, 0, 0, 0);
                float sa = 0.f, sb = 0.f;
#pragma unroll
                for (int h = 0; h < 8; ++h) { sa += wA[rg][h] * __builtin_amdgcn_fmed3f(acc[h], 0.f, __builtin_inff()); sb += wB[rg][h] * __builtin_amdgcn_fmed3f(acc[8 + h], 0.f, __builtin_inff()); }
                const int tA = t0 + 4 * rg + hf, tB = tA + 2;
                LAS unsigned* kA = keys + (4 * rg + hf) * 2048 + key;
                kA[0] = key > tA ? 0u : fkey(sa); kA[2 * 2048] = key > tB ? 0u : fkey(sb);
            }
        }
    }
    __syncthreads();
    for (int rs_ = 0; rs_ < TK_REP_SEL; ++rs_) {
        const int nvalid = 32 * (jd + 1);
        unsigned kA[32], kB[32];
        const LAS unsigned* pa = keys + (2 * wave) * 2048 + lane; const LAS unsigned* pb = pa + 2048;
#pragma unroll
        for (int i = 0; i < 32; ++i) { const bool ok = 64 * i + lane < nvalid; kA[i] = ok ? pa[64 * i] : 0u; kB[i] = ok ? pb[64 * i] : 0u; }
        const int ilim = (nvalid + 63) >> 6;
        unsigned pA = 0u, pB = 0u; bool doneA = false, doneB = false;
        for (int bit = 31; bit >= 0; --bit) {
            const unsigned cA = pA | (1u << bit), cB = pB | (1u << bit); unsigned cnt = 0u;
#pragma unroll
            for (int g4 = 0; g4 < 8; ++g4) { if (4 * g4 < ilim) {
#pragma unroll
                for (int i = 4 * g4; i < 4 * g4 + 4; ++i) { cnt += (kA[i] >= cA) ? 1u : 0u; cnt += (kB[i] >= cB) ? 0x10000u : 0u; } __builtin_amdgcn_sched_barrier(0); } }
            cnt = wsum_u(cnt);
            const unsigned nA = cnt & 0xffffu, nB = cnt >> 16;
            if (!doneA && nA >= (unsigned)TOPK) pA = cA;
            if (!doneB && nB >= (unsigned)TOPK) pB = cB;
            doneA = doneA || nA == (unsigned)TOPK; doneB = doneB || nB == (unsigned)TOPK;
            if (doneA && doneB) break;
        }
        unsigned cge = 0u, cgt = 0u;
#pragma unroll
        for (int i = 0; i < 32; ++i) { cge += (kA[i] >= pA) ? 1u : 0u; cge += (kB[i] >= pB) ? 0x10000u : 0u; cgt += (kA[i] > pA) ? 1u : 0u; cgt += (kB[i] > pB) ? 0x10000u : 0u; if ((i & 3) == 3) __builtin_amdgcn_sched_barrier(0); }
        cge = wsum_u(cge); cgt = wsum_u(cgt);
        asm volatile("" : "+v"(pA), "+v"(pB));
        const bool tie = (cge & 0xffffu) != (unsigned)TOPK || (cge >> 16) != (unsigned)TOPK;
        unsigned wa = 0u, wb = 0u;
        if (!tie) {
#pragma unroll
            for (int i = 0; i < 32; ++i) {
                const unsigned long long mA = __builtin_amdgcn_ballot_w64(kA[i] >= pA), mB = __builtin_amdgcn_ballot_w64(kB[i] >= pB);
                const unsigned a0 = (unsigned)mA, a1 = (unsigned)(mA >> 32), b0 = (unsigned)mB, b1 = (unsigned)(mB >> 32);
                TK_WL4(wa, wb, a0, a1, b0, b1, 2 * i); __builtin_amdgcn_sched_barrier(0);
            }
        } else {
            const unsigned needA = (unsigned)TOPK - (cgt & 0xffffu), needB = (unsigned)TOPK - (cgt >> 16); unsigned runA = 0u, runB = 0u;
            const unsigned long long below = (1ull << lane) - 1ull;
#pragma unroll
            for (int i = 0; i < 32; ++i) {
                const unsigned long long eA = __builtin_amdgcn_ballot_w64(kA[i] == pA), eB = __builtin_amdgcn_ballot_w64(kB[i] == pB);
                const bool tkA = kA[i] > pA || (kA[i] == pA && runA + (unsigned)__builtin_popcountll(eA & below) < needA);
                const bool tkB = kB[i] > pB || (kB[i] == pB && runB + (unsigned)__builtin_popcountll(eB & below) < needB);
                runA += (unsigned)__builtin_popcountll(eA); runB += (unsigned)__builtin_popcountll(eB);
                const unsigned long long mA = __builtin_amdgcn_ballot_w64(tkA), mB = __builtin_amdgcn_ballot_w64(tkB);
                const unsigned a0 = (unsigned)mA, a1 = (unsigned)(mA >> 32), b0 = (unsigned)mB, b1 = (unsigned)(mB >> 32);
                TK_WL4(wa, wb, a0, a1, b0, b1, 2 * i); __builtin_amdgcn_sched_barrier(0);
            }
        }
        unsigned* so = sel + ((size_t)b * L + t0 + 2 * wave) * 64 + lane;
        so[0] = wa; so[64] = wb;
    }
    __syncthreads();
}
#undef TK_WL4
}

namespace sparse {
typedef short bf16x8 __attribute__((ext_vector_type(8)));
typedef short s16x4 __attribute__((ext_vector_type(4)));
typedef float f32x4 __attribute__((ext_vector_type(4)));
typedef int i32x4 __attribute__((ext_vector_type(4)));
typedef __attribute__((address_space(3))) const char* lds_cptr;
typedef short v4i16_t __attribute__((ext_vector_type(4)));
constexpr int BUF = 8192, WAVE_LDS = 2 * BUF + 1024, BT_OFF = 8 * WAVE_LDS, LDS_NEED = BT_OFF + 8192;
__device__ __forceinline__ int fsw(int r) { return ((((r & 7) ^ ((r >> 3) << 2))) << 1) | (r >> 3); }
__device__ __forceinline__ void glds16(const void* gsrc, unsigned lds_dst) { unsigned keep;
    asm volatile("s_mov_b32 %0, m0\n\ts_mov_b32 m0, %2\n\ts_nop 0\n\tglobal_load_lds_dwordx4 %1, off\n\ts_mov_b32 m0, %0" : "=&s"(keep) : "v"(gsrc), "s"(lds_dst) : "memory"); }
__device__ __forceinline__ s16x4 vtr(lds_cptr p) { return __builtin_bit_cast(s16x4, __builtin_amdgcn_ds_read_tr16_b64_v4i16((__attribute__((address_space(3))) v4i16_t*)p)); }
__device__ __forceinline__ float xmax16(float v) { auto r = __builtin_amdgcn_permlane16_swap(__float_as_uint(v), __float_as_uint(v), false, false); return fmaxf(__uint_as_float(r[0]), __uint_as_float(r[1])); }
__device__ __forceinline__ float xmax32(float v) { auto r = __builtin_amdgcn_permlane32_swap(__float_as_uint(v), __float_as_uint(v), false, false); return fmaxf(__uint_as_float(r[0]), __uint_as_float(r[1])); }
__device__ __forceinline__ unsigned cvtpk(float lo, float hi) { typedef float f2 __attribute__((ext_vector_type(2))); typedef __bf16 b2 __attribute__((ext_vector_type(2))); f2 v = {lo, hi}; b2 b = __builtin_convertvector(v, b2); return __builtin_bit_cast(unsigned, b); }

__device__ __forceinline__ void query(const bf16* __restrict__ qq, const bf16* __restrict__ ckv, const unsigned* __restrict__ sel, bf16* __restrict__ olat, int b, int t, char* wl, const float* btl, int lane) {
    const int hd = lane & 15, quad = lane >> 4; const size_t row = (size_t)b * L + t;
    int* idx = (int*)(wl + 2 * BUF);
    const unsigned word = sel[row * 64 + lane];
    { const int z = -1; *(i32x4*)(idx + 4 * lane) = (i32x4){z, z, z, z}; }
    asm volatile("s_waitcnt lgkmcnt(0)" ::: "memory");
    int base = 0;
#pragma unroll 4
    for (int p = 0; p < 32; ++p) {
        const bool on = (word >> p) & 1u; const unsigned long long m = __builtin_amdgcn_ballot_w64(on);
        const int slot = base + (int)__builtin_amdgcn_mbcnt_hi((unsigned)(m >> 32), __builtin_amdgcn_mbcnt_lo((unsigned)m, 0u));
        if (on && slot < 256) idx[slot] = 32 * lane + p;
        base += __builtin_popcountll(m);
    }
    const int n = base < 256 ? base : 256, nch = (n + 31) >> 5;
    asm volatile("s_waitcnt lgkmcnt(0)" ::: "memory");
    bf16x8 qf[4];
    { const bf16* qp = qq + row * NQQ + 512 + hd * 128 + 8 * quad;
#pragma unroll
      for (int s = 0; s < 4; ++s) qf[s] = *(const bf16x8*)(qp + 32 * s); }
    const unsigned lds0 = (unsigned)(uintptr_t)wl;
    const bf16* gbase = ckv + (size_t)b * L * 128;
    const lds_cptr wl3 = (lds_cptr)wl;
    const int fk = fsw(hd);
    const int qp_ = hd >> 2, pp_ = hd & 3, rv = 4 * quad + qp_, fv = fsw(rv);
#define SP_DMA(ch, bufoff) do { _Pragma("unroll") for (int i_ = 0; i_ < 8; ++i_) { const int R_ = 4 * i_ + quad; int key_ = idx[32 * (ch) + R_]; key_ = key_ < 0 ? 0 : key_; \
        glds16(gbase + (size_t)key_ * 128 + 8 * (hd ^ fsw(R_ & 15)), (unsigned)__builtin_amdgcn_readfirstlane(lds0 + (bufoff) + 1024 * i_)); } } while (0)
    f32x4 o[8];
#pragma unroll
    for (int rb = 0; rb < 8; ++rb) o[rb] = (f32x4){0.f, 0.f, 0.f, 0.f};
    float mref = -INFINITY, lsum = 0.f;
    SP_DMA(0, 0);
    for (int ch = 0; ch < nch; ++ch) {
        const int bo = (ch & 1) * BUF;
        if (ch + 1 < nch) { SP_DMA(ch + 1, BUF - bo); asm volatile("s_waitcnt vmcnt(8)" ::: "memory"); }
        else asm volatile("s_waitcnt vmcnt(0)" ::: "memory");
        f32x4 sc[2];
#pragma unroll
        for (int T = 0; T < 2; ++T) { f32x4 acc = {0.f, 0.f, 0.f, 0.f}; const lds_cptr kr = wl3 + bo + 256 * (16 * T + hd);
#pragma unroll
            for (int s = 0; s < 4; ++s) { const bf16x8 kf = *(const __attribute__((address_space(3))) bf16x8*)(kr + 16 * ((4 * s + quad) ^ fk));
                acc = __builtin_amdgcn_mfma_f32_16x16x32_bf16(kf, qf[s], acc, 0, 0, 0); }
            sc[T] = acc; }
        float mloc = -INFINITY;
#pragma unroll
        for (int T = 0; T < 2; ++T) { const i32x4 kx = *(const i32x4*)(idx + 32 * ch + 16 * T + 4 * quad);
#pragma unroll
            for (int r = 0; r < 4; ++r) { int d = t - kx[r]; d = d > 127 ? 127 : d; const float bv = btl[(d < 0 ? 0 : d) * 16 + hd];
                const float v = kx[r] < 0 ? -INFINITY : sc[T][r] + bv; sc[T][r] = v; mloc = fmaxf(mloc, v); } }
        mloc = xmax32(xmax16(mloc));
        if (__builtin_amdgcn_ballot_w64(mloc > mref + 8.f) != 0ull) {
            const float mn = fmaxf(mref, mloc), f = __builtin_amdgcn_exp2f(mref - mn); mref = mn; lsum *= f;
#pragma unroll
            for (int rb = 0; rb < 8; ++rb) o[rb] = o[rb] * f;
        }
        float p0[4], p1[4];
#pragma unroll
        for (int r = 0; r < 4; ++r) { p0[r] = __builtin_amdgcn_exp2f(sc[0][r] - mref); p1[r] = __builtin_amdgcn_exp2f(sc[1][r] - mref); lsum += p0[r] + p1[r]; }
        typedef unsigned u32x4v __attribute__((ext_vector_type(4)));
        const u32x4v pw = {cvtpk(p0[0], p0[1]), cvtpk(p0[2], p0[3]), cvtpk(p1[0], p1[1]), cvtpk(p1[2], p1[3])};
        const bf16x8 pb = __builtin_bit_cast(bf16x8, pw);
        const lds_cptr v0p = wl3 + bo + 256 * rv + 8 * (pp_ & 1), v1p = v0p + 256 * 16;
#pragma unroll
        for (int rb = 0; rb < 8; ++rb) { const int pos = 16 * ((2 * rb + (pp_ >> 1)) ^ fv);
            const s16x4 a0 = vtr(v0p + pos), a1 = vtr(v1p + pos);
            const bf16x8 va = {a0[0], a0[1], a0[2], a0[3], a1[0], a1[1], a1[2], a1[3]};
            o[rb] = __builtin_amdgcn_mfma_f32_16x16x32_bf16(va, pb, o[rb], 0, 0, 0); }
    }
#undef SP_DMA
    lsum = xsum32(xsum16(lsum));
    const float inv = __builtin_amdgcn_rcpf(lsum);
    bf16* op = olat + row * 2048 + hd * 128 + 4 * quad;
#pragma unroll
    for (int rb = 0; rb < 8; ++rb) { typedef unsigned u32x2v __attribute__((ext_vector_type(2)));
        const u32x2v w = {cvtpk(o[rb][0] * inv, o[rb][1] * inv), cvtpk(o[rb][2] * inv, o[rb][3] * inv)};
        *(u32x2v*)(op + 16 * rb) = w; }
    asm volatile("s_waitcnt lgkmcnt(0)" ::: "memory");
}
}

namespace topk2 {
typedef short bf16x8 __attribute__((ext_vector_type(8)));
typedef float f32x4 __attribute__((ext_vector_type(4)));
__device__ __forceinline__ unsigned fkey(float f) { const unsigned u = __float_as_uint(f); return (u & 0x80000000u) ? ~u : (u | 0x80000000u); }
__device__ __forceinline__ float relu(float v) { return __builtin_amdgcn_fmed3f(v, 0.f, __builtin_inff()); }
template <int CTRL> __device__ __forceinline__ unsigned dpp_u(unsigned v) { return (unsigned)__builtin_amdgcn_update_dpp(0, (int)v, CTRL, 0xF, 0xF, true); }
__device__ __forceinline__ unsigned half_sum(unsigned v) {
    v += dpp_u<0xB1>(v); v += dpp_u<0x4E>(v); v += dpp_u<0x141>(v); v += dpp_u<0x140>(v);
    auto r = __builtin_amdgcn_permlane16_swap(v, v, false, false); return r[0] + r[1];
}
#define TK2_WL2(w0_, w1_, a0_, a1_, j0) asm volatile("s_nop 3\n\tv_writelane_b32 %0, %2, %4\n\tv_writelane_b32 %1, %3, %4" : "+v"(w0_), "+v"(w1_) : "s"(a0_), "s"(a1_), "n"(j0))
__device__ __forceinline__ void pair(const bf16* __restrict__ qq, const bf16* __restrict__ ki, const float* __restrict__ wi, unsigned* __restrict__ sel, int b, int t0, int lane) {
    const int hd16 = lane & 15, quad = lane >> 4, hf = lane >> 5, qd1 = quad & 1;
    unsigned* so = sel + ((size_t)b * L + t0) * 64 + lane;
    if (t0 + 1 < TOPK) {
#pragma unroll
        for (int q = 0; q < 2; ++q) { const int t = t0 + q, lo = 32 * lane; unsigned w = 0u; if (lo + 31 <= t) w = 0xffffffffu; else if (lo <= t) w = (2u << (t - lo)) - 1u; so[q * 64] = w; }
        return;
    }
    bf16x8 af[2];
    { const bf16* ap = qq + ((size_t)b * L + t0 + (hd16 >> 3)) * NQQ + (hd16 & 7) * 64 + 16 * quad; af[0] = *(const bf16x8*)ap; af[1] = *(const bf16x8*)(ap + 8); }
    const f32x4 w4 = *(const f32x4*)(wi + ((size_t)b * L + t0 + hf) * 8 + 4 * qd1);
    const int tq = t0 + hf, tmax = t0 + 1;
    const bf16* kp = ki + ((size_t)b * L + hd16) * 64 + 16 * quad;
    unsigned kr[64];
    bf16x8 bb[2][4][2];
#define TK2_LOADG(g, buf) do { _Pragma("unroll") for (int tt_ = 0; tt_ < 4; ++tt_) { bb[buf][tt_][0] = *(const bf16x8*)(kp + (size_t)(4 * (g) + tt_) * 1024); bb[buf][tt_][1] = *(const bf16x8*)(kp + (size_t)(4 * (g) + tt_) * 1024 + 8); } } while (0)
#ifndef TK2_REP_SCORE
#define TK2_REP_SCORE 1
#endif
#ifndef TK2_REP_SEL
#define TK2_REP_SEL 1
#endif
    for (int rs_ = 0; rs_ < TK2_REP_SCORE; ++rs_) {
    TK2_LOADG(0, 0);
#pragma unroll
    for (int g = 0; g < 32; ++g) {
        if (64 * g <= tmax) {
            if (g + 1 < 32) { if (64 * (g + 1) <= tmax) TK2_LOADG(g + 1, (g + 1) & 1); }
#pragma unroll
            for (int pr = 0; pr < 2; ++pr) {
                f32x4 aE = {0.f, 0.f, 0.f, 0.f}, aO = {0.f, 0.f, 0.f, 0.f};
                aE = __builtin_amdgcn_mfma_f32_16x16x32_bf16(af[0], bb[g & 1][2 * pr][0], aE, 0, 0, 0); aO = __builtin_amdgcn_mfma_f32_16x16x32_bf16(af[0], bb[g & 1][2 * pr + 1][0], aO, 0, 0, 0);
                aE = __builtin_amdgcn_mfma_f32_16x16x32_bf16(af[1], bb[g & 1][2 * pr][1], aE, 0, 0, 0); aO = __builtin_amdgcn_mfma_f32_16x16x32_bf16(af[1], bb[g & 1][2 * pr + 1][1], aO, 0, 0, 0);
                float pE = w4[0] * relu(aE[0]), pO = w4[0] * relu(aO[0]);
#pragma unroll
                for (int r = 1; r < 4; ++r) { pE += w4[r] * relu(aE[r]); pO += w4[r] * relu(aO[r]); }
                pE = xsum16(pE); pO = xsum16(pO);
                const float sv = qd1 ? pO : pE;
                const int key = 32 * (2 * g + pr) + (lane & 31);
                kr[2 * g + pr] = key > tq ? 0u : fkey(sv);
            }
        } else { kr[2 * g] = 0u; kr[2 * g + 1] = 0u; }
    }
    }
#undef TK2_LOADG
    const int ilim = (tmax + 32) >> 5;
    unsigned pfx = 0u; bool done = false;
    for (int rs_ = 0; rs_ < TK2_REP_SEL; ++rs_) { pfx = 0u; done = false; asm volatile("" : "+v"(pfx));
    for (int bit = 31; bit >= 0; --bit) {
        const unsigned cand = pfx | (1u << bit); unsigned cnt = 0u;
#pragma unroll
        for (int g4 = 0; g4 < 16; ++g4) { if (4 * g4 < ilim) {
#pragma unroll
            for (int i = 4 * g4; i < 4 * g4 + 4; ++i) cnt += (kr[i] >= cand) ? 1u : 0u; } }
        cnt = half_sum(cnt);
        if (!done && cnt >= (unsigned)TOPK) pfx = cand;
        done = done || cnt == (unsigned)TOPK;
        if (__builtin_amdgcn_ballot_w64(!done) == 0ull) break;
    }
    }
    unsigned cge = 0u, cgt = 0u;
#pragma unroll
    for (int i = 0; i < 64; ++i) { cge += (kr[i] >= pfx) ? 1u : 0u; cgt += (kr[i] > pfx) ? 1u : 0u; }
    cge = half_sum(cge); cgt = half_sum(cgt);
    asm volatile("" : "+v"(pfx));
    const bool tie = __builtin_amdgcn_ballot_w64(cge != (unsigned)TOPK) != 0ull;
    unsigned w0 = 0u, w1 = 0u;
    if (!tie) {
#pragma unroll
        for (int i = 0; i < 64; ++i) { const unsigned long long m = __builtin_amdgcn_ballot_w64(kr[i] >= pfx); const unsigned m0 = (unsigned)m, m1 = (unsigned)(m >> 32);
            TK2_WL2(w0, w1, m0, m1, i); __builtin_amdgcn_sched_barrier(0); }
    } else {
        const unsigned need = (unsigned)TOPK - cgt; unsigned run = 0u; const unsigned below = (1u << (lane & 31)) - 1u;
#pragma unroll
        for (int i = 0; i < 64; ++i) { const unsigned long long e = __builtin_amdgcn_ballot_w64(kr[i] == pfx); const unsigned eh = hf ? (unsigned)(e >> 32) : (unsigned)e;
            const bool tk = kr[i] > pfx || (kr[i] == pfx && run + (unsigned)__builtin_popcount(eh & below) < need);
            run += (unsigned)__builtin_popcount(eh);
            const unsigned long long m = __builtin_amdgcn_ballot_w64(tk); const unsigned m0 = (unsigned)m, m1 = (unsigned)(m >> 32);
            TK2_WL2(w0, w1, m0, m1, i); __builtin_amdgcn_sched_barrier(0); }
    }
    so[0] = w0; so[64] = w1;
}
#undef TK2_WL2
}

constexpr int NWAVES = 8;
constexpr int RING_OFF = 0, RING_BYTES = 131072;
constexpr int LDSCTL_OFF = 162816, MISC_OFF = LDSCTL_OFF + 320;
constexpr int LDS_BYTES = 163840;
static_assert(sparse::LDS_NEED <= LDSCTL_OFF, "sparse phase LDS");
enum { PH_PRO = 0, PH_PRE0, PH_INPROJ0, PH_QGEMM, PH_TOPK, PH_SPARSE, PH_UV, PH_OUT0, PH_POST0, PH_INPROJ1, PH_ATTN1, PH_OUT1, PH_FINAL, N_PHASES };

struct Args { const float* in[N_IN]; float* out; unsigned char* ws; int ph_lo, ph_hi, li, pad; };

__device__ __forceinline__ int fresh_lane(int dep = 0) { int l; asm volatile("v_mbcnt_lo_u32_b32 %0, -1, 0\n\tv_mbcnt_hi_u32_b32 %0, -1, %0 ; dep %1" : "=v"(l) : "s"(dep)); return l; }
__device__ __forceinline__ float wave_sum(float v) { return wave_sum_all(v); }
template <bool HAS_G> __device__ __forceinline__ void p0_transpose_item(const float* W, int K, int N, int Npad, const float* g, bf16* WT, LAS float* scr, int item, int lane) {
    const int nblk = Npad / 32, kb = item / nblk, nb = item % nblk, k0 = 64 * kb, n0 = 32 * nb;
    const bool ok = (n0 + (lane & 31)) < N; const int nc = ok ? n0 + (lane & 31) : N - 1;
    const float* wp = W + (size_t)(k0 + (lane >> 5)) * N + nc; float v[32];
#pragma unroll
    for (int i = 0; i < 32; ++i) v[i] = wp[(size_t)(2 * i) * N];
    if (HAS_G) {
#pragma unroll
        for (int i = 0; i < 32; ++i) v[i] *= g[k0 + 2 * i + (lane >> 5)];
    }
#pragma unroll
    for (int i = 0; i < 32; ++i) scr[(2 * i + (lane >> 5)) * 33 + (lane & 31)] = ok ? v[i] : 0.f;
    LDS_WAIT(); asm volatile("" ::: "memory");
    const int c = lane & 7;
#pragma unroll
    for (int j = 0; j < 4; ++j) { const int n = (lane >> 3) + 8 * j; const LAS float* s = scr + (8 * c) * 33 + n;
        v4u o; o.x = pk2(s[0 * 33], s[1 * 33]); o.y = pk2(s[2 * 33], s[3 * 33]); o.z = pk2(s[4 * 33], s[5 * 33]); o.w = pk2(s[6 * 33], s[7 * 33]);
        *(GAS v4u*)(WT + (size_t)(n0 + n) * K + k0 + 8 * c) = o; }
    LDS_WAIT(); asm volatile("" ::: "memory");
}
typedef const __attribute__((address_space(4))) Args CArgs;
__device__ __forceinline__ CArgs* kargs(int dep) { CArgs* p = (CArgs*)__builtin_amdgcn_kernarg_segment_ptr(); asm volatile("; kargs %1" : "+s"(p) : "s"(dep)); return p; }
__device__ __forceinline__ void p0_mod(CArgs* ap, LAS unsigned char* lds, int tid, int lane, int wave, int vcu, int G) {
    unsigned char* ws = ap->ws;
    float* mod = (float*)(ws + WS_MOD); Misc* ms = (Misc*)(ws + WS_MISC);
    if (vcu < 96) {
        LAS float* cact = (LAS float*)lds;
        LAS float* red = (LAS float*)(lds + 32768);
        const float* c = ap->in[I_C];
        for (int i = tid; i < NB * D; i += NWAVES * 64) cact[i] = siluf(c[i]);
        __syncthreads();
        const int li = vcu / 48, n = (vcu % 48) * 64 + lane; const float* mw = ap->in[I_MODW] + ((size_t)li * D + wave * 128) * 3072 + n;
        float acc[NB];
#pragma unroll
        for (int b = 0; b < NB; ++b) acc[b] = 0.f;
        for (int k0 = 0; k0 < 128; k0 += 16) { float wv[16];
#pragma unroll
            for (int k = 0; k < 16; ++k) wv[k] = mw[(size_t)(k0 + k) * 3072];
#pragma unroll
            for (int k = 0; k < 16; ++k) {
#pragma unroll
                for (int b = 0; b < NB; ++b) acc[b] += cact[b * D + wave * 128 + k0 + k] * wv[k]; } }
#pragma unroll
        for (int b = 0; b < NB; ++b) red[(wave * NB + b) * 64 + lane] = acc[b];
        __syncthreads();
        { const int b = tid >> 6; float s = 0.f;
#pragma unroll
          for (int w = 0; w < NWAVES; ++w) s += red[(w * NB + b) * 64 + lane];
          mod[((size_t)li * NB + b) * 3072 + n] = s + ap->in[I_MODB][li * 3072 + n]; }
        __syncthreads();
    }
    if (vcu == 96 && tid < 128) {
        const int t = tid;
        if (t == 0) { float s1 = 0.f, s2 = 0.f; for (int i = 0; i < 64; ++i) { s1 += ap->in[I_BLQ1][i] * ap->in[I_BLK1][i]; s2 += ap->in[I_BLQ2][i] * ap->in[I_BLK2][i]; } ms->lam = expf(s1) - expf(s2) + LAMBDA_INIT; }
        int bk; if (t < 16) bk = t; else { bk = 16 + (int)(logf((float)t / 16.f) / 2.0794415416798357f * 16.f); if (bk > 31) bk = 31; } ms->lut[t] = bk;
        for (int cix = 0; cix < 16; ++cix) ms->btab[t * 16 + cix] = ap->in[I_RELB][bk * 16 + cix];
    }
}
__device__ __forceinline__ void p0_weights(CArgs* ap, LAS unsigned char* lds, int lane, int wave, int vcu, int G) {
    unsigned char* ws = ap->ws;
    LAS float* scr = (LAS float*)(lds + RING_OFF + wave * 16384);
    const int gw = vcu * NWAVES + wave, NGW = G * NWAVES;
    bf16 *win0 = (bf16*)(ws + WS_WIN0), *wq2 = (bf16*)(ws + WS_WQ2), *wuv = (bf16*)(ws + WS_WUV), *wout0 = (bf16*)(ws + WS_WOUT0), *win1 = (bf16*)(ws + WS_WIN1), *wout1 = (bf16*)(ws + WS_WOUT1);
    constexpr int I_A = 16 * 48, I_QI = 4 * 16, I_O0 = 16 * 32, I_B = 16 * 128, I_O1 = 16 * 32, NITEMS = I_A + I_QI + I_O0 + I_B + I_O1;
    for (int it = gw; it < NITEMS; it += NGW) {
        int r = it;
        if (r < I_B) { p0_transpose_item<false>(ap->in[I_BWIN], D, B_IN, B_IN, nullptr, win1, scr, r, lane); continue; } r -= I_B;
        if (r < I_A) { p0_transpose_item<false>(ap->in[I_AWIN], D, A_IN, A_INP, nullptr, win0, scr, r, lane); continue; } r -= I_A;
        if (r < I_O0) { p0_transpose_item<false>(ap->in[I_AWOUT], D, D, D, nullptr, wout0, scr, r, lane); continue; } r -= I_O0;
        if (r < I_O1) { p0_transpose_item<false>(ap->in[I_BWOUT], D, D, D, nullptr, wout1, scr, r, lane); continue; } r -= I_O1;
        p0_transpose_item<true>(ap->in[I_AWQIDX], QR, 512, 512, ap->in[I_AQN], wq2, scr, r, lane);
    }
    for (int it = gw; it < 16 * 4 * 32; it += NGW) {
        const int h = it >> 7, kt = (it >> 5) & 3, r0 = (it & 31) * 4, k = kt * 64 + lane;
        const float* uq = ap->in[I_AWUQ] + (size_t)k * 1024 + h * 64; float av[64];
#pragma unroll
        for (int d4 = 0; d4 < 16; ++d4) { const f32x4 t4 = *(const f32x4*)(uq + 4 * d4); av[4 * d4] = t4[0]; av[4 * d4 + 1] = t4[1]; av[4 * d4 + 2] = t4[2]; av[4 * d4 + 3] = t4[3]; }
        const float gk = ap->in[I_AQN][k] * C2;
#pragma unroll
        for (int rr = 0; rr < 4; ++rr) { const int r = r0 + rr; const float* uk = ap->in[I_AWUK] + ((size_t)h * 128 + r) * 64; float s = 0.f;
#pragma unroll
            for (int d = 0; d < 64; ++d) s += av[d] * uk[d];
            wq2[(size_t)(512 + h * 128 + r) * 256 + k] = (bf16)f2bf(s * gk); }
    }
    for (int i = gw * 64 + lane; i < 1024 * 512; i += NGW * 64) {
        const int n = i >> 9, kp = i & 511, h = n >> 6, d = n & 63; float v = 0.f;
        if ((kp >> 7) == ((n & 255) >> 6)) v = ap->in[I_AWUV][((size_t)h * 128 + (kp & 127)) * 64 + d];
        wuv[i] = (bf16)f2bf(v);
    }
}
__device__ __forceinline__ void prenorm_rows(const float* x, const float* g, const float* modl, bf16* H, int gw, int NGW, int lane) {
    for (int row = gw; row < M; row += NGW) {
        const int b = row / L; const GAS f32x4* xr = (const GAS f32x4*)(x + (size_t)row * D) + lane;
        f32x4 v[4]; float s = 0.f;
#pragma unroll
        for (int j = 0; j < 4; ++j) { v[j] = xr[64 * j]; s += (v[j].x * v[j].x + v[j].y * v[j].y) + (v[j].z * v[j].z + v[j].w * v[j].w); }
        const float rs = rsqrtf(wave_sum(s) * (1.f / D) + EPS);
        const f32x4* g4 = (const f32x4*)g + lane; const f32x4* sh4 = (const f32x4*)(modl + (size_t)b * 3072) + lane; const f32x4* sc4 = sh4 + 256;
        GAS unsigned long long* o8 = (GAS unsigned long long*)(H + (size_t)row * D) + lane;
#pragma unroll
        for (int j = 0; j < 4; ++j) { const f32x4 o = v[j] * rs * g4[64 * j] * (sc4[64 * j] + 1.f) + sh4[64 * j];
            o8[64 * j] = (unsigned long long)pk2(o.x, o.y) | ((unsigned long long)pk2(o.z, o.w) << 32); }
    }
}
__device__ __forceinline__ void post_rows(const float* xin, const bf16* Y, const float* postg, const float* modc, const float* pregn, const float* modn, float* xout, bf16* H, int gw, int NGW, int lane) {
    for (int row = gw; row < M; row += NGW) {
        const int b = row / L; const GAS unsigned long long* y8 = (const GAS unsigned long long*)(Y + (size_t)row * D) + lane;
        f32x4 yv[4]; float s = 0.f;
#pragma unroll
        for (int j = 0; j < 4; ++j) { const unsigned long long w = y8[64 * j]; const unsigned lo = (unsigned)w, hi = (unsigned)(w >> 32);
            yv[j].x = __uint_as_float(lo << 16); yv[j].y = __uint_as_float(lo & 0xffff0000u); yv[j].z = __uint_as_float(hi << 16); yv[j].w = __uint_as_float(hi & 0xffff0000u);
            s += (yv[j].x * yv[j].x + yv[j].y * yv[j].y) + (yv[j].z * yv[j].z + yv[j].w * yv[j].w); }
        const float rs = rsqrtf(wave_sum(s) * (1.f / D) + EPS);
        const GAS f32x4* xr = (const GAS f32x4*)(xin + (size_t)row * D) + lane; GAS f32x4* xo = (GAS f32x4*)(xout + (size_t)row * D) + lane;
        const f32x4* pg4 = (const f32x4*)postg + lane; const f32x4* rg4 = (const f32x4*)(modc + (size_t)b * 3072 + 2048) + lane;
        f32x4 x1[4]; float s2 = 0.f;
#pragma unroll
        for (int j = 0; j < 4; ++j) { x1[j] = xr[64 * j] + rg4[64 * j] * (yv[j] * rs * pg4[64 * j]); xo[64 * j] = x1[j];
            s2 += (x1[j].x * x1[j].x + x1[j].y * x1[j].y) + (x1[j].z * x1[j].z + x1[j].w * x1[j].w); }
        if (H) { const float r2 = rsqrtf(wave_sum(s2) * (1.f / D) + EPS);
            const f32x4* g4 = (const f32x4*)pregn + lane; const f32x4* sh4 = (const f32x4*)(modn + (size_t)b * 3072) + lane; const f32x4* sc4 = sh4 + 256;
            GAS unsigned long long* o8 = (GAS unsigned long long*)(H + (size_t)row * D) + lane;
#pragma unroll
            for (int j = 0; j < 4; ++j) { const f32x4 o = x1[j] * r2 * g4[64 * j] * (sc4[64 * j] + 1.f) + sh4[64 * j];
                o8[64 * j] = (unsigned long long)pk2(o.x, o.y) | ((unsigned long long)pk2(o.z, o.w) << 32); } }
    }
}
__device__ __forceinline__ void norm_kv_rows(const bf16* proj0, const float* stats, const float* kvg, const float* kig, bf16* ckv, bf16* ki, float* wi, int gw, int NGW, int lane) {
    for (int row = gw; row < M; row += NGW) {
        const float* st = stats + (size_t)row * 16; const bf16* p = proj0 + (size_t)row * A_INP;
        const float rkv = rsqrtf(((st[4] + st[5]) + (st[6] + st[7])) * (1.f / 128.f) + EPS), rki = rsqrtf((st[8] + st[9]) * (1.f / 64.f) + EPS);
        const unsigned w = *(const unsigned*)(p + 256 + 2 * lane);
        const float a0 = __uint_as_float(w << 16) * rkv * kvg[2 * lane], a1 = __uint_as_float(w & 0xffff0000u) * rkv * kvg[2 * lane + 1];
        *(unsigned*)(ckv + (size_t)row * 128 + 2 * lane) = pk2(a0, a1);
        ki[(size_t)row * 64 + lane] = (bf16)f2bf(bf2f(p[384 + lane]) * rki * kig[lane]);
        if (lane < 8) wi[(size_t)row * 8 + lane] = bf2f(p[448 + lane]) * (0.35355339059327373f * 0.125f);
    }
}

__global__ void __launch_bounds__(NWAVES * 64, 2) mk_fwd(Args args) {
    extern __shared__ __attribute__((aligned(16))) unsigned char lds_raw[];
    LAS unsigned char* lds = (LAS unsigned char*)lds_raw;
    const int wave = __builtin_amdgcn_readfirstlane(threadIdx.x >> 6);
    const int G = gridDim.x; const int bx = blockIdx.x; const int vcu = (G % 8 == 0) ? (bx % 8) * (G / 8) + bx / 8 : bx;
    for (int u = wave * 64 + lane_now(0); u < (LDS_BYTES - LDSCTL_OFF) / 4; u += NWAVES * 64) ((LAS unsigned*)(lds + LDSCTL_OFF))[u] = 0u;
    __syncthreads();
    XcdBarrier bar = xcd_barrier_post((unsigned*)((gu32*)(args.ws + WS_CTL) + CW_BAR) + args.li * XCD_BAR_WORDS, (volatile LAS unsigned*)(lds + MISC_OFF) + 8, wave);
    const int lo = args.ph_lo, hi = args.ph_hi;
#define IN(k) (lo <= (k) && (k) < hi)
#ifndef REP_PHASE
#define REP_PHASE (-1)
#endif
#define PHASE_BEGIN(k) if (IN(k)) { for (int rep_ = 0; rep_ < ((k) == REP_PHASE ? 2 : 1); ++rep_) { if (rep_) xcd_barrier(bar);
#define PHASE_END(k) } } SEAM(k);
#define SEAM(k) do { if (IN(k) && IN((k) + 1)) xcd_barrier(bar); } while (0)
    const int gw = vcu * NWAVES + wave, NGW = G * NWAVES;

    PHASE_BEGIN(PH_PRO) const int lane = fresh_lane(); p0_mod(kargs(PH_PRO), lds, wave * 64 + lane, lane, wave, vcu, G); PHASE_END(PH_PRO)
    PHASE_BEGIN(PH_PRE0) CArgs* A = kargs(PH_PRE0); unsigned char* ws = A->ws; prenorm_rows(A->in[I_X], A->in[I_PREG], (const float*)(ws + WS_MOD), (bf16*)(ws + WS_H), gw, NGW, fresh_lane());
#ifndef REP_W
#define REP_W 1
#endif
        for (int rw_ = 0; rw_ < REP_W; ++rw_) p0_weights(A, lds, fresh_lane(1 + rw_), wave, vcu, G); PHASE_END(PH_PRE0)
    PHASE_BEGIN(PH_INPROJ0)
        CArgs* A = kargs(PH_INPROJ0); unsigned char* ws = A->ws;
        pg8::Gemm g{(const bf16*)(ws + WS_H), (const bf16*)(ws + WS_WIN0), M, A_INP, D, D, D, 0}; pg8::StaticOrder S; S.init(M, A_INP, G, bx);
        pg8::Epi<pg8::EM_PROJ0> E{(bf16*)(ws + WS_PROJ0), A_INP, (float*)(ws + WS_STATS), nullptr, 0};
        pg8::gemm_phase<pg8::Epi<pg8::EM_PROJ0>, pg8::StaticOrder, true, true>(lds + RING_OFF, g, S, E, wave);
    PHASE_END(PH_INPROJ0)
    PHASE_BEGIN(PH_QGEMM)
        CArgs* A = kargs(PH_QGEMM); unsigned char* ws = A->ws;
        pg8::Gemm g{(const bf16*)(ws + WS_PROJ0), (const bf16*)(ws + WS_WQ2), M, NQQ, QR, A_INP, QR, 0}; pg8::StaticOrder S; S.init(M, NQQ, G, bx);
        pg8::Epi<pg8::EM_ROWSCALE> E{(bf16*)(ws + WS_QQ), NQQ, (float*)(ws + WS_STATS), nullptr, 0};
        pg8::gemm_phase<pg8::Epi<pg8::EM_ROWSCALE>, pg8::StaticOrder, true, true>(lds + RING_OFF, g, S, E, wave);
        norm_kv_rows((const bf16*)(ws + WS_PROJ0), (const float*)(ws + WS_STATS), A->in[I_AKVN], A->in[I_AKIN], (bf16*)(ws + WS_CKV), (bf16*)(ws + WS_KI), (float*)(ws + WS_WI), gw, NGW, fresh_lane());
    PHASE_END(PH_QGEMM)
    PHASE_BEGIN(PH_TOPK)
        CArgs* A = kargs(PH_TOPK); unsigned char* ws = A->ws;
        unsigned* sel = (unsigned*)(ws + WS_SEL); const int lane = fresh_lane();
        const bf16* qq = (const bf16*)(ws + WS_QQ); const bf16* ki = (const bf16*)(ws + WS_KI); const float* wi = (const float*)(ws + WS_WI);
        for (int p = vcu; p < NB * 64; p += G) {
            const int b = p >> 6, u = p & 63;
            for (int r2 = 0; r2 < 2; ++r2) topk::unit(qq, ki, wi, sel, b, 16 * (r2 ? 127 - u : u), (LAS unsigned*)(lds + RING_OFF), wave, lane);
        }
    PHASE_END(PH_TOPK)
    PHASE_BEGIN(PH_SPARSE)
        CArgs* A = kargs(PH_SPARSE); unsigned char* ws = A->ws; const Misc* ms = (const Misc*)(ws + WS_MISC);
        const int lane = fresh_lane(); float* btl = (float*)((char*)lds_raw + sparse::BT_OFF);
        for (int i = wave * 64 + lane; i < 128 * 16; i += NWAVES * 64) btl[i] = ms->btab[i] * LOG2E;
        __syncthreads();
        const int per = M / NGW;
        char* wl = (char*)lds_raw + wave * sparse::WAVE_LDS;
        for (int k = 0; k < per; ++k) { const int q = gw * per + k;
            sparse::query((const bf16*)(ws + WS_QQ), (const bf16*)(ws + WS_CKV), (const unsigned*)(ws + WS_SEL), (bf16*)(ws + WS_OLAT), q / L, q % L, wl, btl, lane); }
        for (int q = NGW * per + gw; q < M; q += NGW)
            sparse::query((const bf16*)(ws + WS_QQ), (const bf16*)(ws + WS_CKV), (const unsigned*)(ws + WS_SEL), (bf16*)(ws + WS_OLAT), q / L, q % L, wl, btl, lane);
        __syncthreads();
    PHASE_END(PH_SPARSE)
    PHASE_BEGIN(PH_UV)
        CArgs* A = kargs(PH_UV); unsigned char* ws = A->ws;
        pg8::Gemm g{(const bf16*)(ws + WS_OLAT), (const bf16*)(ws + WS_WUV), M, D, 512, 2048, 512, 512}; pg8::StaticOrder S; S.init(M, D, G, bx);
        pg8::Epi<pg8::EM_UVGATE> E{(bf16*)(ws + WS_OG0), D, nullptr, (const bf16*)(ws + WS_PROJ0) + 456, A_INP};
        pg8::gemm_phase<pg8::Epi<pg8::EM_UVGATE>, pg8::StaticOrder, true, true>(lds + RING_OFF, g, S, E, wave);
    PHASE_END(PH_UV)
    PHASE_BEGIN(PH_OUT0)
        CArgs* A = kargs(PH_OUT0); unsigned char* ws = A->ws;
        pg8::Gemm g{(const bf16*)(ws + WS_OG0), (const bf16*)(ws + WS_WOUT0), M, D, D, D, D, 0}; pg8::StaticOrder S; S.init(M, D, G, bx);
        pg8::Epi<pg8::EM_PLAIN> E{(bf16*)(ws + WS_Y0), D, nullptr, nullptr, 0};
        pg8::gemm_phase<pg8::Epi<pg8::EM_PLAIN>, pg8::StaticOrder, true, true>(lds + RING_OFF, g, S, E, wave);
    PHASE_END(PH_OUT0)
    PHASE_BEGIN(PH_POST0) CArgs* A = kargs(PH_POST0); unsigned char* ws = A->ws; const float* mod = (const float*)(ws + WS_MOD);
        post_rows(A->in[I_X], (const bf16*)(ws + WS_Y0), A->in[I_POSTG], mod, A->in[I_PREG] + D, mod + (size_t)NB * 3072, A->out, (bf16*)(ws + WS_H), gw, NGW, fresh_lane()); PHASE_END(PH_POST0)
    PHASE_BEGIN(PH_INPROJ1)
        CArgs* A = kargs(PH_INPROJ1); unsigned char* ws = A->ws;
        pg8::Gemm g{(const bf16*)(ws + WS_H), (const bf16*)(ws + WS_WIN1), M, B_IN, D, D, D, 0}; pg8::StaticOrder S; S.init(M, B_IN, G, bx);
        pg8::Epi<pg8::EM_PROJ1> E{(bf16*)(ws + WS_PROJ1), B_IN, nullptr, nullptr, 0};
        pg8::gemm_phase<pg8::Epi<pg8::EM_PROJ1>, pg8::StaticOrder, true, true>(lds + RING_OFF, g, S, E, wave);
    PHASE_END(PH_INPROJ1)
    PHASE_BEGIN(PH_ATTN1)
        CArgs* A = kargs(PH_ATTN1); unsigned char* ws = A->ws; const Misc* ms = (const Misc*)(ws + WS_MISC);
        const bf16* proj1 = (const bf16*)(ws + WS_PROJ1); bf16* og1 = (bf16*)(ws + WS_OG1); const float* subln = A->in[I_BSUBLN];
        attn_body::bf16* oscr = (attn_body::bf16*)(ws + WS_OSCR);
        const attn_body::bf16* pj = (const attn_body::bf16*)proj1;
        char* shm = (char*)lds_raw + RING_OFF;
        for (int p = vcu; p < 256; p += G) {
            const int bh = p >> 2, s4 = p & 3, b = bh >> 3, h = bh & 7;
            for (int ui = 0; ui < 2; ++ui) {
                const int qb = ui == 0 ? s4 : 7 - s4;
                attn_body::bf16* ob = oscr + ((size_t)bh * L + qb * 256) * attn_body::OPITCH;
                for (int vi = 0; vi < 4; ++vi) {
                    const int mp = 2 * h + (vi >> 1);
                    attn_body::attn_unit<8>(wave, b, qb, pj + mp * 64, pj + 1024 + mp * 64, pj + 2048 + h * 128 + (vi & 1) * 64, ob + vi * 64, ms->btab + mp, shm);
                }
                asm volatile("s_waitcnt vmcnt(0)" ::: "memory");
                const int lane2 = fresh_lane(qb);
                const int r = wave * 32 + (lane2 & 31), eh = lane2 >> 5, t = qb * 256 + r; const size_t grow = (size_t)b * L + t;
                const v4u* o1p = (const v4u*)((const bf16*)ob + (size_t)r * 256 + eh * 64); const v4u* o2p = o1p + 16;
                const float lam = ms->lam; float o[64]; float ss = 0.f;
#pragma unroll
                for (int c8 = 0; c8 < 8; ++c8) { const v4u a1 = __builtin_nontemporal_load(o1p + c8), a2 = __builtin_nontemporal_load(o2p + c8);
#pragma unroll
                    for (int q = 0; q < 4; ++q) { const float x0 = __uint_as_float(a1[q] << 16) - lam * __uint_as_float(a2[q] << 16), x1 = __uint_as_float(a1[q] & 0xffff0000u) - lam * __uint_as_float(a2[q] & 0xffff0000u);
                        o[c8 * 8 + 2 * q] = x0; o[c8 * 8 + 2 * q + 1] = x1; ss += x0 * x0 + x1 * x1; } }
                ss = xsum32(ss);
                const float rs = rsqrtf(ss * (1.f / 128.f) + EPS) * (1.f - LAMBDA_INIT);
                const v4u* gp = (const v4u*)(proj1 + grow * B_IN + 3072 + h * 128 + eh * 64); const f32x4* sl = (const f32x4*)(subln + eh * 64);
                v4u* op = (v4u*)(og1 + grow * D + h * 128 + eh * 64);
#pragma unroll
                for (int c8 = 0; c8 < 8; ++c8) { const v4u gq = gp[c8]; const f32x4 s0 = sl[2 * c8], s1 = sl[2 * c8 + 1]; v4u w;
#pragma unroll
                    for (int q = 0; q < 4; ++q) { const float g0 = __uint_as_float(gq[q] << 16), g1 = __uint_as_float(gq[q] & 0xffff0000u);
                        const float sa = q < 2 ? s0[2 * q] : s1[2 * q - 4], sb = q < 2 ? s0[2 * q + 1] : s1[2 * q - 3];
                        w[q] = pk2(o[c8 * 8 + 2 * q] * rs * sa * siluf(g0), o[c8 * 8 + 2 * q + 1] * rs * sb * siluf(g1)); }
                    op[c8] = w; }
            }
        }
    PHASE_END(PH_ATTN1)
    PHASE_BEGIN(PH_OUT1)
        CArgs* A = kargs(PH_OUT1); unsigned char* ws = A->ws;
        pg8::Gemm g{(const bf16*)(ws + WS_OG1), (const bf16*)(ws + WS_WOUT1), M, D, D, D, D, 0}; pg8::StaticOrder S; S.init(M, D, G, bx);
        pg8::Epi<pg8::EM_PLAIN> E{(bf16*)(ws + WS_Y1), D, nullptr, nullptr, 0};
        pg8::gemm_phase<pg8::Epi<pg8::EM_PLAIN>, pg8::StaticOrder, true, true>(lds + RING_OFF, g, S, E, wave);
    PHASE_END(PH_OUT1)
    PHASE_BEGIN(PH_FINAL) CArgs* A = kargs(PH_FINAL); unsigned char* ws = A->ws;
        post_rows(A->out, (const bf16*)(ws + WS_Y1), A->in[I_POSTG] + D, (const float*)(ws + WS_MOD) + (size_t)NB * 3072, nullptr, nullptr, A->out, nullptr, gw, NGW, fresh_lane()); } }
#undef IN
#undef SEAM
}

__device__ __forceinline__ float block_sum(float v, float* red) {
    for (int o = 32; o > 0; o >>= 1) v += __shfl_xor(v, o);
    __syncthreads(); if ((threadIdx.x & 63) == 0) red[threadIdx.x >> 6] = v; __syncthreads();
    return red[0] + red[1] + red[2] + red[3];
}
__device__ __forceinline__ unsigned fkey(float f) { unsigned u = __float_as_uint(f); return (u & 0x80000000u) ? ~u : (u | 0x80000000u); }
__global__ void __launch_bounds__(256) k_topk(const bf16_t* qq, const bf16_t* ki, const float* wi, unsigned* sel) {
    __shared__ float qs[512]; __shared__ unsigned keys[2048]; __shared__ unsigned cnts[256]; __shared__ unsigned words[64]; __shared__ float ws[8];
    int row = blockIdx.x, b = row / L, t = row % L, tid = threadIdx.x;
    for (int i = tid; i < 512; i += 256) qs[i] = bf2f(qq[(size_t)row * NQQ + i]);
    if (tid < 8) ws[tid] = wi[(size_t)row * 8 + tid];
    if (tid < 64) words[tid] = 0u;
    __syncthreads();
    for (int s = tid; s < L; s += 256) {
        unsigned kk = 0u;
        if (s <= t) { const bf16_t* kr = ki + ((size_t)b * L + s) * 64; float a0 = 0.f, a1 = 0.f, a2 = 0.f, a3 = 0.f, a4 = 0.f, a5 = 0.f, a6 = 0.f, a7 = 0.f;
            for (int d = 0; d < 64; ++d) { float kf = bf2f(kr[d]); a0 += qs[d] * kf; a1 += qs[64 + d] * kf; a2 += qs[128 + d] * kf; a3 += qs[192 + d] * kf;
                a4 += qs[256 + d] * kf; a5 += qs[320 + d] * kf; a6 += qs[384 + d] * kf; a7 += qs[448 + d] * kf; }
            float sc = ws[0] * fmaxf(a0, 0.f); sc += ws[1] * fmaxf(a1, 0.f); sc += ws[2] * fmaxf(a2, 0.f); sc += ws[3] * fmaxf(a3, 0.f);
            sc += ws[4] * fmaxf(a4, 0.f); sc += ws[5] * fmaxf(a5, 0.f); sc += ws[6] * fmaxf(a6, 0.f); sc += ws[7] * fmaxf(a7, 0.f);
            kk = fkey(sc); }
        keys[s] = kk;
    }
    __syncthreads();
    int nvalid = t + 1;
    if (nvalid <= TOPK) { for (int s = tid; s <= t; s += 256) atomicOr(&words[s >> 5], 1u << (s & 31)); }
    else {
        unsigned prefix = 0u;
        for (int bit = 31; bit >= 0; --bit) {
            unsigned cand = prefix | (1u << bit); unsigned c = 0;
            for (int i = 0; i < 8; ++i) c += keys[tid * 8 + i] >= cand;
            cnts[tid] = c; __syncthreads();
            for (int o = 128; o > 0; o >>= 1) { if (tid < o) cnts[tid] += cnts[tid + o]; __syncthreads(); }
            unsigned tot = cnts[0]; __syncthreads();
            if (tot >= (unsigned)TOPK) prefix = cand;
        }
        unsigned cg = 0, ce = 0; for (int i = 0; i < 8; ++i) { unsigned k = keys[tid * 8 + i]; cg += k > prefix; ce += k == prefix; }
        cnts[tid] = cg; __syncthreads();
        for (int o = 128; o > 0; o >>= 1) { if (tid < o) cnts[tid] += cnts[tid + o]; __syncthreads(); }
        unsigned ngt = cnts[0]; __syncthreads();
        cnts[tid] = ce; __syncthreads();
        if (tid == 0) { unsigned run = 0; for (int i = 0; i < 256; ++i) { unsigned v = cnts[i]; cnts[i] = run; run += v; } }
        __syncthreads();
        unsigned need = TOPK - ngt, rank = cnts[tid];
        for (int i = 0; i < 8; ++i) { int s = tid * 8 + i; unsigned k = keys[s]; bool take = k > prefix; if (k == prefix) { take = rank < need; ++rank; }
            if (take) atomicOr(&words[s >> 5], 1u << (s & 31)); }
    }
    __syncthreads();
    if (tid < 64) sel[(size_t)row * 64 + tid] = words[tid];
}
__global__ void __launch_bounds__(256) k_sparse(const bf16_t* qq, const bf16_t* ckv, const unsigned* sel, const Misc* ms, bf16_t* olat) {
    __shared__ float qa[16 * 128]; __shared__ int idx[256]; __shared__ float lg[16 * 256]; __shared__ int nsel_s;
    int row = blockIdx.x, b = row / L, t = row % L, tid = threadIdx.x;
    for (int i = tid; i < 2048; i += 256) qa[i] = bf2f(qq[(size_t)row * NQQ + 512 + i]);
    if (tid == 0) { int n = 0; for (int w = 0; w < 64; ++w) { unsigned v = sel[(size_t)row * 64 + w]; while (v) { int bpos = __ffs(v) - 1; v &= v - 1; if (n < 256) idx[n] = w * 32 + bpos; ++n; } } nsel_s = n < 256 ? n : 256; }
    __syncthreads();
    int ns = nsel_s;
    for (int p = tid; p < 16 * 256; p += 256) { int h = p >> 8, k = p & 255; float v = -INFINITY;
        if (k < ns) { const bf16_t* kr = ckv + ((size_t)b * L + idx[k]) * 128; float a = 0.f; for (int r = 0; r < 128; ++r) a += qa[h * 128 + r] * bf2f(kr[r]);
            int dd = t - idx[k]; if (dd > 127) dd = 127; v = a + ms->btab[dd * 16 + h] * LOG2E; }
        lg[p] = v; }
    __syncthreads();
    if (tid < 16) { float mx = -INFINITY; for (int k = 0; k < ns; ++k) mx = fmaxf(mx, lg[tid * 256 + k]); float s = 0.f;
        for (int k = 0; k < ns; ++k) { float e = exp2f(lg[tid * 256 + k] - mx); lg[tid * 256 + k] = e; s += e; } float inv = 1.f / s; for (int k = 0; k < ns; ++k) lg[tid * 256 + k] *= inv; }
    __syncthreads();
    for (int o = tid; o < 2048; o += 256) { int h = o >> 7, r = o & 127; float a = 0.f;
        for (int k = 0; k < ns; ++k) a += lg[h * 256 + k] * bf2f(ckv[((size_t)b * L + idx[k]) * 128 + r]);
        olat[(size_t)row * 2048 + o] = f2bf(a); }
}
__global__ void __launch_bounds__(256) k_diffattn(const bf16_t* proj, const Misc* ms, const float* subln, bf16_t* og) {
    __shared__ float q[2][64]; __shared__ float p[2][2048]; __shared__ float red[4]; __shared__ float part[2][128];
    int row = blockIdx.x, h = blockIdx.y, b = row / L, t = row % L, tid = threadIdx.x;
    if (tid < 128) q[tid >> 6][tid & 63] = bf2f(proj[(size_t)row * B_IN + (2 * h + (tid >> 6)) * 64 + (tid & 63)]);
    __syncthreads();
    float mx[2] = {-INFINITY, -INFINITY};
    for (int l = tid; l <= t; l += 256) { int dd = t - l; if (dd > 127) dd = 127;
        for (int j = 0; j < 2; ++j) { const bf16_t* kr = proj + ((size_t)b * L + l) * B_IN + 1024 + (2 * h + j) * 64; float a = 0.f;
            for (int d = 0; d < 64; ++d) a += q[j][d] * bf2f(kr[d]);
            a += ms->btab[dd * 16 + 2 * h + j] * LOG2E; p[j][l] = a; mx[j] = fmaxf(mx[j], a); } }
    float sm[2];
    for (int j = 0; j < 2; ++j) { float m = mx[j]; for (int o = 32; o > 0; o >>= 1) m = fmaxf(m, __shfl_xor(m, o));
        __syncthreads(); if ((tid & 63) == 0) red[tid >> 6] = m; __syncthreads(); m = fmaxf(fmaxf(red[0], red[1]), fmaxf(red[2], red[3]));
        float s = 0.f; for (int l = tid; l <= t; l += 256) { float e = exp2f(p[j][l] - m); p[j][l] = e; s += e; }
        sm[j] = block_sum(s, red); }
    __syncthreads();
    float lam = ms->lam, i0 = 1.f / sm[0], i1 = lam / sm[1];
    int e = tid & 127, half = tid >> 7; float a = 0.f;
    for (int l = half; l <= t; l += 2) a += (p[0][l] * i0 - p[1][l] * i1) * bf2f(proj[((size_t)b * L + l) * B_IN + 2048 + h * 128 + e]);
    part[half][e] = a; __syncthreads();
    float o = part[0][e] + part[1][e];
    float ss = block_sum(half == 0 ? o * o : 0.f, red);
    if (half == 0) { float v = o * rsqrtf(ss / 128.f + EPS) * subln[e] * (1.f - LAMBDA_INIT);
        float gte = bf2f(proj[(size_t)row * B_IN + 3072 + h * 128 + e]);
        og[(size_t)row * D + h * 128 + e] = f2bf(v * siluf(gte)); }
}


extern "C" void kernel_launch(void* const* d_in, const int* in_sizes, int n_in, void* d_out, int out_size, void* d_ws, size_t ws_size, hipStream_t stream) {
    (void)in_sizes; (void)out_size; (void)ws_size;
    static int grid = 0;
    if (grid == 0) {
        int dev = 0, cus = 0;
        if (n_in != N_IN || hipGetDevice(&dev) != hipSuccess || hipDeviceGetAttribute(&cus, hipDeviceAttributeMultiprocessorCount, dev) != hipSuccess) { grid = -1; return; }
        if (hipFuncSetAttribute((const void*)mk_fwd, hipFuncAttributeMaxDynamicSharedMemorySize, LDS_BYTES) != hipSuccess) { grid = -1; return; }
        grid = cus;
    }
    if (grid < 0) return;
    char* ws = (char*)d_ws;
    hipMemsetAsync(ws + WS_CTL, 0, CTL_ZERO_BYTES, stream);
    Args a{};
    for (int i = 0; i < N_IN; ++i) a.in[i] = (const float*)d_in[i];
    a.out = (float*)d_out; a.ws = (unsigned char*)d_ws;
    int li = 0;
    auto run = [&](int lo, int hi) { a.ph_lo = lo; a.ph_hi = hi; a.li = li++; hipLaunchKernelGGL(mk_fwd, dim3(grid), dim3(NWAVES * 64), LDS_BYTES, stream, a); };
    Misc* ms = (Misc*)(ws + WS_MISC);
    bf16_t *ckv = (bf16_t*)(ws + WS_CKV), *ki = (bf16_t*)(ws + WS_KI); float* wi = (float*)(ws + WS_WI); unsigned* sel = (unsigned*)(ws + WS_SEL);
    bf16_t *qq = (bf16_t*)(ws + WS_QQ), *olat = (bf16_t*)(ws + WS_OLAT), *proj1 = (bf16_t*)(ws + WS_PROJ1), *og1 = (bf16_t*)(ws + WS_OG1);
#ifdef PROBE_PHASE
    run(PH_PRO, PROBE_PHASE + 1); run(PROBE_PHASE, PROBE_PHASE + 1); if (PROBE_PHASE + 1 < N_PHASES) run(PROBE_PHASE + 1, PH_FINAL + 1);
#else
    run(PH_PRO, PH_FINAL + 1);
#endif
}
```

```cpp
#include <hip/hip_runtime.h>
#include <stdint.h>
#include <math.h>
#include <cstdio>
#include <hip/hip_bf16.h>

constexpr int NB = 8, L = 2048, D = 1024, M = NB * L;
constexpr int A_IN = 1480, A_INP = 1536, QR = 256, TOPK = 256;
constexpr int NQQ = 512 + 2048;
constexpr int B_IN = 4096, BH = 8;
constexpr float EPS = 1e-6f;
constexpr float LOG2E = 1.4426950408889634f;
constexpr float C2 = 0.125f * LOG2E;
constexpr float LAMBDA_INIT = 0.35550906759096934f;

constexpr size_t MiB = 1u << 20;
constexpr size_t WS_CTL = 0, CTL_ZERO_BYTES = 256 * 1024;
constexpr size_t WS_MOD = 512 * 1024;
constexpr size_t WS_MISC = 768 * 1024;
constexpr size_t WS_WIN0 = 1 * MiB;
constexpr size_t WS_WQ2 = 4 * MiB;
constexpr size_t WS_WUV = 6 * MiB;
constexpr size_t WS_WOUT0 = 7 * MiB;
constexpr size_t WS_WIN1 = 9 * MiB;
constexpr size_t WS_WOUT1 = 17 * MiB;
constexpr size_t WS_STATS = 19 * MiB;
constexpr size_t WS_CKV = 20 * MiB;
constexpr size_t WS_KI = 24 * MiB;
constexpr size_t WS_WI = 26 * MiB;
constexpr size_t WS_SEL = 28 * MiB;
constexpr size_t WS_H = 32 * MiB;
constexpr size_t WS_PROJ0 = 64 * MiB;
constexpr size_t WS_QQ = 112 * MiB;
constexpr size_t WS_OLAT = 192 * MiB;
constexpr size_t WS_OG0 = 112 * MiB;
constexpr size_t WS_Y0 = 144 * MiB;
constexpr size_t WS_PROJ1 = 64 * MiB;
constexpr size_t WS_OSCR = 192 * MiB;
constexpr size_t WS_OG1 = 32 * MiB;
constexpr size_t WS_Y1 = 64 * MiB;
constexpr int CW_BAR = 4096;

struct Misc { float lam; int pad[31]; int lut[128]; float btab[128 * 16]; };

enum { I_X = 0, I_C, I_RELB, I_MODW, I_MODB, I_PREG, I_POSTG, I_AWIN, I_AQN, I_AKVN, I_AKIN, I_AWUQ, I_AWQIDX, I_AWUK, I_AWUV, I_AWOUT,
       I_BWIN, I_BLQ1, I_BLK1, I_BLQ2, I_BLK2, I_BSUBLN, I_BWOUT, N_IN };

__device__ __forceinline__ float siluf(float v) { return v * __builtin_amdgcn_rcpf(1.f + __builtin_amdgcn_exp2f(-1.4426950408889634f * v)); }
__device__ __forceinline__ float bf2f(unsigned short v) { return __uint_as_float((unsigned)v << 16); }
__device__ __forceinline__ float xsum32(float v) { auto r = __builtin_amdgcn_permlane32_swap(__float_as_uint(v), __float_as_uint(v), false, false); return __uint_as_float(r[0]) + __uint_as_float(r[1]); }
__device__ __forceinline__ float xsum16(float v) { auto r = __builtin_amdgcn_permlane16_swap(__float_as_uint(v), __float_as_uint(v), false, false); return __uint_as_float(r[0]) + __uint_as_float(r[1]); }
template <int CTRL> __device__ __forceinline__ float dpp_f(float v) { return __uint_as_float((unsigned)__builtin_amdgcn_update_dpp(0, (int)__float_as_uint(v), CTRL, 0xF, 0xF, true)); }
__device__ __forceinline__ float wave_sum_all(float v) {
    v += dpp_f<0xB1>(v);
    v += dpp_f<0x4E>(v);
    v += dpp_f<0x141>(v);
    v += dpp_f<0x140>(v);
    v = xsum16(v); return xsum32(v);
}
typedef unsigned short bf16_t;
#define GAS __attribute__((address_space(1)))
#define LAS __attribute__((address_space(3)))
typedef unsigned short bf16;
typedef unsigned v4u __attribute__((ext_vector_type(4)));
typedef float f32x4 __attribute__((ext_vector_type(4)));
typedef short bf16x8 __attribute__((ext_vector_type(8)));
typedef GAS unsigned gu32;
typedef GAS unsigned long long gu64;
#define RLX_AGENT __ATOMIC_RELAXED, __HIP_MEMORY_SCOPE_AGENT
#define LDS_WAIT() asm volatile("s_waitcnt lgkmcnt(0)" ::: "memory")
#define VM_WAIT() asm volatile("s_waitcnt vmcnt(0)" ::: "memory")
__device__ __forceinline__ unsigned long long rt() { return __builtin_amdgcn_s_memrealtime(); }
__device__ __forceinline__ unsigned f2bf(float f) { unsigned u = __builtin_bit_cast(unsigned, f); return (u + 0x7fffu + ((u >> 16) & 1u)) >> 16; }
__device__ __forceinline__ unsigned pk2(float lo, float hi) { return f2bf(lo) | (f2bf(hi) << 16); }

#define XB_TMO      128
#define XB_XCNT(j)  (256  + 64 * (j))
#define XB_XSUB(j)  (1280 + 64 * (j))
#define XB_XGEN(j)  (2304 + 64 * (j))
#define XB_TOP      3328
#define XB_TOPGEN   3392
#define XCD_BAR_WORDS 3456
#define XB_SPIN_CAP (1u << 18)

__device__ __forceinline__ unsigned xb_ld(unsigned* p)              { return __hip_atomic_load(p, __ATOMIC_RELAXED, __HIP_MEMORY_SCOPE_AGENT); }
__device__ __forceinline__ unsigned xb_add(unsigned* p, unsigned v) { return __hip_atomic_fetch_add(p, v, __ATOMIC_RELAXED, __HIP_MEMORY_SCOPE_AGENT); }
__device__ __forceinline__ unsigned xb_xcc_id() { return (unsigned)__builtin_amdgcn_s_getreg((3 << 11) | 20) & 0xFu; }
#define XB_SPIN(cond, bar) do { unsigned _sp = 0; while (cond) { __builtin_amdgcn_s_sleep(1); \
    if ((++_sp & 255u) == 0u) { if (xb_ld(&(bar)[XB_TMO])) break; if (_sp > XB_SPIN_CAP) { atomicAdd(&(bar)[XB_TMO], 1u); break; } } } } while (0)

__device__ __forceinline__ int lane_now(int dep) { int l; asm volatile("v_mbcnt_lo_u32_b32 %0, -1, 0\n\tv_mbcnt_hi_u32_b32 %0, -1, %0 ; dep %1" : "=v"(l) : "s"(dep)); return l; }
struct XcdBarrier {
    unsigned* bar; unsigned x; int wave;
    volatile LAS unsigned* st;
};

__device__ __forceinline__ XcdBarrier xcd_barrier_post(unsigned* bar, volatile LAS unsigned* st, int wave) {
    XcdBarrier b; b.bar = bar; b.x = xb_xcc_id(); b.st = st; b.wave = wave;
    if (wave == 0 && lane_now(0) == 0) (void)xb_add(&bar[XB_XCNT(b.x)], 1u);
    return b;
}
__device__ __forceinline__ void xcd_barrier_complete(unsigned* bar, unsigned x, unsigned& nloc, unsigned& nx) {
    const unsigned G = gridDim.x * gridDim.y * gridDim.z;
    unsigned sum, cnt, mine, sp = 0u;
    for (;;) {
        sum = 0u; cnt = 0u; mine = 0u;
#pragma unroll
        for (unsigned j = 0; j < 16; ++j) { const unsigned c = xb_ld(&bar[XB_XCNT(j)]); sum += c; cnt += (c > 0u) ? 1u : 0u; mine = (j == x) ? c : mine; }
        if (sum == G) break;
        __builtin_amdgcn_s_sleep(1);
        if ((++sp & 255u) == 0u) { if (xb_ld(&bar[XB_TMO])) break; if (sp > XB_SPIN_CAP) { atomicAdd(&bar[XB_TMO], 1u); break; } }
    }
    nloc = mine > 0u ? mine : 1u; nx = cnt > 0u ? cnt : 1u;
}

__device__ __forceinline__ void xcd_barrier(const XcdBarrier& b) {
    asm volatile("s_waitcnt vmcnt(0)" ::: "memory");
    __syncthreads();
    if (b.wave == 0 && lane_now(1) == 0) {
        unsigned* bar = b.bar;
        __builtin_amdgcn_s_waitcnt(0);
        unsigned nloc = b.st[0], nx = b.st[1];
        if (nloc == 0u) { xcd_barrier_complete(bar, b.x, nloc, nx); b.st[0] = nloc; b.st[1] = nx; }
        const unsigned old = xb_add(&bar[XB_XSUB(b.x)], 1u);
        const unsigned gen = old / nloc;
        if (old + 1u == (gen + 1u) * nloc) {
            __builtin_amdgcn_fence(__ATOMIC_RELEASE, "agent");
            asm volatile("s_waitcnt vmcnt(0)" ::: "memory");
            const unsigned og = xb_add(&bar[XB_TOP], 1u);
            const unsigned tg = og / nx;
            if (og + 1u == (tg + 1u) * nx) xb_add(&bar[XB_TOPGEN], 1u);
            else XB_SPIN(xb_ld(&bar[XB_TOPGEN]) == tg, bar);
            __builtin_amdgcn_fence(__ATOMIC_ACQUIRE, "agent");
            xb_add(&bar[XB_XGEN(b.x)], 1u);
            asm volatile("s_waitcnt vmcnt(0)" ::: "memory");
        } else {
            XB_SPIN(xb_ld(&bar[XB_XGEN(b.x)]) == gen, bar);
            __builtin_amdgcn_fence(__ATOMIC_ACQUIRE, "agent");
            asm volatile("s_waitcnt vmcnt(0)" ::: "memory");
        }
    }
    __syncthreads();
}
namespace pg8 {
#define PG8_LAS __attribute__((address_space(3)))
typedef unsigned short bf16_t;
typedef short bf16x8 __attribute__((ext_vector_type(8)));
typedef float f32x4 __attribute__((ext_vector_type(4)));
typedef unsigned u32x4 __attribute__((ext_vector_type(4)));
constexpr int BM = 256, BK = 64, HALF = 128, HTB = HALF * BK * 2  , STAGE_BYTES = 8 * HTB, NXCD = 8, WGM = 8;

__host__ __device__ __forceinline__ int lds_byte(int r, int c) { const int st = (r >> 4) * 2 + (c >> 5), rr = r & 15, cc = c & 31, ob = rr * 64 + cc * 2; return st * 1024 + (ob ^ (((ob >> 9) & 1) << 5)); }
__host__ __device__ __forceinline__ void stage_rc(int b, int& R, int& C) { const int st = b / 1024, sb = b % 1024, swz = sb ^ (((sb >> 9) & 1) << 5); R = (st >> 1) * 16 + swz / 64; C = (st & 1) * 32 + (swz % 64) / 2; }
__host__ __device__ __forceinline__ int perm32(int rho) { const int n = rho >> 4, i = rho & 15; return 8 * (i >> 2) + 4 * n + (i & 3); }

struct Unit { int pm, pn; };
struct Gemm { const bf16_t* A; const bf16_t* Bt; int M, N, K, lda, ldb, a_koff_pn; };

struct StaticOrder {
    int nM, nN, nwg, G, c;
    __host__ __device__ void init(int M, int N, int G_, int c_) { nM = M / BM; nN = N / BM; nwg = nM * nN; G = G_; c = c_; }
    __host__ __device__ bool next(int i, Unit& u) const {
        const long L = (long)i * G + c; if (L >= nwg) return false;
        int wgid = (int)L; { const int q = nwg / NXCD, r = nwg % NXCD, xcd = wgid % NXCD, off = wgid / NXCD; wgid = (xcd < r ? xcd * (q + 1) : r * (q + 1) + (xcd - r) * q) + off; }
        const int nig = WGM * nN, gid = wgid / nig, fm = gid * WGM, gsz = (nM - fm) < WGM ? (nM - fm) : WGM;
        u.pm = fm + ((wgid % nig) % gsz); u.pn = (wgid % nig) / gsz; return true;
    }
    __device__ __forceinline__ void a_ready(const Unit&) const {}
    __device__ __forceinline__ void done(const Unit&) const {}
};
__device__ __forceinline__ unsigned cvt_pk_bf16(float lo, float hi) { unsigned r; asm volatile("v_cvt_pk_bf16_f32 %0, %1, %2" : "=v"(r) : "v"(lo), "v"(hi)); return r; }
typedef float f32x2 __attribute__((ext_vector_type(2)));
enum { EM_PLAIN = 0, EM_PROJ0 = 1, EM_ROWSCALE = 2, EM_UVGATE = 3, EM_PROJ1 = 4 };
template <int MODE> struct Epi {
    static constexpr bool PERM = true, AFTER_DRAIN = false;
    bf16_t* O; int ldc; float* stats; const bf16_t* gate; int ldg;
    __device__ __forceinline__ void operator()(const f32x4 (&acc)[2][2][4][2], const Unit& u, int wr, int wc, int fr, int fq) const {
        const int row0 = u.pm * BM + wr * 64 + fr, col0 = u.pn * BM + wc * 32 + 8 * fq;
#pragma unroll
        for (int ai = 0; ai < 2; ++ai)
#pragma unroll
            for (int m = 0; m < 4; ++m) {
                const int row = row0 + ai * HALF + m * 16;
                float rs = 1.f;
                if (MODE == EM_ROWSCALE) { const f32x4 s = *(const f32x4*)(stats + (size_t)row * 16); rs = rsqrtf(((s[0] + s[1]) + (s[2] + s[3])) * (1.f / 256.f) + 1e-6f); }
                if (MODE == EM_PROJ1) rs = (u.pn < 4) ? (0.125f * 1.4426950408889634f) : 1.f;
                float ss[2] = {0.f, 0.f};
#pragma unroll
                for (int bj = 0; bj < 2; ++bj) {
                    f32x4 v0 = acc[ai][bj][m][0] * rs, v1 = acc[ai][bj][m][1] * rs;
                    if (MODE == EM_PROJ0) ss[bj] = ((v0[0] * v0[0] + v0[1] * v0[1]) + (v0[2] * v0[2] + v0[3] * v0[3])) + ((v1[0] * v1[0] + v1[1] * v1[1]) + (v1[2] * v1[2] + v1[3] * v1[3]));
                    if (MODE == EM_UVGATE) { const u32x4 gw = *(const u32x4*)(gate + (size_t)row * ldg + col0 + bj * HALF);
#pragma unroll
                        for (int q = 0; q < 4; ++q) { const float g0 = __uint_as_float(gw[q] << 16), g1 = __uint_as_float(gw[q] & 0xffff0000u);
                            const float s0 = g0 * __builtin_amdgcn_rcpf(1.f + __builtin_amdgcn_exp2f(-1.4426950408889634f * g0)), s1 = g1 * __builtin_amdgcn_rcpf(1.f + __builtin_amdgcn_exp2f(-1.4426950408889634f * g1));
                            if (q < 2) { v0[2 * q] *= s0; v0[2 * q + 1] *= s1; } else { v1[2 * q - 4] *= s0; v1[2 * q - 3] *= s1; } } }
                    u32x4 w; w.x = cvt_pk_bf16(v0[0], v0[1]); w.y = cvt_pk_bf16(v0[2], v0[3]); w.z = cvt_pk_bf16(v1[0], v1[1]); w.w = cvt_pk_bf16(v1[2], v1[3]);
                    *(u32x4*)(O + (size_t)row * ldc + col0 + bj * HALF) = w; }
                if (MODE == EM_PROJ0) { if (u.pn < 2) {
                    float a = ss[0], b = ss[1];
                    a = xsum32(xsum16(a)); b = xsum32(xsum16(b));
                    if (fq == 0) { if (u.pn == 0) stats[(size_t)row * 16 + wc] = a + b; else { stats[(size_t)row * 16 + 4 + wc] = a; if (wc < 2) stats[(size_t)row * 16 + 8 + wc] = b; } } } }
            }
    }
};

template <class Epi, class Sched, bool ALIGN_EPI = false, bool SP2 = false>
__device__ __forceinline__ void gemm_phase(PG8_LAS unsigned char* lds, const Gemm g, const Sched& S, const Epi& E, const int wid) {
    const int lane = lane_now(g.N), tid = wid * 64 + lane, wr = wid >> 2, wc = wid & 3, fr = lane & 15, fq = lane >> 4;
    const int K = g.K, nt = K / BK;
    unsigned voffA[2], voffB[2];
#pragma unroll
    for (int i = 0; i < 2; ++i) { int R, C; stage_rc(tid * 16 + i * 8192, R, C); const int Rb = Epi::PERM ? ((R & ~31) + perm32(R & 31)) : R;
        voffA[i] = (unsigned)(R * g.lda + C) * 2u; voffB[i] = (unsigned)(Rb * g.ldb + C) * 2u; }
    const size_t kstep = (size_t)(BK * 2);
    const size_t hstepA = (size_t)HALF * g.lda * 2, hstepB = (size_t)HALF * g.ldb * 2;
    const size_t tstepA = 2 * hstepA, tstepB = 2 * hstepB, aoffpn = (size_t)g.a_koff_pn * 2;
    const unsigned ldsw = (unsigned)wid * 1024u;
    const int aoff = lds_byte(wr * 64 + fr, fq * 8), boff = lds_byte(wc * 32 + fr, fq * 8);
#define PG8_SA(b, h) (((b) * 2 + (h)) * HTB)
#define PG8_SB(b, h) ((4 + (b) * 2 + (h)) * HTB)
#define PG8_STAGE(bufoff, gbase, voff) do { _Pragma("unroll") for (int _i = 0; _i < 2; ++_i) \
        __builtin_amdgcn_global_load_lds((const unsigned*)((const char*)(gbase) + (voff)[_i]), (PG8_LAS unsigned*)(lds + (bufoff) + ldsw + _i * 8192), 16, 0, 0); } while (0)
#define PG8_LDA(dst, b, h) do { _Pragma("unroll") for (int m = 0; m < 4; ++m) _Pragma("unroll") for (int k = 0; k < 2; ++k) dst[m][k] = *(const PG8_LAS bf16x8*)(lds + PG8_SA(b, h) + aoff + m * 2048 + k * 1024); } while (0)
#define PG8_LDB(dst, b, h) do { _Pragma("unroll") for (int n = 0; n < 2; ++n) _Pragma("unroll") for (int k = 0; k < 2; ++k) dst[n][k] = *(const PG8_LAS bf16x8*)(lds + PG8_SB(b, h) + boff + n * 2048 + k * 1024); } while (0)
#define PG8_MMA(ai, bj, At, Bt) do { __builtin_amdgcn_s_setprio(1); _Pragma("unroll") for (int m = 0; m < 4; ++m) _Pragma("unroll") for (int n = 0; n < 2; ++n) _Pragma("unroll") for (int k = 0; k < 2; ++k) \
        acc[ai][bj][m][n] = __builtin_amdgcn_mfma_f32_16x16x32_bf16(Bt[n][k], At[m][k], acc[ai][bj][m][n], 0, 0, 0); __builtin_amdgcn_s_setprio(0); } while (0)
#define PG8_WAIT_V(n) asm volatile("s_waitcnt vmcnt(" #n ")" ::: "memory")
#define PG8_WAIT_L(n) asm volatile("s_waitcnt lgkmcnt(" #n ")" ::: "memory")
#define PG8_BAR __builtin_amdgcn_s_barrier()
#define PG8_SCHED __builtin_amdgcn_sched_barrier(0)
    Unit cur, nxt; int ui = 0;
    if (!S.next(0, cur)) return;
    f32x4 acc[2][2][4][2];
#pragma unroll
    for (int a = 0; a < 2; ++a)
#pragma unroll
        for (int b = 0; b < 2; ++b)
#pragma unroll
            for (int m = 0; m < 4; ++m)
#pragma unroll
                for (int n = 0; n < 2; ++n) acc[a][b][m][n] = (f32x4){0.f, 0.f, 0.f, 0.f};
    bf16x8 At[4][2], B0[2][2], B1[2][2];
    const char* cA = (const char*)g.A + (size_t)cur.pm * tstepA + (size_t)cur.pn * aoffpn; const char* cB = (const char*)g.Bt + (size_t)cur.pn * tstepB;
    S.a_ready(cur);
    if constexpr (SP2) {
        PG8_STAGE(PG8_SB(0, 0), cB, voffB); PG8_STAGE(PG8_SB(0, 1), cB + hstepB, voffB); PG8_STAGE(PG8_SA(0, 0), cA, voffA); PG8_STAGE(PG8_SA(0, 1), cA + hstepA, voffA);
        if (wr == 1) PG8_BAR;
        PG8_WAIT_V(2); PG8_BAR;
        PG8_STAGE(PG8_SB(1, 0), cB + kstep, voffB); PG8_STAGE(PG8_SA(1, 0), cA + kstep, voffA); PG8_STAGE(PG8_SB(1, 1), cB + hstepB + kstep, voffB);
        PG8_WAIT_V(6); PG8_BAR;
    } else {
        PG8_STAGE(PG8_SB(0, 0), cB, voffB); PG8_STAGE(PG8_SA(0, 0), cA, voffA); PG8_STAGE(PG8_SB(0, 1), cB + hstepB, voffB); PG8_STAGE(PG8_SA(0, 1), cA + hstepA, voffA);
        if (wr == 1) PG8_BAR;
        PG8_WAIT_V(4); PG8_BAR;
        PG8_STAGE(PG8_SB(1, 0), cB + kstep, voffB); PG8_STAGE(PG8_SA(1, 0), cA + kstep, voffA); PG8_STAGE(PG8_SB(1, 1), cB + hstepB + kstep, voffB);
        PG8_WAIT_V(6); PG8_BAR;
    }
    for (;;) {
        const bool has_next = S.next(ui + 1, nxt);
        const char* nA = has_next ? (const char*)g.A + (size_t)nxt.pm * tstepA + (size_t)nxt.pn * aoffpn : cA; const char* nB = has_next ? (const char*)g.Bt + (size_t)nxt.pn * tstepB : cB;
        for (int t = 0; t < nt; t += 2) {
            const bool last = (t == nt - 2);
            const char* a1 = cA + (size_t)(t + 1) * kstep;
            const char* a2 = last ? nA : cA + (size_t)(t + 2) * kstep; const char* b2 = last ? nB : cB + (size_t)(t + 2) * kstep;
            const char* a3 = a2 + kstep; const char* b3 = b2 + kstep;
            if (last && has_next) S.a_ready(nxt);
            if constexpr (SP2) {
            PG8_LDB(B0, 0, 0); PG8_LDB(B1, 0, 1); PG8_SCHED; PG8_LDA(At, 0, 0); PG8_STAGE(PG8_SA(1, 1), a1 + hstepA, voffA);
            PG8_WAIT_V(8); PG8_WAIT_L(0); PG8_BAR; PG8_MMA(0, 0, At, B0); PG8_MMA(0, 1, At, B1); PG8_BAR; PG8_SCHED;
            PG8_LDA(At, 0, 1); PG8_STAGE(PG8_SB(0, 0), b2, voffB); PG8_STAGE(PG8_SB(0, 1), b2 + hstepB, voffB); PG8_STAGE(PG8_SA(0, 0), a2, voffA);
            PG8_WAIT_V(8); PG8_WAIT_L(0); PG8_BAR; PG8_MMA(1, 0, At, B0); PG8_MMA(1, 1, At, B1); PG8_BAR; PG8_SCHED;
            PG8_LDB(B0, 1, 0); PG8_LDB(B1, 1, 1); PG8_SCHED; PG8_LDA(At, 1, 0); PG8_STAGE(PG8_SA(0, 1), a2 + hstepA, voffA);
            PG8_WAIT_V(8); PG8_WAIT_L(0); PG8_BAR; PG8_MMA(0, 0, At, B0); PG8_MMA(0, 1, At, B1); PG8_BAR; PG8_SCHED;
            PG8_LDA(At, 1, 1); PG8_STAGE(PG8_SB(1, 0), b3, voffB); PG8_STAGE(PG8_SB(1, 1), b3 + hstepB, voffB); PG8_STAGE(PG8_SA(1, 0), a3, voffA);
            PG8_WAIT_V(8); PG8_WAIT_L(0); PG8_BAR; PG8_MMA(1, 0, At, B0); PG8_MMA(1, 1, At, B1); PG8_BAR; PG8_SCHED;
            } else {
            PG8_LDB(B0, 0, 0); PG8_SCHED; PG8_LDA(At, 0, 0); PG8_STAGE(PG8_SA(1, 1), a1 + hstepA, voffA);
            PG8_WAIT_L(8); PG8_BAR; PG8_WAIT_L(0); PG8_MMA(0, 0, At, B0); PG8_BAR; PG8_SCHED;
            PG8_LDB(B1, 0, 1); PG8_STAGE(PG8_SB(0, 0), b2, voffB);
            PG8_BAR; PG8_WAIT_L(0); PG8_MMA(0, 1, At, B1); PG8_BAR;
            PG8_LDA(At, 0, 1); PG8_STAGE(PG8_SA(0, 0), a2, voffA);
            PG8_BAR; PG8_WAIT_L(0); PG8_MMA(1, 0, At, B0); PG8_BAR; PG8_SCHED;
            PG8_STAGE(PG8_SB(0, 1), b2 + hstepB, voffB);
            PG8_WAIT_V(6); PG8_BAR; PG8_MMA(1, 1, At, B1); PG8_BAR;
            PG8_LDB(B0, 1, 0); PG8_SCHED; PG8_LDA(At, 1, 0); PG8_STAGE(PG8_SA(0, 1), a2 + hstepA, voffA);
            PG8_WAIT_L(8); PG8_BAR; PG8_WAIT_L(0); PG8_MMA(0, 0, At, B0); PG8_BAR; PG8_SCHED;
            PG8_LDB(B1, 1, 1); PG8_STAGE(PG8_SB(1, 0), b3, voffB);
            PG8_BAR; PG8_WAIT_L(0); PG8_MMA(0, 1, At, B1); PG8_BAR;
            PG8_LDA(At, 1, 1); PG8_STAGE(PG8_SA(1, 0), a3, voffA);
            PG8_BAR; PG8_WAIT_L(0); PG8_MMA(1, 0, At, B0); PG8_BAR; PG8_SCHED;
            PG8_STAGE(PG8_SB(1, 1), b3 + hstepB, voffB);
            PG8_WAIT_V(6); PG8_BAR; PG8_MMA(1, 1, At, B1); PG8_BAR;
            }
        }
        if constexpr (ALIGN_EPI) { if (wr == 0) PG8_BAR; }
        if constexpr (!Epi::AFTER_DRAIN) { E(acc, cur, wr, wc, fr, fq); S.done(cur); }
        if (!has_next) break;
#pragma unroll
        for (int a = 0; a < 2; ++a)
#pragma unroll
            for (int b = 0; b < 2; ++b)
#pragma unroll
                for (int m = 0; m < 4; ++m)
#pragma unroll
                    for (int n = 0; n < 2; ++n) acc[a][b][m][n] = (f32x4){0.f, 0.f, 0.f, 0.f};
        cur = nxt; cA = nA; cB = nB; ++ui;
        if constexpr (ALIGN_EPI) { if (wr == 1) PG8_BAR; }
    }
    PG8_WAIT_V(0);
    if constexpr (!ALIGN_EPI) { if (wr == 0) PG8_BAR; }
    PG8_BAR;
    if constexpr (Epi::AFTER_DRAIN) { E.fused(acc, cur, wr, wc, fr, fq, lds, wid, lane); S.done(cur); }
#undef PG8_SA
#undef PG8_SB
#undef PG8_STAGE
#undef PG8_LDA
#undef PG8_LDB
#undef PG8_MMA
#undef PG8_WAIT_V
#undef PG8_WAIT_L
#undef PG8_BAR
#undef PG8_SCHED
}
}
namespace attn_body {
using bf16=__hip_bfloat16;
using bf16x8=__attribute__((ext_vector_type(8)))short;
using s16x4=__attribute__((ext_vector_type(4)))short;
using f32x16=__attribute__((ext_vector_type(16)))float;
using u32x4=__attribute__((ext_vector_type(4)))unsigned;
constexpr int SEQ=2048,D=64,DM=4096,OPITCH=256;
constexpr int NW=8,QBLK=32,QB=QBLK*NW,KVBLK=64,NQB=SEQ/QB;
constexpr int ATTN_UNIT_ROWS=QB;
__device__ __forceinline__ int crow(int r,int hi){return (r&3)+8*(r>>2)+4*hi;}
#define SBAR() __builtin_amdgcn_sched_barrier(0)
__device__ __forceinline__ void cmask(f32x16&p0,f32x16&p1,int jb,int qrel,int hi){
  const float NEG=-INFINITY; int x=qrel-(64*jb+4*hi); asm volatile("":"+v"(x));
  #pragma unroll
  for(int r=0;r<16;++r){const int c=(r&3)+8*(r>>2); if(c>x)p0[r]=NEG; if(c+32>x)p1[r]=NEG;}
}

constexpr int NSLOT=3, SLOTB=8192;
constexpr int LDS_K=0, LDS_V=NSLOT*SLOTB, LDS_WS=2*NSLOT*SLOTB, LDS_OST=LDS_WS+NW*64*4, LDS_BT=LDS_OST+NW*4096, BT_N=704, LDS_BYTES=LDS_BT+BT_N*4;
constexpr float C2=0.125f*1.4426950408889634f;
__device__ __forceinline__ void glds16(const void*gsrc,unsigned lds_dst){unsigned keep;
  asm volatile("s_mov_b32 %0, m0\n\ts_mov_b32 m0, %2\n\ts_nop 0\n\tglobal_load_lds_dwordx4 %1, off\n\ts_mov_b32 m0, %0":"=&s"(keep):"v"(gsrc),"s"(lds_dst):"memory");}
__device__ __forceinline__ float max3f(float a,float b,float c){float r;asm("v_max3_f32 %0, %1, %2, %3":"=v"(r):"v"(a),"v"(b),"v"(c));return r;}
__device__ __forceinline__ float max2f(float a,float b){float r;asm("v_max_f32_e32 %0, %1, %2":"=v"(r):"v"(a),"v"(b));return r;}
__device__ __forceinline__ float fadd_s(float a,float b){float r;asm("v_add_f32_e32 %0, %1, %2":"=v"(r):"v"(a),"v"(b));return r;}
__device__ __forceinline__ float fsub_s(float a,float b){float r;asm("v_sub_f32_e32 %0, %1, %2":"=v"(r):"v"(a),"v"(b));return r;}
typedef float f32x2_t __attribute__((ext_vector_type(2))); typedef __bf16 bf16x2_t __attribute__((ext_vector_type(2)));
__device__ __forceinline__ unsigned cvtpk_s(float lo,float hi){f32x2_t v={lo,hi};bf16x2_t b=__builtin_convertvector(v,bf16x2_t);return __builtin_bit_cast(unsigned,b);}
#define WAIT_BAR(N) asm volatile("s_waitcnt vmcnt(" #N ") lgkmcnt(0)\n\ts_barrier":::"memory")

__device__ __forceinline__ void qkt(f32x16&p0,f32x16&p1,const char*Kslot,const bf16x8*qr,int r32,int hi){
  const char*kb=Kslot+hi*1024+r32*16;
  #pragma unroll
  for(int d0=0;d0<4;++d0){
    const bf16x8 b0=*reinterpret_cast<const bf16x8*>(kb+d0*2048);
    const bf16x8 b1=*reinterpret_cast<const bf16x8*>(kb+d0*2048+512);
    if(d0==0){p0=__builtin_amdgcn_mfma_f32_32x32x16_bf16(b0,qr[0],f32x16{},0,0,0);p1=__builtin_amdgcn_mfma_f32_32x32x16_bf16(b1,qr[0],f32x16{},0,0,0);}
    else{p0=__builtin_amdgcn_mfma_f32_32x32x16_bf16(b0,qr[d0],p0,0,0,0);p1=__builtin_amdgcn_mfma_f32_32x32x16_bf16(b1,qr[d0],p1,0,0,0);}}
}
typedef __attribute__((address_space(3))) const char* lds_cptr;
typedef short v4i16_t __attribute__((ext_vector_type(4)));
__device__ __forceinline__ void kload8(bf16x8*kf,lds_cptr kp){
  kf[0]=*(const __attribute__((address_space(3))) bf16x8*)(kp);      kf[1]=*(const __attribute__((address_space(3))) bf16x8*)(kp+512);
  kf[2]=*(const __attribute__((address_space(3))) bf16x8*)(kp+2048); kf[3]=*(const __attribute__((address_space(3))) bf16x8*)(kp+2560);
  kf[4]=*(const __attribute__((address_space(3))) bf16x8*)(kp+4096); kf[5]=*(const __attribute__((address_space(3))) bf16x8*)(kp+4608);
  kf[6]=*(const __attribute__((address_space(3))) bf16x8*)(kp+6144); kf[7]=*(const __attribute__((address_space(3))) bf16x8*)(kp+6656);
}
__device__ __forceinline__ void kload2(bf16x8*kf,lds_cptr kp,int j){ kf[2*j]=*(const __attribute__((address_space(3))) bf16x8*)(kp+j*2048); kf[2*j+1]=*(const __attribute__((address_space(3))) bf16x8*)(kp+j*2048+512); }
__device__ __forceinline__ s16x4 vtr(lds_cptr p){ return __builtin_bit_cast(s16x4,__builtin_amdgcn_ds_read_tr16_b64_v4i16((__attribute__((address_space(3))) v4i16_t*)p)); }
__device__ __forceinline__ float rowmax(const f32x16&p0,const f32x16&p1){
  float a=max3f(p0[0],p0[1],p1[0]),b=max3f(p0[2],p0[3],p1[1]);a=max3f(a,p1[2],p1[3]);
  #pragma unroll
  for(int r=4;r<16;r+=4){a=max3f(a,p0[r],p0[r+1]);b=max3f(b,p0[r+2],p0[r+3]);a=max3f(a,p1[r],p1[r+1]);b=max3f(b,p1[r+2],p1[r+3]);}
  const float m=max2f(a,b);
  auto rr=__builtin_amdgcn_permlane32_swap(__float_as_uint(m),__float_as_uint(m),false,false);
  return max2f(__uint_as_float(rr[0]),__uint_as_float(rr[1]));
}
__device__ __forceinline__ void pv(f32x16*o,int vb,bf16x8 pa0,bf16x8 pa1,bf16x8 pa2,bf16x8 pa3){
  #pragma unroll
  for(int d0=0;d0<2;++d0){s16x4 lo[4],hi[4];
    #pragma unroll
    for(int ks=0;ks<4;++ks){
      asm volatile("ds_read_b64_tr_b16 %0,%1 offset:%c2":"=&v"(lo[ks]):"v"(vb),"i"(d0*4096+ks*1024):"memory");
      asm volatile("ds_read_b64_tr_b16 %0,%1 offset:%c2":"=&v"(hi[ks]):"v"(vb),"i"(d0*4096+ks*1024+512):"memory");}
    asm volatile("s_waitcnt lgkmcnt(0)":::"memory");SBAR();
    #define PK(k) (bf16x8){lo[k][0],lo[k][1],lo[k][2],lo[k][3],hi[k][0],hi[k][1],hi[k][2],hi[k][3]}
    o[d0]=__builtin_amdgcn_mfma_f32_32x32x16_bf16(pa0,PK(0),o[d0],0,0,0);
    o[d0]=__builtin_amdgcn_mfma_f32_32x32x16_bf16(pa1,PK(1),o[d0],0,0,0);
    o[d0]=__builtin_amdgcn_mfma_f32_32x32x16_bf16(pa2,PK(2),o[d0],0,0,0);
    o[d0]=__builtin_amdgcn_mfma_f32_32x32x16_bf16(pa3,PK(3),o[d0],0,0,0);
    #undef PK
  }
}

#ifndef ATTN_STORE16
#define ATTN_STORE16(p,v) (*(u32x4*)(p)=(v))
#endif
template<int THRL> __device__ __forceinline__ void attn_unit(const int wid,int b,int qb,const bf16*Qc,const bf16*__restrict__ Kc,const bf16*__restrict__ Vc,bf16*Oc,const float*btabm,char*shm){
  int lane; asm volatile("v_mbcnt_lo_u32_b32 %0, -1, 0\n\tv_mbcnt_hi_u32_b32 %0, -1, %0 ; dep %1":"=v"(lane):"s"(qb));
  const int tid=wid*64+lane,r32=lane&31,hi=lane>>5;
  const long rowbase=(long)b*SEQ; const int q0=qb*QB;
  const bf16*Qw=Qc+(rowbase+q0+wid*QBLK)*DM;
  const bf16*Kh=Kc+rowbase*DM,*Vh=Vc+rowbase*DM;
  const unsigned lds0=(unsigned)(uintptr_t)shm;
  float*wsf=(float*)(shm+LDS_WS)+wid*64;
  const float b31n=btabm[127*16]; const float b31l=b31n*1.4426950408889634f;
  { float*R=(float*)(shm+LDS_BT); for(int j=tid;j<BT_N;j+=NW*64){ int d=447-j; float v=0.f; if(d>=0&&d<127) v=(btabm[d*16]-b31n)*1.4426950408889634f; R[j]=v; } }
  const bf16*ksrc=Kh+(long)lane*DM+wid*8;
  const bf16*vsrc=Vh+(long)(16*(wid&3)+(lane>>2))*DM+(wid>>2)*32+(lane&3)*8;
  const unsigned kdst=lds0+LDS_K+wid*1024, vdst=lds0+LDS_V+wid*1024;
  #define DMA_K(t,slot) glds16(ksrc+(long)(t)*KVBLK*DM,(unsigned)__builtin_amdgcn_readfirstlane(kdst+(slot)))
  #define DMA_V(t,slot) glds16(vsrc+(long)(t)*KVBLK*DM,(unsigned)__builtin_amdgcn_readfirstlane(vdst+(slot)))
  const int vb0=(int)(lds0+LDS_V)+((lane>>4)&1)*32+(lane&3)*8+(4*hi+((lane&15)>>2))*64;
  const char*Kbase=shm+LDS_K; bf16x8 kf[8];
  const lds_cptr shm3=(lds_cptr)shm; const lds_cptr kp0=shm3+LDS_K+hi*1024+r32*16; const lds_cptr vp0=shm3+LDS_V+((lane>>4)&1)*32+(lane&3)*8+(4*hi+((lane&15)>>2))*64;
  const int NT=(q0+QB)/KVBLK;
  DMA_K(0,0);DMA_V(0,0);DMA_K(1,SLOTB);
  bf16x8 qr[4];
  #pragma unroll
  for(int d0=0;d0<4;++d0)qr[d0]=*reinterpret_cast<const bf16x8*>(&Qw[(long)r32*DM+d0*16+hi*8]);
  float mhat=0.f,l_reg=0.f;f32x16 o[2];o[0]=f32x16{};o[1]=f32x16{};
  const int qrel=wid*QBLK+r32;
  typedef __attribute__((address_space(3))) const float* lds_fptr;
  const lds_fptr Rl=(lds_fptr)((lds_cptr)shm+LDS_BT)+(447-(q0+qrel-4*hi));
  #define CBIAS(P0,P1,t) do{ const lds_fptr rp_=Rl+64*(t); \
    _Pragma("unroll") for(int g_=0;g_<4;++g_){ SBAR(); _Pragma("unroll") for(int r=4*g_;r<4*g_+4;++r){ P0[r]+=rp_[(r&3)+8*(r>>2)]; P1[r]+=rp_[32+(r&3)+8*(r>>2)]; } } SBAR(); }while(0)
  #define CMASK(P0,P1,t) do{ if((t)>=NT-7){ CBIAS(P0,P1,t); } int jb_=(t)-(NT-4); if(jb_>=0)cmask(P0,P1,jb_,qrel,hi);}while(0)
  bool resc=false;
  #define START(P0,P1) do{ const float rm=rowmax(P0,P1); resc=false; \
    { const float dl=rm; mhat=fadd_s(mhat,dl); \
      _Pragma("unroll") for(int r=0;r<16;++r){P0[r]=fsub_s(P0[r],dl);P1[r]=fsub_s(P1[r],dl);} \
      } \
    _Pragma("unroll") for(int r=0;r<16;++r)P0[r]=__builtin_amdgcn_exp2f(P0[r]); }while(0)
  #define RESC() do{ if(resc){ asm volatile("s_waitcnt lgkmcnt(0)":::"memory"); \
      _Pragma("unroll") for(int d_=0;d_<2;++d_) _Pragma("unroll") for(int r=0;r<16;++r)o[d_][r]*=wsf[crow(r,hi)]; } }while(0)
  f32x16 pA0,pA1,pB0,pB1;
  int sl_prev=0,sl_cur=0,sl_next=SLOTB;
  #define ROT() do{sl_prev=sl_cur;sl_cur=sl_next;sl_next=(sl_next==(NSLOT-1)*SLOTB)?0:sl_next+SLOTB;}while(0)
  DMA_K(2,2*SLOTB);
  WAIT_BAR(3);
  qkt(pA0,pA1,Kbase,qr,r32,hi);asm volatile("s_nop 15\n\ts_nop 7":"+v"(pA0),"+v"(pA1));
  #pragma unroll
  for(int r=0;r<16;++r){pA0[r]+=b31l;pA1[r]+=b31l;}
  CMASK(pA0,pA1,0);
  START(pA0,pA1);
  _Pragma("unroll") for(int r=0;r<16;++r)pA1[r]=__builtin_amdgcn_exp2f(pA1[r]);
  WAIT_BAR(0);
  DMA_K(3,0);DMA_V(1,SLOTB);
  ROT();
  kload8(kf,kp0+sl_cur);
  WAIT_BAR(2);
  s16x4 vlo[8],vhi[8]; u32x4 pw0,pw1,pw2,pw3;
  #define PKW(P,B) cvtpk_s(P[B],P[B+1])
  #define PAF(k) __builtin_bit_cast(bf16x8,pw##k)
  #define VFR(i) (bf16x8){vlo[i][0],vlo[i][1],vlo[i][2],vlo[i][3],vhi[i][0],vhi[i][1],vhi[i][2],vhi[i][3]}
  #define PIN(x) asm volatile("":"+v"(x))
  #define MX3(a,b,c) __builtin_fmaxf(__builtin_fmaxf((a),(b)),(c))
  #define GAPA(MF,A0,A1,A2,A3,W0,W1,PW) do{ MF; sacc+=A0; sacc+=A1; sacc+=A2; sacc+=A3; PIN(sacc); W0; W1; PIN(PW); SBAR(); }while(0)
  #define EX(v) __builtin_amdgcn_exp2f(v)
  #define GAPB(MF,X,B) do{ MF; X[B]=EX(X[B]); X[B+1]=EX(X[B+1]); X[B+2]=EX(X[B+2]); X[B+3]=EX(X[B+3]); PIN(X); SBAR(); }while(0)
  #define VRD(i) do{ vlo[i]=vtr(vp_+(((i)>>2)*4096+((i)&3)*1024)); vhi[i]=vtr(vp_+(((i)>>2)*4096+((i)&3)*1024+512)); }while(0)
  #define KRD(G,j) do{ if(G){ kload2(kf,kp0+sl_next,j); SBAR(); } }while(0)
  #define STEP(C0,C1,P0,P1,t,GK,GV,GL) do{ SBAR(); \
    const lds_cptr vp_=vp0+sl_prev; \
    VRD(0); SBAR(); float sacc=(P0[0]+P0[1]); \
    GAPA(C0=__builtin_amdgcn_mfma_f32_32x32x16_bf16(kf[0],qr[0],f32x16{},0,0,0), P0[2],P0[3],P0[4],P0[5],     pw0[0]=PKW(P0,0), pw0[1]=PKW(P0,2), pw0); \
    VRD(4); SBAR(); GAPA(C1=__builtin_amdgcn_mfma_f32_32x32x16_bf16(kf[1],qr[0],f32x16{},0,0,0), P0[6],P0[7],P0[8],P0[9],     pw0[2]=PKW(P0,4), pw0[3]=PKW(P0,6), pw0); \
    VRD(1); SBAR(); GAPA(C0=__builtin_amdgcn_mfma_f32_32x32x16_bf16(kf[2],qr[1],C0,0,0,0),   P0[10],P0[11],P0[12],P0[13], pw1[0]=PKW(P0,8), pw1[1]=PKW(P0,10), pw1); \
    VRD(5); SBAR(); GAPA(C1=__builtin_amdgcn_mfma_f32_32x32x16_bf16(kf[3],qr[1],C1,0,0,0),   P0[14],P0[15],P1[0],P1[1],   pw1[2]=PKW(P0,12),pw1[3]=PKW(P0,14), pw1); \
    VRD(2); SBAR(); GAPA(C0=__builtin_amdgcn_mfma_f32_32x32x16_bf16(kf[4],qr[2],C0,0,0,0),   P1[2],P1[3],P1[4],P1[5],     pw2[0]=PKW(P1,0), pw2[1]=PKW(P1,2), pw2); \
    VRD(6); SBAR(); GAPA(C1=__builtin_amdgcn_mfma_f32_32x32x16_bf16(kf[5],qr[2],C1,0,0,0),   P1[6],P1[7],P1[8],P1[9],     pw2[2]=PKW(P1,4), pw2[3]=PKW(P1,6), pw2); \
    VRD(3); SBAR(); GAPA(C0=__builtin_amdgcn_mfma_f32_32x32x16_bf16(kf[6],qr[3],C0,0,0,0),   P1[10],P1[11],P1[12],P1[13], pw3[0]=PKW(P1,8), pw3[1]=PKW(P1,10), pw3); \
    VRD(7); SBAR(); GAPA(C1=__builtin_amdgcn_mfma_f32_32x32x16_bf16(kf[7],qr[3],C1,0,0,0),   P1[14],P1[15],0.f,0.f,       pw3[2]=PKW(P1,12),pw3[3]=PKW(P1,14), pw3); \
    l_reg+=sacc; \
    if(GK){DMA_K((t)+3,sl_cur);} if(GV){DMA_V((t)+1,sl_next);} \
    { const float nb_=b31l-mhat; _Pragma("unroll") for(int r=0;r<16;++r){C0[r]+=nb_;C1[r]+=nb_;} } \
    CMASK(C0,C1,t); \
    { float a=MX3(C0[0],C0[1],C1[0]),b=MX3(C0[2],C0[3],C1[1]); a=MX3(a,C1[2],C1[3]); \
      _Pragma("unroll") for(int r=4;r<16;r+=4){a=MX3(a,C0[r],C0[r+1]);b=MX3(b,C0[r+2],C0[r+3]);a=MX3(a,C1[r],C1[r+1]);b=MX3(b,C1[r+2],C1[r+3]);} \
      float rm=__builtin_fmaxf(a,b); { auto rr=__builtin_amdgcn_permlane32_swap(__float_as_uint(rm),__float_as_uint(rm),false,false); rm=__builtin_fmaxf(__uint_as_float(rr[0]),__uint_as_float(rr[1])); } \
      resc=false; \
      if(__builtin_expect(__any(rm>(float)THRL),0)){ const float dl=__builtin_fmaxf(rm,0.f); mhat+=dl; \
        _Pragma("unroll") for(int r=0;r<16;++r){C0[r]-=dl;C1[r]-=dl;} \
        const float f=__builtin_amdgcn_exp2f(-dl); l_reg*=f; { int r32b_=r32; asm volatile("":"+v"(r32b_)); if(hi==0)wsf[r32b_]=f; } resc=true; } } \
    SBAR(); \
    GAPB(o[0]=__builtin_amdgcn_mfma_f32_32x32x16_bf16(PAF(0),VFR(0),o[0],0,0,0), C0,0); \
    GAPB(o[1]=__builtin_amdgcn_mfma_f32_32x32x16_bf16(PAF(0),VFR(4),o[1],0,0,0), C0,4); \
    KRD(GL,0); GAPB(o[0]=__builtin_amdgcn_mfma_f32_32x32x16_bf16(PAF(1),VFR(1),o[0],0,0,0), C0,8); \
    KRD(GL,1); GAPB(o[1]=__builtin_amdgcn_mfma_f32_32x32x16_bf16(PAF(1),VFR(5),o[1],0,0,0), C0,12); \
    KRD(GL,2); GAPB(o[0]=__builtin_amdgcn_mfma_f32_32x32x16_bf16(PAF(2),VFR(2),o[0],0,0,0), C1,0); \
    KRD(GL,3); GAPB(o[1]=__builtin_amdgcn_mfma_f32_32x32x16_bf16(PAF(2),VFR(6),o[1],0,0,0), C1,4); \
    GAPB(o[0]=__builtin_amdgcn_mfma_f32_32x32x16_bf16(PAF(3),VFR(3),o[0],0,0,0), C1,8); \
    GAPB(o[1]=__builtin_amdgcn_mfma_f32_32x32x16_bf16(PAF(3),VFR(7),o[1],0,0,0), C1,12); \
    }while(0)
  int t=1;
  #undef CMASK
  #define CMASK(P0,P1,t) do{}while(0)
  for(;t+7<NT;t+=2){
    STEP(pB0,pB1,pA0,pA1,t,true,true,true);     WAIT_BAR(2); RESC(); ROT();
    STEP(pA0,pA1,pB0,pB1,t+1,true,true,true);   WAIT_BAR(2); RESC(); ROT();
  }
  #undef CMASK
  #define CMASK(P0,P1,t) do{ CBIAS(P0,P1,t); int jb_=(t)-(NT-4); if(jb_>=0)cmask(P0,P1,jb_,qrel,hi);}while(0)
  #define ENDW(tt) do{ if((tt)+3<NT){WAIT_BAR(2);} else if((tt)+2<NT){WAIT_BAR(1);} else {WAIT_BAR(0);} }while(0)
  for(;t+1<NT;t+=2){
    STEP(pB0,pB1,pA0,pA1,t,(t+3<NT),(t+1<NT),(t+1<NT));       ENDW(t);   RESC(); ROT();
    STEP(pA0,pA1,pB0,pB1,t+1,(t+4<NT),(t+2<NT),(t+2<NT));     ENDW(t+1); RESC(); ROT();
  }
  STEP(pB0,pB1,pA0,pA1,NT-1,false,false,false); RESC();
  { float sacc=pB0[0]+pB0[1]; _Pragma("unroll") for(int r=2;r<16;++r)sacc+=pB0[r]; _Pragma("unroll") for(int r=0;r<16;++r)sacc+=pB1[r]; l_reg+=sacc;
    pw0=(u32x4){PKW(pB0,0),PKW(pB0,2),PKW(pB0,4),PKW(pB0,6)};pw1=(u32x4){PKW(pB0,8),PKW(pB0,10),PKW(pB0,12),PKW(pB0,14)};pw2=(u32x4){PKW(pB1,0),PKW(pB1,2),PKW(pB1,4),PKW(pB1,6)};pw3=(u32x4){PKW(pB1,8),PKW(pB1,10),PKW(pB1,12),PKW(pB1,14)};
    SBAR(); pv(o,vb0+sl_cur,PAF(0),PAF(1),PAF(2),PAF(3)); }
  #undef PKW
  #undef PAF
  #undef VFR
  #undef PIN
  #undef MX3
  #undef GAPA
  #undef GAPB
  #undef EX
  #undef VRD
  #undef KRD
  #undef STEP
  #undef ENDW
  {auto rr=__builtin_amdgcn_permlane32_swap(__float_as_uint(l_reg),__float_as_uint(l_reg),false,false);l_reg=__uint_as_float(rr[0])+__uint_as_float(rr[1]);}
  if(hi==0)wsf[32+r32]=l_reg;asm volatile("s_waitcnt lgkmcnt(0)":::"memory");
  float rli[16];
  #pragma unroll
  for(int r=0;r<16;++r)rli[r]=__builtin_amdgcn_rcpf(wsf[32+crow(r,hi)]);
  bf16*Ow=Oc+(long)(wid*QBLK)*OPITCH;
  { bf16*stg=(bf16*)(shm+LDS_OST)+wid*2048;
    #pragma unroll
    for(int r=0;r<16;++r){const int orow=crow(r,hi);
      #pragma unroll
      for(int d0=0;d0<2;++d0)stg[orow*64+d0*32+r32]=__float2bfloat16(o[d0][r]*rli[r]);}
    asm volatile("s_waitcnt lgkmcnt(0)":::"memory");
    #pragma unroll
    for(int i=0;i<4;++i){const int row=i*8+(lane>>3),ch=lane&7; const u32x4 v=*(const u32x4*)(stg+row*64+ch*8); ATTN_STORE16(Ow+(long)row*OPITCH+ch*8,v);} }
  asm volatile("s_waitcnt lgkmcnt(0)\n\ts_barrier":::"memory");
  #undef DMA_K
  #undef DMA_V
  #undef CMASK
  #undef CBIAS
  #undef START
  #undef RESC
  #undef ROT
}
constexpr int ATTN_LDS_BYTES=LDS_BYTES;
#undef SBAR
#undef WAIT_BAR
}

namespace attn2 {
using bf16=__hip_bfloat16;
using bf16x8=__attribute__((ext_vector_type(8)))short;
using s16x4=__attribute__((ext_vector_type(4)))short;
using f32x16=__attribute__((ext_vector_type(16)))float;
using u32x4=__attribute__((ext_vector_type(4)))unsigned;
constexpr int SEQ=2048,D=64,DM=4096,OPITCH=256;
constexpr int NW=8,QBLK=32,QB=QBLK*NW,KVBLK=64,NQB=SEQ/QB;
constexpr int ATTN_UNIT_ROWS=QB;
__device__ __forceinline__ int crow(int r,int hi){return (r&3)+8*(r>>2)+4*hi;}
#define SBAR() __builtin_amdgcn_sched_barrier(0)
__device__ __forceinline__ void cmask(f32x16&p0,f32x16&p1,int jb,int qrel,int hi){
  const float NEG=-INFINITY; int x=qrel-(64*jb+4*hi); asm volatile("":"+v"(x));
  #pragma unroll
  for(int r=0;r<16;++r){const int c=(r&3)+8*(r>>2); if(c>x)p0[r]=NEG; if(c+32>x)p1[r]=NEG;}
}

constexpr int NSLOT=3, SLOTB=8192, VSLOTB=16384;
constexpr int LDS_K=0, LDS_V=NSLOT*SLOTB, LDS_WS=LDS_V+NSLOT*VSLOTB, LDS_OST=LDS_WS+NW*64*4, LDS_BT=LDS_OST+NW*8192, BT_N=704, LDS_BYTES=LDS_BT+BT_N*4;
constexpr float C2=0.125f*1.4426950408889634f;
__device__ __forceinline__ void glds16(const void*gsrc,unsigned lds_dst){unsigned keep;
  asm volatile("s_mov_b32 %0, m0\n\ts_mov_b32 m0, %2\n\ts_nop 0\n\tglobal_load_lds_dwordx4 %1, off\n\ts_mov_b32 m0, %0":"=&s"(keep):"v"(gsrc),"s"(lds_dst):"memory");}
__device__ __forceinline__ float max3f(float a,float b,float c){float r;asm("v_max3_f32 %0, %1, %2, %3":"=v"(r):"v"(a),"v"(b),"v"(c));return r;}
__device__ __forceinline__ float max2f(float a,float b){float r;asm("v_max_f32_e32 %0, %1, %2":"=v"(r):"v"(a),"v"(b));return r;}
__device__ __forceinline__ float fadd_s(float a,float b){float r;asm("v_add_f32_e32 %0, %1, %2":"=v"(r):"v"(a),"v"(b));return r;}
__device__ __forceinline__ float fsub_s(float a,float b){float r;asm("v_sub_f32_e32 %0, %1, %2":"=v"(r):"v"(a),"v"(b));return r;}
typedef float f32x2_t __attribute__((ext_vector_type(2))); typedef __bf16 bf16x2_t __attribute__((ext_vector_type(2)));
__device__ __forceinline__ unsigned cvtpk_s(float lo,float hi){f32x2_t v={lo,hi};bf16x2_t b=__builtin_convertvector(v,bf16x2_t);return __builtin_bit_cast(unsigned,b);}
#define WAIT_BAR(N) asm volatile("s_waitcnt vmcnt(" #N ") lgkmcnt(0)\n\ts_barrier":::"memory")

__device__ __forceinline__ void qkt(f32x16&p0,f32x16&p1,const char*Kslot,const bf16x8*qr,int r32,int hi){
  const char*kb=Kslot+hi*1024+r32*16;
  #pragma unroll
  for(int d0=0;d0<4;++d0){
    const bf16x8 b0=*reinterpret_cast<const bf16x8*>(kb+d0*2048);
    const bf16x8 b1=*reinterpret_cast<const bf16x8*>(kb+d0*2048+512);
    if(d0==0){p0=__builtin_amdgcn_mfma_f32_32x32x16_bf16(b0,qr[0],f32x16{},0,0,0);p1=__builtin_amdgcn_mfma_f32_32x32x16_bf16(b1,qr[0],f32x16{},0,0,0);}
    else{p0=__builtin_amdgcn_mfma_f32_32x32x16_bf16(b0,qr[d0],p0,0,0,0);p1=__builtin_amdgcn_mfma_f32_32x32x16_bf16(b1,qr[d0],p1,0,0,0);}}
}
typedef __attribute__((address_space(3))) const char* lds_cptr;
typedef short v4i16_t __attribute__((ext_vector_type(4)));
__device__ __forceinline__ void kload8(bf16x8*kf,lds_cptr kp){
  kf[0]=*(const __attribute__((address_space(3))) bf16x8*)(kp);      kf[1]=*(const __attribute__((address_space(3))) bf16x8*)(kp+512);
  kf[2]=*(const __attribute__((address_space(3))) bf16x8*)(kp+2048); kf[3]=*(const __attribute__((address_space(3))) bf16x8*)(kp+2560);
  kf[4]=*(const __attribute__((address_space(3))) bf16x8*)(kp+4096); kf[5]=*(const __attribute__((address_space(3))) bf16x8*)(kp+4608);
  kf[6]=*(const __attribute__((address_space(3))) bf16x8*)(kp+6144); kf[7]=*(const __attribute__((address_space(3))) bf16x8*)(kp+6656);
}
__device__ __forceinline__ void kload2(bf16x8*kf,lds_cptr kp,int j){ kf[2*j]=*(const __attribute__((address_space(3))) bf16x8*)(kp+j*2048); kf[2*j+1]=*(const __attribute__((address_space(3))) bf16x8*)(kp+j*2048+512); }
__device__ __forceinline__ s16x4 vtr(lds_cptr p){ return __builtin_bit_cast(s16x4,__builtin_amdgcn_ds_read_tr16_b64_v4i16((__attribute__((address_space(3))) v4i16_t*)p)); }
__device__ __forceinline__ float rowmax(const f32x16&p0,const f32x16&p1){
  float a=max3f(p0[0],p0[1],p1[0]),b=max3f(p0[2],p0[3],p1[1]);a=max3f(a,p1[2],p1[3]);
  #pragma unroll
  for(int r=4;r<16;r+=4){a=max3f(a,p0[r],p0[r+1]);b=max3f(b,p0[r+2],p0[r+3]);a=max3f(a,p1[r],p1[r+1]);b=max3f(b,p1[r+2],p1[r+3]);}
  const float m=max2f(a,b);
  auto rr=__builtin_amdgcn_permlane32_swap(__float_as_uint(m),__float_as_uint(m),false,false);
  return max2f(__uint_as_float(rr[0]),__uint_as_float(rr[1]));
}
__device__ __forceinline__ void pv(f32x16*o,int vb,bf16x8 pa0,bf16x8 pa1,bf16x8 pa2,bf16x8 pa3){
  #pragma unroll
  for(int d0=0;d0<4;++d0){s16x4 lo[4],hi[4];
    #pragma unroll
    for(int ks=0;ks<4;++ks){
      asm volatile("ds_read_b64_tr_b16 %0,%1 offset:%c2":"=&v"(lo[ks]):"v"(vb),"i"(d0*4096+ks*1024):"memory");
      asm volatile("ds_read_b64_tr_b16 %0,%1 offset:%c2":"=&v"(hi[ks]):"v"(vb),"i"(d0*4096+ks*1024+512):"memory");}
    asm volatile("s_waitcnt lgkmcnt(0)":::"memory");SBAR();
    #define PK(k) (bf16x8){lo[k][0],lo[k][1],lo[k][2],lo[k][3],hi[k][0],hi[k][1],hi[k][2],hi[k][3]}
    o[d0]=__builtin_amdgcn_mfma_f32_32x32x16_bf16(pa0,PK(0),o[d0],0,0,0);
    o[d0]=__builtin_amdgcn_mfma_f32_32x32x16_bf16(pa1,PK(1),o[d0],0,0,0);
    o[d0]=__builtin_amdgcn_mfma_f32_32x32x16_bf16(pa2,PK(2),o[d0],0,0,0);
    o[d0]=__builtin_amdgcn_mfma_f32_32x32x16_bf16(pa3,PK(3),o[d0],0,0,0);
    #undef PK
  }
}

#ifndef ATTN_STORE16
#define ATTN_STORE16(p,v) (*(u32x4*)(p)=(v))
#endif
template<int THRL> __device__ __forceinline__ void attn_unit(const int wid,int b,int qb,const bf16*Qc,const bf16*__restrict__ Kc,const bf16*__restrict__ Vc,bf16*Oc,const float*btabm,char*shm){
  int lane; asm volatile("v_mbcnt_lo_u32_b32 %0, -1, 0\n\tv_mbcnt_hi_u32_b32 %0, -1, %0 ; dep %1":"=v"(lane):"s"(qb));
  const int tid=wid*64+lane,r32=lane&31,hi=lane>>5;
  const long rowbase=(long)b*SEQ; const int q0=qb*QB;
  const bf16*Qw=Qc+(rowbase+q0+wid*QBLK)*DM;
  const bf16*Kh=Kc+rowbase*DM,*Vh=Vc+rowbase*DM;
  const unsigned lds0=(unsigned)(uintptr_t)shm;
  float*wsf=(float*)(shm+LDS_WS)+wid*64;
  const float b31n=btabm[127*16]; const float b31l=b31n*1.4426950408889634f;
  { float*R=(float*)(shm+LDS_BT); for(int j=tid;j<BT_N;j+=NW*64){ int d=447-j; float v=0.f; if(d>=0&&d<127) v=(btabm[d*16]-b31n)*1.4426950408889634f; R[j]=v; } }
  const bf16*ksrc=Kh+(long)lane*DM+wid*8;
  const bf16*vsrc=Vh+(long)(16*(wid&3)+(lane>>2))*DM+(wid>>2)*32+(lane&3)*8;
  const unsigned kdst=lds0+LDS_K+wid*1024, vdst=lds0+LDS_V+wid*1024;
  #define DMA_K(t,slot) glds16(ksrc+(long)(t)*KVBLK*DM,(unsigned)__builtin_amdgcn_readfirstlane(kdst+(slot)))
  #define DMA_V(t,slot) do{ glds16(vsrc+(long)(t)*KVBLK*DM,(unsigned)__builtin_amdgcn_readfirstlane(vdst+2*(slot))); glds16(vsrc+64+(long)(t)*KVBLK*DM,(unsigned)__builtin_amdgcn_readfirstlane(vdst+2*(slot)+8192)); }while(0)
  const int vb0=(int)(lds0+LDS_V)+((lane>>4)&1)*32+(lane&3)*8+(4*hi+((lane&15)>>2))*64;
  const char*Kbase=shm+LDS_K; bf16x8 kf[8];
  const lds_cptr shm3=(lds_cptr)shm; const lds_cptr kp0=shm3+LDS_K+hi*1024+r32*16; const lds_cptr vp0=shm3+LDS_V+((lane>>4)&1)*32+(lane&3)*8+(4*hi+((lane&15)>>2))*64;
  const int NT=(q0+QB)/KVBLK;
  DMA_K(0,0);DMA_V(0,0);DMA_K(1,SLOTB);
  bf16x8 qr[4];
  #pragma unroll
  for(int d0=0;d0<4;++d0)qr[d0]=*reinterpret_cast<const bf16x8*>(&Qw[(long)r32*DM+d0*16+hi*8]);
  float mhat=0.f,l_reg=0.f;f32x16 o[4];o[0]=f32x16{};o[1]=f32x16{};o[2]=f32x16{};o[3]=f32x16{};
  const int qrel=wid*QBLK+r32;
  typedef __attribute__((address_space(3))) const float* lds_fptr;
  const lds_fptr Rl=(lds_fptr)((lds_cptr)shm+LDS_BT)+(447-(q0+qrel-4*hi));
  #define CBIAS(P0,P1,t) do{ const lds_fptr rp_=Rl+64*(t); \
    _Pragma("unroll") for(int g_=0;g_<4;++g_){ SBAR(); _Pragma("unroll") for(int r=4*g_;r<4*g_+4;++r){ P0[r]+=rp_[(r&3)+8*(r>>2)]; P1[r]+=rp_[32+(r&3)+8*(r>>2)]; } } SBAR(); }while(0)
  #define CMASK(P0,P1,t) do{ if((t)>=NT-7){ CBIAS(P0,P1,t); } int jb_=(t)-(NT-4); if(jb_>=0)cmask(P0,P1,jb_,qrel,hi);}while(0)
  bool resc=false;
  #define START(P0,P1) do{ const float rm=rowmax(P0,P1); resc=false; \
    { const float dl=rm; mhat=fadd_s(mhat,dl); \
      _Pragma("unroll") for(int r=0;r<16;++r){P0[r]=fsub_s(P0[r],dl);P1[r]=fsub_s(P1[r],dl);} \
      } \
    _Pragma("unroll") for(int r=0;r<16;++r)P0[r]=__builtin_amdgcn_exp2f(P0[r]); }while(0)
  #define RESC() do{ if(resc){ asm volatile("s_waitcnt lgkmcnt(0)":::"memory"); \
      _Pragma("unroll") for(int d_=0;d_<4;++d_) _Pragma("unroll") for(int r=0;r<16;++r)o[d_][r]*=wsf[crow(r,hi)]; } }while(0)
  f32x16 pA0,pA1,pB0,pB1;
  int sl_prev=0,sl_cur=0,sl_next=SLOTB;
  #define ROT() do{sl_prev=sl_cur;sl_cur=sl_next;sl_next=(sl_next==(NSLOT-1)*SLOTB)?0:sl_next+SLOTB;}while(0)
  DMA_K(2,2*SLOTB);
  WAIT_BAR(3);
  qkt(pA0,pA1,Kbase,qr,r32,hi);asm volatile("s_nop 15\n\ts_nop 7":"+v"(pA0),"+v"(pA1));
  #pragma unroll
  for(int r=0;r<16;++r){pA0[r]+=b31l;pA1[r]+=b31l;}
  CMASK(pA0,pA1,0);
  START(pA0,pA1);
  _Pragma("unroll") for(int r=0;r<16;++r)pA1[r]=__builtin_amdgcn_exp2f(pA1[r]);
  WAIT_BAR(0);
  DMA_K(3,0);DMA_V(1,SLOTB);
  ROT();
  kload8(kf,kp0+sl_cur);
  WAIT_BAR(3);
  s16x4 vfl0,vfl1,vfl2,vfl3,vfh0,vfh1,vfh2,vfh3; u32x4 pw0,pw1,pw2,pw3;
  #define PKW(P,B) cvtpk_s(P[B],P[B+1])
  #define PAF(k) __builtin_bit_cast(bf16x8,pw##k)
  #define VFRS(s_) (bf16x8){vfl##s_[0],vfl##s_[1],vfl##s_[2],vfl##s_[3],vfh##s_[0],vfh##s_[1],vfh##s_[2],vfh##s_[3]}
  #define PIN(x) asm volatile("":"+v"(x))
  #define MX3(a,b,c) __builtin_fmaxf(__builtin_fmaxf((a),(b)),(c))
  #define GAPA(MF,A0,A1,A2,A3,W0,W1,PW) do{ MF; sacc+=A0; sacc+=A1; sacc+=A2; sacc+=A3; PIN(sacc); W0; W1; PIN(PW); SBAR(); }while(0)
  #define EX(v) __builtin_amdgcn_exp2f(v)
  #define GAPB(MF,X,B) do{ MF; X[B]=EX(X[B]); X[B+1]=EX(X[B+1]); PIN(X); SBAR(); }while(0)
  #define VRF(s_,i) do{ vfl##s_=vtr(vp_+(((i)>>2)*4096+((i)&3)*1024)); vfh##s_=vtr(vp_+(((i)>>2)*4096+((i)&3)*1024+512)); }while(0)
  #define KRD(G,j) do{ if(G){ kload2(kf,kp0+sl_next,j); SBAR(); } }while(0)
  #define STEP(C0,C1,P0,P1,t,GK,GV,GL) do{ SBAR(); \
    const lds_cptr vp_=vp0+2*sl_prev; \
    float sacc=(P0[0]+P0[1]); \
    GAPA(C0=__builtin_amdgcn_mfma_f32_32x32x16_bf16(kf[0],qr[0],f32x16{},0,0,0), P0[2],P0[3],P0[4],P0[5],     pw0[0]=PKW(P0,0), pw0[1]=PKW(P0,2), pw0); \
    GAPA(C1=__builtin_amdgcn_mfma_f32_32x32x16_bf16(kf[1],qr[0],f32x16{},0,0,0), P0[6],P0[7],P0[8],P0[9],     pw0[2]=PKW(P0,4), pw0[3]=PKW(P0,6), pw0); \
    GAPA(C0=__builtin_amdgcn_mfma_f32_32x32x16_bf16(kf[2],qr[1],C0,0,0,0),   P0[10],P0[11],P0[12],P0[13], pw1[0]=PKW(P0,8), pw1[1]=PKW(P0,10), pw1); \
    GAPA(C1=__builtin_amdgcn_mfma_f32_32x32x16_bf16(kf[3],qr[1],C1,0,0,0),   P0[14],P0[15],P1[0],P1[1],   pw1[2]=PKW(P0,12),pw1[3]=PKW(P0,14), pw1); \
    GAPA(C0=__builtin_amdgcn_mfma_f32_32x32x16_bf16(kf[4],qr[2],C0,0,0,0),   P1[2],P1[3],P1[4],P1[5],     pw2[0]=PKW(P1,0), pw2[1]=PKW(P1,2), pw2); \
    GAPA(C1=__builtin_amdgcn_mfma_f32_32x32x16_bf16(kf[5],qr[2],C1,0,0,0),   P1[6],P1[7],P1[8],P1[9],     pw2[2]=PKW(P1,4), pw2[3]=PKW(P1,6), pw2); \
    GAPA(C0=__builtin_amdgcn_mfma_f32_32x32x16_bf16(kf[6],qr[3],C0,0,0,0),   P1[10],P1[11],P1[12],P1[13], pw3[0]=PKW(P1,8), pw3[1]=PKW(P1,10), pw3); \
    GAPA(C1=__builtin_amdgcn_mfma_f32_32x32x16_bf16(kf[7],qr[3],C1,0,0,0),   P1[14],P1[15],0.f,0.f,       pw3[2]=PKW(P1,12),pw3[3]=PKW(P1,14), pw3); \
    l_reg+=sacc; \
    VRF(0,0); VRF(1,4); VRF(2,8); SBAR(); \
    if(GK){DMA_K((t)+3,sl_cur);} if(GV){DMA_V((t)+1,sl_next);} \
    { const float nb_=b31l-mhat; _Pragma("unroll") for(int r=0;r<16;++r){C0[r]+=nb_;C1[r]+=nb_;} } \
    CMASK(C0,C1,t); \
    { float a=MX3(C0[0],C0[1],C1[0]),b=MX3(C0[2],C0[3],C1[1]); a=MX3(a,C1[2],C1[3]); \
      _Pragma("unroll") for(int r=4;r<16;r+=4){a=MX3(a,C0[r],C0[r+1]);b=MX3(b,C0[r+2],C0[r+3]);a=MX3(a,C1[r],C1[r+1]);b=MX3(b,C1[r+2],C1[r+3]);} \
      float rm=__builtin_fmaxf(a,b); { auto rr=__builtin_amdgcn_permlane32_swap(__float_as_uint(rm),__float_as_uint(rm),false,false); rm=__builtin_fmaxf(__uint_as_float(rr[0]),__uint_as_float(rr[1])); } \
      resc=false; \
      if(__builtin_expect(__any(rm>(float)THRL),0)){ const float dl=__builtin_fmaxf(rm,0.f); mhat+=dl; \
        _Pragma("unroll") for(int r=0;r<16;++r){C0[r]-=dl;C1[r]-=dl;} \
        const float f=__builtin_amdgcn_exp2f(-dl); l_reg*=f; { int r32b_=r32; asm volatile("":"+v"(r32b_)); if(hi==0)wsf[r32b_]=f; } resc=true; } } \
    SBAR(); \
    VRF(3,12); GAPB(o[0]=__builtin_amdgcn_mfma_f32_32x32x16_bf16(PAF(0),VFRS(0),o[0],0,0,0), C0,0); \
    VRF(0,1); GAPB(o[1]=__builtin_amdgcn_mfma_f32_32x32x16_bf16(PAF(0),VFRS(1),o[1],0,0,0), C0,2); \
    VRF(1,5); GAPB(o[2]=__builtin_amdgcn_mfma_f32_32x32x16_bf16(PAF(0),VFRS(2),o[2],0,0,0), C0,4); \
    VRF(2,9); GAPB(o[3]=__builtin_amdgcn_mfma_f32_32x32x16_bf16(PAF(0),VFRS(3),o[3],0,0,0), C0,6); \
    VRF(3,13); KRD(GL,0); GAPB(o[0]=__builtin_amdgcn_mfma_f32_32x32x16_bf16(PAF(1),VFRS(0),o[0],0,0,0), C0,8); \
    VRF(0,2); GAPB(o[1]=__builtin_amdgcn_mfma_f32_32x32x16_bf16(PAF(1),VFRS(1),o[1],0,0,0), C0,10); \
    VRF(1,6); KRD(GL,1); GAPB(o[2]=__builtin_amdgcn_mfma_f32_32x32x16_bf16(PAF(1),VFRS(2),o[2],0,0,0), C0,12); \
    VRF(2,10); GAPB(o[3]=__builtin_amdgcn_mfma_f32_32x32x16_bf16(PAF(1),VFRS(3),o[3],0,0,0), C0,14); \
    VRF(3,14); KRD(GL,2); GAPB(o[0]=__builtin_amdgcn_mfma_f32_32x32x16_bf16(PAF(2),VFRS(0),o[0],0,0,0), C1,0); \
    VRF(0,3); GAPB(o[1]=__builtin_amdgcn_mfma_f32_32x32x16_bf16(PAF(2),VFRS(1),o[1],0,0,0), C1,2); \
    VRF(1,7); KRD(GL,3); GAPB(o[2]=__builtin_amdgcn_mfma_f32_32x32x16_bf16(PAF(2),VFRS(2),o[2],0,0,0), C1,4); \
    VRF(2,11); GAPB(o[3]=__builtin_amdgcn_mfma_f32_32x32x16_bf16(PAF(2),VFRS(3),o[3],0,0,0), C1,6); \
    VRF(3,15); GAPB(o[0]=__builtin_amdgcn_mfma_f32_32x32x16_bf16(PAF(3),VFRS(0),o[0],0,0,0), C1,8); \
    GAPB(o[1]=__builtin_amdgcn_mfma_f32_32x32x16_bf16(PAF(3),VFRS(1),o[1],0,0,0), C1,10); \
    GAPB(o[2]=__builtin_amdgcn_mfma_f32_32x32x16_bf16(PAF(3),VFRS(2),o[2],0,0,0), C1,12); \
    GAPB(o[3]=__builtin_amdgcn_mfma_f32_32x32x16_bf16(PAF(3),VFRS(3),o[3],0,0,0), C1,14); \
    }while(0)
  int t=1;
  #undef CMASK
  #define CMASK(P0,P1,t) do{}while(0)
  for(;t+7<NT;t+=2){
    STEP(pB0,pB1,pA0,pA1,t,true,true,true);     WAIT_BAR(3); RESC(); ROT();
    STEP(pA0,pA1,pB0,pB1,t+1,true,true,true);   WAIT_BAR(3); RESC(); ROT();
  }
  #undef CMASK
  #define CMASK(P0,P1,t) do{ CBIAS(P0,P1,t); int jb_=(t)-(NT-4); if(jb_>=0)cmask(P0,P1,jb_,qrel,hi);}while(0)
  #define ENDW(tt) do{ if((tt)+3<NT){WAIT_BAR(3);} else if((tt)+2<NT){WAIT_BAR(2);} else {WAIT_BAR(0);} }while(0)
  for(;t+1<NT;t+=2){
    STEP(pB0,pB1,pA0,pA1,t,(t+3<NT),(t+1<NT),(t+1<NT));       ENDW(t);   RESC(); ROT();
    STEP(pA0,pA1,pB0,pB1,t+1,(t+4<NT),(t+2<NT),(t+2<NT));     ENDW(t+1); RESC(); ROT();
  }
  STEP(pB0,pB1,pA0,pA1,NT-1,false,false,false); RESC();
  { float sacc=pB0[0]+pB0[1]; _Pragma("unroll") for(int r=2;r<16;++r)sacc+=pB0[r]; _Pragma("unroll") for(int r=0;r<16;++r)sacc+=pB1[r]; l_reg+=sacc;
    pw0=(u32x4){PKW(pB0,0),PKW(pB0,2),PKW(pB0,4),PKW(pB0,6)};pw1=(u32x4){PKW(pB0,8),PKW(pB0,10),PKW(pB0,12),PKW(pB0,14)};pw2=(u32x4){PKW(pB1,0),PKW(pB1,2),PKW(pB1,4),PKW(pB1,6)};pw3=(u32x4){PKW(pB1,8),PKW(pB1,10),PKW(pB1,12),PKW(pB1,14)};
    SBAR(); pv(o,vb0+2*sl_cur,PAF(0),PAF(1),PAF(2),PAF(3)); }
  #undef PKW
  #undef PAF
  #undef VFRS
  #undef PIN
  #undef MX3
  #undef GAPA
  #undef GAPB
  #undef EX
  #undef VRF
  #undef KRD
  #undef STEP
  #undef ENDW
  {auto rr=__builtin_amdgcn_permlane32_swap(__float_as_uint(l_reg),__float_as_uint(l_reg),false,false);l_reg=__uint_as_float(rr[0])+__uint_as_float(rr[1]);}
  if(hi==0)wsf[32+r32]=l_reg;asm volatile("s_waitcnt lgkmcnt(0)":::"memory");
  float rli[16];
  #pragma unroll
  for(int r=0;r<16;++r)rli[r]=__builtin_amdgcn_rcpf(wsf[32+crow(r,hi)]);
  bf16*Ow=Oc+(long)(wid*QBLK)*OPITCH;
  { bf16*stg=(bf16*)(shm+LDS_OST)+wid*4096;
    #pragma unroll
    for(int r=0;r<16;++r){const int orow=crow(r,hi);
      #pragma unroll
      for(int d0=0;d0<4;++d0)stg[orow*128+d0*32+r32]=__float2bfloat16(o[d0][r]*rli[r]);}
    asm volatile("s_waitcnt lgkmcnt(0)":::"memory");
    #pragma unroll
    for(int i=0;i<8;++i){const int row=i*4+(lane>>4),ch=lane&15; const u32x4 v=*(const u32x4*)(stg+row*128+ch*8); ATTN_STORE16(Ow+(long)row*OPITCH+ch*8,v);} }
  asm volatile("s_waitcnt lgkmcnt(0)\n\ts_barrier":::"memory");
  #undef DMA_K
  #undef DMA_V
  #undef CMASK
  #undef CBIAS
  #undef START
  #undef RESC
  #undef ROT
}
constexpr int ATTN_LDS_BYTES=LDS_BYTES;
#undef SBAR
#undef WAIT_BAR
}

namespace topk {
typedef short bf16x8 __attribute__((ext_vector_type(8)));
typedef float f32x16 __attribute__((ext_vector_type(16)));
#define TK_WL4(wa_, wb_, a0_, a1_, b0_, b1_, j0) asm volatile("s_nop 3\n\tv_writelane_b32 %0, %2, %6\n\tv_writelane_b32 %0, %3, %7\n\tv_writelane_b32 %1, %4, %6\n\tv_writelane_b32 %1, %5, %7" : "+v"(wa_), "+v"(wb_) : "s"(a0_), "s"(a1_), "s"(b0_), "s"(b1_), "n"(j0), "n"((j0) + 1))
__device__ __forceinline__ unsigned fkey(float f) { const unsigned u = __float_as_uint(f); return (u & 0x80000000u) ? ~u : (u | 0x80000000u); }
template <int CTRL> __device__ __forceinline__ unsigned dpp_u(unsigned v) { return (unsigned)__builtin_amdgcn_update_dpp(0, (int)v, CTRL, 0xF, 0xF, true); }
__device__ __forceinline__ unsigned wsum_u(unsigned v) {
    v += dpp_u<0xB1>(v); v += dpp_u<0x4E>(v); v += dpp_u<0x141>(v); v += dpp_u<0x140>(v);
    auto r = __builtin_amdgcn_permlane16_swap(v, v, false, false); v = r[0] + r[1];
    auto r2 = __builtin_amdgcn_permlane32_swap(v, v, false, false); return r2[0] + r2[1];
}
__device__ __forceinline__ void unit(const bf16* __restrict__ qq, const bf16* __restrict__ ki, const float* __restrict__ wi, unsigned* __restrict__ sel, int b, int t0, LAS unsigned* keys, int wave, int lane) {
    if (t0 + 15 < TOPK) {
#pragma unroll
        for (int q = 0; q < 2; ++q) { const int t = t0 + 2 * wave + q, lo = 32 * lane; unsigned w = 0u; if (lo + 31 <= t) w = 0xffffffffu; else if (lo <= t) w = (2u << (t - lo)) - 1u;
            sel[((size_t)b * L + t) * 64 + lane] = w; }
        return;
    }
    const int jd = (t0 + 15) >> 5;
#ifndef TK_REP_SCORE
#define TK_REP_SCORE 1
#endif
#ifndef TK_REP_SEL
#define TK_REP_SEL 1
#endif
    for (int rs_ = 0; rs_ < TK_REP_SCORE; ++rs_) {
        const int c = lane & 31, hf = lane >> 5;
        const int qa = ((c >> 4) << 1) | ((c >> 2) & 1), ha = (c & 3) | (((c >> 3) & 1) << 2);
        bf16x8 af[4][4]; float wA[4][8], wB[4][8];
#pragma unroll
        for (int rg = 0; rg < 4; ++rg) {
            const bf16* ap = qq + ((size_t)b * L + t0 + 4 * rg + qa) * NQQ + ha * 64 + 32 * hf;
#pragma unroll
            for (int s = 0; s < 4; ++s) af[rg][s] = *(const bf16x8*)(ap + 8 * s);
            const f32x4* wp = (const f32x4*)(wi + ((size_t)b * L + t0 + 4 * rg + hf) * 8); const f32x4 w0 = wp[0], w1 = wp[1], w2 = wp[4], w3 = wp[5];
#pragma unroll
            for (int k = 0; k < 4; ++k) { wA[rg][k] = w0[k]; wA[rg][4 + k] = w1[k]; wB[rg][k] = w2[k]; wB[rg][4 + k] = w3[k]; }
        }
        const bf16* kp = ki + ((size_t)b * L + c) * 64 + 32 * hf;
        bf16x8 bn[4];
        if (wave <= jd) {
#pragma unroll
            for (int s = 0; s < 4; ++s) bn[s] = *(const bf16x8*)(kp + (size_t)wave * 32 * 64 + 8 * s);
        }
        for (int j = wave; j <= jd; j += 8) {
            bf16x8 bc[4];
#pragma unroll
            for (int s = 0; s < 4; ++s) bc[s] = bn[s];
            if (j + 8 <= jd) {
#pragma unroll
                for (int s = 0; s < 4; ++s) bn[s] = *(const bf16x8*)(kp + (size_t)(j + 8) * 32 * 64 + 8 * s);
            }
            const int key = 32 * j + c;
#pragma unroll
            for (int rg = 0; rg < 4; ++rg) {
                f32x16 acc = {};
#pragma unroll
                for (int s = 0; s < 4; ++s) acc = __builtin_amdgcn_mfma_f32_32x32x16_bf16(af[rg][s], bc[s], acc, 0, 0, 0);
                float sa = 0.f, sb = 0.f;
#pragma unroll
                for (int h = 0; h < 8; ++h) { sa += wA[rg][h] * __builtin_amdgcn_fmed3f(acc[h], 0.f, __builtin_inff()); sb += wB[rg][h] * __builtin_amdgcn_fmed3f(acc[8 + h], 0.f, __builtin_inff()); }
                const int tA = t0 + 4 * rg + hf, tB = tA + 2;
                LAS unsigned* kA = keys + (4 * rg + hf) * 2048 + key;
                kA[0] = key > tA ? 0u : fkey(sa); kA[2 * 2048] = key > tB ? 0u : fkey(sb);
            }
        }
    }
    __syncthreads();
    for (int rs_ = 0; rs_ < TK_REP_SEL; ++rs_) {
        const int nvalid = 32 * (jd + 1);
        unsigned kA[32], kB[32];
        const LAS unsigned* pa = keys + (2 * wave) * 2048 + lane; const LAS unsigned* pb = pa + 2048;
#pragma unroll
        for (int i = 0; i < 32; ++i) { const bool ok = 64 * i + lane < nvalid; kA[i] = ok ? pa[64 * i] : 0u; kB[i] = ok ? pb[64 * i] : 0u; }
        const int ilim = (nvalid + 63) >> 6;
        unsigned pA = 0u, pB = 0u; bool doneA = false, doneB = false;
        for (int bit = 31; bit >= 0; --bit) {
            const unsigned cA = pA | (1u << bit), cB = pB | (1u << bit); unsigned cnt = 0u;
#pragma unroll
            for (int g4 = 0; g4 < 8; ++g4) { if (4 * g4 < ilim) {
#pragma unroll
                for (int i = 4 * g4; i < 4 * g4 + 4; ++i) { cnt += (kA[i] >= cA) ? 1u : 0u; cnt += (kB[i] >= cB) ? 0x10000u : 0u; } __builtin_amdgcn_sched_barrier(0); } }
            cnt = wsum_u(cnt);
            const unsigned nA = cnt & 0xffffu, nB = cnt >> 16;
            if (!doneA && nA >= (unsigned)TOPK) pA = cA;
            if (!doneB && nB >= (unsigned)TOPK) pB = cB;
            doneA = doneA || nA == (unsigned)TOPK; doneB = doneB || nB == (unsigned)TOPK;
            if (doneA && doneB) break;
        }
        unsigned cge = 0u, cgt = 0u;
#pragma unroll
        for (int i = 0; i < 32; ++i) { cge += (kA[i] >= pA) ? 1u : 0u; cge += (kB[i] >= pB) ? 0x10000u : 0u; cgt += (kA[i] > pA) ? 1u : 0u; cgt += (kB[i] > pB) ? 0x10000u : 0u; if ((i & 3) == 3) __builtin_amdgcn_sched_barrier(0); }
        cge = wsum_u(cge); cgt = wsum_u(cgt);
        asm volatile("" : "+v"(pA), "+v"(pB));
        const bool tie = (cge & 0xffffu) != (unsigned)TOPK || (cge >> 16) != (unsigned)TOPK;
        unsigned wa = 0u, wb = 0u;
        if (!tie) {
#pragma unroll
            for (int i = 0; i < 32; ++i) {
                const unsigned long long mA = __builtin_amdgcn_ballot_w64(kA[i] >= pA), mB = __builtin_amdgcn_ballot_w64(kB[i] >= pB);
                const unsigned a0 = (unsigned)mA, a1 = (unsigned)(mA >> 32), b0 = (unsigned)mB, b1 = (unsigned)(mB >> 32);
                TK_WL4(wa, wb, a0, a1, b0, b1, 2 * i); __builtin_amdgcn_sched_barrier(0);
            }
        } else {
            const unsigned needA = (unsigned)TOPK - (cgt & 0xffffu), needB = (unsigned)TOPK - (cgt >> 16); unsigned runA = 0u, runB = 0u;
            const unsigned long long below = (1ull << lane) - 1ull;
#pragma unroll
            for (int i = 0; i < 32; ++i) {
                const unsigned long long eA = __builtin_amdgcn_ballot_w64(kA[i] == pA), eB = __builtin_amdgcn_ballot_w64(kB[i] == pB);
                const bool tkA = kA[i] > pA || (kA[i] == pA && runA + (unsigned)__builtin_popcountll(eA & below) < needA);
                const bool tkB = kB[i] > pB || (kB[i] == pB && runB + (unsigned)__builtin_popcountll(eB & below) < needB);
                runA += (unsigned)__builtin_popcountll(eA); runB += (unsigned)__builtin_popcountll(eB);
                const unsigned long long mA = __builtin_amdgcn_ballot_w64(tkA), mB = __builtin_amdgcn_ballot_w64(tkB);
                const unsigned a0 = (unsigned)mA, a1 = (unsigned)(mA >> 32), b0 = (unsigned)mB, b1 = (unsigned)(mB >> 32);
                TK_WL4(wa, wb, a0, a1, b0, b1, 2 * i); __builtin_amdgcn_sched_barrier(0);
            }
        }
        unsigned* so = sel + ((size_t)b * L + t0 + 2 * wave) * 64 + lane;
        so[0] = wa; so[64] = wb;
    }
    __syncthreads();
}
#undef TK_WL4
}

namespace sparse {
typedef short bf16x8 __attribute__((ext_vector_type(8)));
typedef short s16x4 __attribute__((ext_vector_type(4)));
typedef float f32x4 __attribute__((ext_vector_type(4)));
typedef int i32x4 __attribute__((ext_vector_type(4)));
typedef unsigned u32x4 __attribute__((ext_vector_type(4)));
typedef __attribute__((address_space(3))) const char* lds_cptr;
typedef short v4i16_t __attribute__((ext_vector_type(4)));
constexpr int BUF = 8192, LIST = 1024, WAVE_LDS = 2 * BUF + 2 * LIST, BT_OFF = 8 * WAVE_LDS, LDS_NEED = BT_OFF + 8192;
__device__ __forceinline__ int fsw(int r) { return ((((r & 7) ^ ((r >> 3) << 2))) << 1) | (r >> 3); }
__device__ __forceinline__ void glds16(const void* gsrc, unsigned lds_dst) { unsigned keep;
    asm volatile("s_mov_b32 %0, m0\n\ts_mov_b32 m0, %2\n\ts_nop 0\n\tglobal_load_lds_dwordx4 %1, off\n\ts_mov_b32 m0, %0" : "=&s"(keep) : "v"(gsrc), "s"(lds_dst) : "memory"); }
__device__ __forceinline__ s16x4 vtr(lds_cptr p) { return __builtin_bit_cast(s16x4, __builtin_amdgcn_ds_read_tr16_b64_v4i16((__attribute__((address_space(3))) v4i16_t*)p)); }
__device__ __forceinline__ float xmax16(float v) { auto r = __builtin_amdgcn_permlane16_swap(__float_as_uint(v), __float_as_uint(v), false, false); return fmaxf(__uint_as_float(r[0]), __uint_as_float(r[1])); }
__device__ __forceinline__ float xmax32(float v) { auto r = __builtin_amdgcn_permlane32_swap(__float_as_uint(v), __float_as_uint(v), false, false); return fmaxf(__uint_as_float(r[0]), __uint_as_float(r[1])); }
__device__ __forceinline__ unsigned cvtpk(float lo, float hi) { typedef float f2 __attribute__((ext_vector_type(2))); typedef __bf16 b2 __attribute__((ext_vector_type(2))); f2 v = {lo, hi}; b2 b = __builtin_convertvector(v, b2); return __builtin_bit_cast(unsigned, b); }
template <int CTRL> __device__ __forceinline__ int dpp_i(int v) { return __builtin_amdgcn_update_dpp(0, v, CTRL, 0xF, 0xF, true); }

__device__ __forceinline__ int expand(unsigned word, int t, unsigned* list, int lane) {
    const int cntl = __builtin_popcount(word);
    int v = cntl;
    v += __builtin_amdgcn_update_dpp(0, v, 0x111, 0xF, 0xF, true);
    v += __builtin_amdgcn_update_dpp(0, v, 0x112, 0xF, 0xF, true);
    v += __builtin_amdgcn_update_dpp(0, v, 0x114, 0xF, 0xF, true);
    v += __builtin_amdgcn_update_dpp(0, v, 0x118, 0xF, 0xF, true);
    v += __builtin_amdgcn_update_dpp(0, v, 0x142, 0xA, 0xF, true);
    v += __builtin_amdgcn_update_dpp(0, v, 0x143, 0xC, 0xF, true);
    const int total = __builtin_amdgcn_readlane(v, 63);
    int slot = v - cntl; unsigned w = word;
    const int maxc = total;
    while (__builtin_amdgcn_ballot_w64(w != 0u) != 0ull) {
        if (w != 0u) { const int bpos = __builtin_ctz(w); w &= w - 1u; const int key = 32 * lane + bpos;
            if (slot < 256) { int d = t - key; d = d > 127 ? 127 : d; list[slot] = ((unsigned)key << 8) | ((unsigned)d << 24); }
            ++slot; }
    }
    (void)maxc;
    { const int s = total + (lane & 31); if (lane < 32 && s < 256) list[s] = 0u; }
    return total < 256 ? total : 256;
}

__device__ __forceinline__ void stream(const bf16* __restrict__ qq, const bf16* __restrict__ ckv, const unsigned* __restrict__ sel, bf16* __restrict__ olat, int q0, int nq, char* wl, const float* btl, int lane) {
    const int hd = lane & 15, quad = lane >> 4;
    const unsigned lds0 = (unsigned)(uintptr_t)wl; const lds_cptr wl3 = (lds_cptr)wl;
    unsigned* lists = (unsigned*)(wl + 2 * BUF);
    const int fk = fsw(hd);
    const int qp_ = hd >> 2, pp_ = hd & 3, rv = 4 * quad + qp_, fv = fsw(rv);
    int swz[4];
#pragma unroll
    for (int i = 0; i < 4; ++i) swz[i] = 16 * (hd ^ fsw(4 * i + quad));
    const lds_cptr btl3 = (lds_cptr)(const char*)btl + 4 * hd;
#define SP_DMA(gb, li, ch, bufoff) do { const unsigned* l_ = lists + (li) * 256 + 32 * (ch) + quad; _Pragma("unroll") for (int i_ = 0; i_ < 8; ++i_) { \
        glds16((const char*)(gb) + ((l_[4 * i_] & 0xffffffu) + (unsigned)swz[i_ & 3]), (unsigned)__builtin_amdgcn_readfirstlane(lds0 + (bufoff) + 1024 * i_)); } } while (0)
#define SP_LOADQ(dst, row) do { const bf16* qp__ = qq + (size_t)(row) * NQQ + 512 + hd * 128 + 8 * quad; _Pragma("unroll") for (int s_ = 0; s_ < 4; ++s_) dst[s_] = *(const bf16x8*)(qp__ + 32 * s_); } while (0)
    bf16x8 qf[4], qfn[4]; unsigned wnext = 0u; int ncur, nnext = 0, li = 0, bufsel = 0;
    {
        SP_LOADQ(qf, q0);
        const unsigned w0 = sel[(size_t)q0 * 64 + lane];
        if (nq > 1) wnext = sel[(size_t)(q0 + 1) * 64 + lane];
        ncur = expand(w0, q0 % L, lists, lane);
        asm volatile("s_waitcnt lgkmcnt(0)" ::: "memory");
        SP_DMA(ckv + (size_t)(q0 / L) * L * 128, 0, 0, 0);
    }
    for (int qi = 0; qi < nq; ++qi) {
        const int row = q0 + qi, b = row / L, t = row % L, nch = (ncur + 31) >> 5;
        if (qi + 1 < nq) {
            nnext = expand(wnext, (row + 1) % L, lists + (li ^ 1) * 256, lane);
            SP_LOADQ(qfn, row + 1);
            if (qi + 2 < nq) wnext = sel[(size_t)(row + 2) * 64 + lane];
            asm volatile("s_waitcnt lgkmcnt(0)" ::: "memory");
        }
        f32x4 o[8];
#pragma unroll
        for (int rb = 0; rb < 8; ++rb) o[rb] = (f32x4){0.f, 0.f, 0.f, 0.f};
        float mref = -INFINITY, lsum = 0.f;
        const unsigned* dl = lists + li * 256 + 4 * quad;
        for (int ch = 0; ch < nch; ++ch) {
            const int bo = bufsel * BUF;
            if (ch + 1 < nch) { SP_DMA(ckv + (size_t)b * L * 128, li, ch + 1, BUF - bo); asm volatile("s_waitcnt vmcnt(8)" ::: "memory"); }
            else if (qi + 1 < nq) { SP_DMA(ckv + (size_t)((row + 1) / L) * L * 128, li ^ 1, 0, BUF - bo); asm volatile("s_waitcnt vmcnt(8)" ::: "memory"); }
            else asm volatile("s_waitcnt vmcnt(0)" ::: "memory");
            f32x4 sc[2];
#pragma unroll
            for (int T = 0; T < 2; ++T) { f32x4 acc = {0.f, 0.f, 0.f, 0.f}; const lds_cptr kr = wl3 + bo + 256 * (16 * T + hd);
#pragma unroll
                for (int s = 0; s < 4; ++s) { const bf16x8 kf = *(const __attribute__((address_space(3))) bf16x8*)(kr + 16 * ((4 * s + quad) ^ fk));
                    acc = __builtin_amdgcn_mfma_f32_16x16x32_bf16(kf, qf[s], acc, 0, 0, 0); }
                sc[T] = acc; }
#pragma unroll
            for (int T = 0; T < 2; ++T) { const u32x4 dx = *(const u32x4*)(dl + 32 * ch + 16 * T);
#pragma unroll
                for (int r = 0; r < 4; ++r) sc[T][r] += *(const __attribute__((address_space(3))) float*)(btl3 + ((dx[r] >> 18) & 0x3fc0u)); }
            if (ch == nch - 1 && (ncur & 31)) {
#pragma unroll
                for (int T = 0; T < 2; ++T)
#pragma unroll
                    for (int r = 0; r < 4; ++r) if (32 * ch + 16 * T + 4 * quad + r >= ncur) sc[T][r] = -INFINITY;
            }
            float mloc = fmaxf(fmaxf(fmaxf(sc[0][0], sc[0][1]), fmaxf(sc[0][2], sc[0][3])), fmaxf(fmaxf(sc[1][0], sc[1][1]), fmaxf(sc[1][2], sc[1][3])));
            mloc = xmax32(xmax16(mloc));
            if (__builtin_amdgcn_ballot_w64(mloc > mref + 8.f) != 0ull) {
                const float mn = fmaxf(mref, mloc), f = __builtin_amdgcn_exp2f(mref - mn); mref = mn; lsum *= f;
#pragma unroll
                for (int rb = 0; rb < 8; ++rb) o[rb] = o[rb] * f;
            }
            float p0[4], p1[4];
#pragma unroll
            for (int r = 0; r < 4; ++r) { p0[r] = __builtin_amdgcn_exp2f(sc[0][r] - mref); p1[r] = __builtin_amdgcn_exp2f(sc[1][r] - mref); lsum += p0[r] + p1[r]; }
            const u32x4 pw = {cvtpk(p0[0], p0[1]), cvtpk(p0[2], p0[3]), cvtpk(p1[0], p1[1]), cvtpk(p1[2], p1[3])};
            const bf16x8 pb = __builtin_bit_cast(bf16x8, pw);
            const lds_cptr v0p = wl3 + bo + 256 * rv + 8 * (pp_ & 1), v1p = v0p + 256 * 16;
#pragma unroll
            for (int rb = 0; rb < 8; ++rb) { const int pos = 16 * ((2 * rb + (pp_ >> 1)) ^ fv);
                const s16x4 a0 = vtr(v0p + pos), a1 = vtr(v1p + pos);
                const bf16x8 va = {a0[0], a0[1], a0[2], a0[3], a1[0], a1[1], a1[2], a1[3]};
                o[rb] = __builtin_amdgcn_mfma_f32_16x16x32_bf16(va, pb, o[rb], 0, 0, 0); }
            bufsel ^= 1;
        }
        lsum = xsum32(xsum16(lsum));
        const float inv = __builtin_amdgcn_rcpf(lsum);
        bf16* op = olat + (size_t)row * 2048 + hd * 128 + 4 * quad;
#pragma unroll
        for (int rb = 0; rb < 8; ++rb) { typedef unsigned u32x2v __attribute__((ext_vector_type(2)));
            const u32x2v w = {cvtpk(o[rb][0] * inv, o[rb][1] * inv), cvtpk(o[rb][2] * inv, o[rb][3] * inv)};
            *(u32x2v*)(op + 16 * rb) = w; }
        li ^= 1; ncur = nnext;
#pragma unroll
        for (int s = 0; s < 4; ++s) qf[s] = qfn[s];
    }
    asm volatile("s_waitcnt lgkmcnt(0)" ::: "memory");
#undef SP_DMA
#undef SP_LOADQ
}
}

namespace topk2 {
typedef short bf16x8 __attribute__((ext_vector_type(8)));
typedef float f32x4 __attribute__((ext_vector_type(4)));
__device__ __forceinline__ unsigned fkey(float f) { const unsigned u = __float_as_uint(f); return (u & 0x80000000u) ? ~u : (u | 0x80000000u); }
__device__ __forceinline__ float relu(float v) { return __builtin_amdgcn_fmed3f(v, 0.f, __builtin_inff()); }
template <int CTRL> __device__ __forceinline__ unsigned dpp_u(unsigned v) { return (unsigned)__builtin_amdgcn_update_dpp(0, (int)v, CTRL, 0xF, 0xF, true); }
__device__ __forceinline__ unsigned half_sum(unsigned v) {
    v += dpp_u<0xB1>(v); v += dpp_u<0x4E>(v); v += dpp_u<0x141>(v); v += dpp_u<0x140>(v);
    auto r = __builtin_amdgcn_permlane16_swap(v, v, false, false); return r[0] + r[1];
}
#define TK2_WL2(w0_, w1_, a0_, a1_, j0) asm volatile("s_nop 3\n\tv_writelane_b32 %0, %2, %4\n\tv_writelane_b32 %1, %3, %4" : "+v"(w0_), "+v"(w1_) : "s"(a0_), "s"(a1_), "n"(j0))
__device__ __forceinline__ void pair(const bf16* __restrict__ qq, const bf16* __restrict__ ki, const float* __restrict__ wi, unsigned* __restrict__ sel, int b, int t0, int lane) {
    const int hd16 = lane & 15, quad = lane >> 4, hf = lane >> 5, qd1 = quad & 1;
    unsigned* so = sel + ((size_t)b * L + t0) * 64 + lane;
    if (t0 + 1 < TOPK) {
#pragma unroll
        for (int q = 0; q < 2; ++q) { const int t = t0 + q, lo = 32 * lane; unsigned w = 0u; if (lo + 31 <= t) w = 0xffffffffu; else if (lo <= t) w = (2u << (t - lo)) - 1u; so[q * 64] = w; }
        return;
    }
    bf16x8 af[2];
    { const bf16* ap = qq + ((size_t)b * L + t0 + (hd16 >> 3)) * NQQ + (hd16 & 7) * 64 + 16 * quad; af[0] = *(const bf16x8*)ap; af[1] = *(const bf16x8*)(ap + 8); }
    const f32x4 w4 = *(const f32x4*)(wi + ((size_t)b * L + t0 + hf) * 8 + 4 * qd1);
    const int tq = t0 + hf, tmax = t0 + 1;
    const bf16* kp = ki + ((size_t)b * L + hd16) * 64 + 16 * quad;
    unsigned kr[64];
    bf16x8 bb[2][4][2];
#define TK2_LOADG(g, buf) do { _Pragma("unroll") for (int tt_ = 0; tt_ < 4; ++tt_) { bb[buf][tt_][0] = *(const bf16x8*)(kp + (size_t)(4 * (g) + tt_) * 1024); bb[buf][tt_][1] = *(const bf16x8*)(kp + (size_t)(4 * (g) + tt_) * 1024 + 8); } } while (0)
#ifndef TK2_REP_SCORE
#define TK2_REP_SCORE 1
#endif
#ifndef TK2_REP_SEL
#define TK2_REP_SEL 1
#endif
    for (int rs_ = 0; rs_ < TK2_REP_SCORE; ++rs_) {
    TK2_LOADG(0, 0);
#pragma unroll
    for (int g = 0; g < 32; ++g) {
        if (64 * g <= tmax) {
            if (g + 1 < 32) { if (64 * (g + 1) <= tmax) TK2_LOADG(g + 1, (g + 1) & 1); }
#pragma unroll
            for (int pr = 0; pr < 2; ++pr) {
                f32x4 aE = {0.f, 0.f, 0.f, 0.f}, aO = {0.f, 0.f, 0.f, 0.f};
                aE = __builtin_amdgcn_mfma_f32_16x16x32_bf16(af[0], bb[g & 1][2 * pr][0], aE, 0, 0, 0); aO = __builtin_amdgcn_mfma_f32_16x16x32_bf16(af[0], bb[g & 1][2 * pr + 1][0], aO, 0, 0, 0);
                aE = __builtin_amdgcn_mfma_f32_16x16x32_bf16(af[1], bb[g & 1][2 * pr][1], aE, 0, 0, 0); aO = __builtin_amdgcn_mfma_f32_16x16x32_bf16(af[1], bb[g & 1][2 * pr + 1][1], aO, 0, 0, 0);
                float pE = w4[0] * relu(aE[0]), pO = w4[0] * relu(aO[0]);
#pragma unroll
                for (int r = 1; r < 4; ++r) { pE += w4[r] * relu(aE[r]); pO += w4[r] * relu(aO[r]); }
                pE = xsum16(pE); pO = xsum16(pO);
                const float sv = qd1 ? pO : pE;
                const int key = 32 * (2 * g + pr) + (lane & 31);
                kr[2 * g + pr] = key > tq ? 0u : fkey(sv);
            }
        } else { kr[2 * g] = 0u; kr[2 * g + 1] = 0u; }
    }
    }
#undef TK2_LOADG
    const int ilim = (tmax + 32) >> 5;
    unsigned pfx = 0u; bool done = false;
    for (int rs_ = 0; rs_ < TK2_REP_SEL; ++rs_) { pfx = 0u; done = false; asm volatile("" : "+v"(pfx));
    for (int bit = 31; bit >= 0; --bit) {
        const unsigned cand = pfx | (1u << bit); unsigned cnt = 0u;
#pragma unroll
        for (int g4 = 0; g4 < 16; ++g4) { if (4 * g4 < ilim) {
#pragma unroll
            for (int i = 4 * g4; i < 4 * g4 + 4; ++i) cnt += (kr[i] >= cand) ? 1u : 0u; } }
        cnt = half_sum(cnt);
        if (!done && cnt >= (unsigned)TOPK) pfx = cand;
        done = done || cnt == (unsigned)TOPK;
        if (__builtin_amdgcn_ballot_w64(!done) == 0ull) break;
    }
    }
    unsigned cge = 0u, cgt = 0u;
#pragma unroll
    for (int i = 0; i < 64; ++i) { cge += (kr[i] >= pfx) ? 1u : 0u; cgt += (kr[i] > pfx) ? 1u : 0u; }
    cge = half_sum(cge); cgt = half_sum(cgt);
    asm volatile("" : "+v"(pfx));
    const bool tie = __builtin_amdgcn_ballot_w64(cge != (unsigned)TOPK) != 0ull;
    unsigned w0 = 0u, w1 = 0u;
    if (!tie) {
#pragma unroll
        for (int i = 0; i < 64; ++i) { const unsigned long long m = __builtin_amdgcn_ballot_w64(kr[i] >= pfx); const unsigned m0 = (unsigned)m, m1 = (unsigned)(m >> 32);
            TK2_WL2(w0, w1, m0, m1, i); __builtin_amdgcn_sched_barrier(0); }
    } else {
        const unsigned need = (unsigned)TOPK - cgt; unsigned run = 0u; const unsigned below = (1u << (lane & 31)) - 1u;
#pragma unroll
        for (int i = 0; i < 64; ++i) { const unsigned long long e = __builtin_amdgcn_ballot_w64(kr[i] == pfx); const unsigned eh = hf ? (unsigned)(e >> 32) : (unsigned)e;
            const bool tk = kr[i] > pfx || (kr[i] == pfx && run + (unsigned)__builtin_popcount(eh & below) < need);
            run += (unsigned)__builtin_popcount(eh);
            const unsigned long long m = __builtin_amdgcn_ballot_w64(tk); const unsigned m0 = (unsigned)m, m1 = (unsigned)(m >> 32);
            TK2_WL2(w0, w1, m0, m1, i); __builtin_amdgcn_sched_barrier(0); }
    }
    so[0] = w0; so[64] = w1;
}
#undef TK2_WL2
}

constexpr int NWAVES = 8;
constexpr int RING_OFF = 0, RING_BYTES = 131072;
constexpr int LDSCTL_OFF = 162816, MISC_OFF = LDSCTL_OFF + 320;
constexpr int LDS_BYTES = 163840;
static_assert(sparse::LDS_NEED <= LDSCTL_OFF && attn2::ATTN_LDS_BYTES <= LDSCTL_OFF, "phase LDS");
enum { PH_PRO = 0, PH_PRE0, PH_INPROJ0, PH_QGEMM, PH_TOPK, PH_SPARSE, PH_UV, PH_OUT0, PH_POST0, PH_INPROJ1, PH_ATTN1, PH_OUT1, PH_FINAL, N_PHASES };

struct Args { const float* in[N_IN]; float* out; unsigned char* ws; int ph_lo, ph_hi, li, pad; };

__device__ __forceinline__ int fresh_lane(int dep = 0) { int l; asm volatile("v_mbcnt_lo_u32_b32 %0, -1, 0\n\tv_mbcnt_hi_u32_b32 %0, -1, %0 ; dep %1" : "=v"(l) : "s"(dep)); return l; }
__device__ __forceinline__ float wave_sum(float v) { return wave_sum_all(v); }
template <bool HAS_G> __device__ __forceinline__ void p0_transpose_item(const float* W, int K, int N, int Npad, const float* g, bf16* WT, LAS float* scr, int item, int lane) {
    const int nblk = Npad / 32, kb = item / nblk, nb = item % nblk, k0 = 64 * kb, n0 = 32 * nb;
    const bool ok = (n0 + (lane & 31)) < N; const int nc = ok ? n0 + (lane & 31) : N - 1;
    const float* wp = W + (size_t)(k0 + (lane >> 5)) * N + nc; float v[32];
#pragma unroll
    for (int i = 0; i < 32; ++i) v[i] = wp[(size_t)(2 * i) * N];
    if (HAS_G) {
#pragma unroll
        for (int i = 0; i < 32; ++i) v[i] *= g[k0 + 2 * i + (lane >> 5)];
    }
#pragma unroll
    for (int i = 0; i < 32; ++i) scr[(2 * i + (lane >> 5)) * 33 + (lane & 31)] = ok ? v[i] : 0.f;
    LDS_WAIT(); asm volatile("" ::: "memory");
    const int c = lane & 7;
#pragma unroll
    for (int j = 0; j < 4; ++j) { const int n = (lane >> 3) + 8 * j; const LAS float* s = scr + (8 * c) * 33 + n;
        v4u o; o.x = pk2(s[0 * 33], s[1 * 33]); o.y = pk2(s[2 * 33], s[3 * 33]); o.z = pk2(s[4 * 33], s[5 * 33]); o.w = pk2(s[6 * 33], s[7 * 33]);
        *(GAS v4u*)(WT + (size_t)(n0 + n) * K + k0 + 8 * c) = o; }
    LDS_WAIT(); asm volatile("" ::: "memory");
}
typedef const __attribute__((address_space(4))) Args CArgs;
__device__ __forceinline__ CArgs* kargs(int dep) { CArgs* p = (CArgs*)__builtin_amdgcn_kernarg_segment_ptr(); asm volatile("; kargs %1" : "+s"(p) : "s"(dep)); return p; }
__device__ __forceinline__ void p0_mod(CArgs* ap, LAS unsigned char* lds, int tid, int lane, int wave, int vcu, int G) {
    unsigned char* ws = ap->ws;
    float* mod = (float*)(ws + WS_MOD); Misc* ms = (Misc*)(ws + WS_MISC);
    if (vcu < 96) {
        LAS float* cact = (LAS float*)lds;
        LAS float* red = (LAS float*)(lds + 32768);
        const float* c = ap->in[I_C];
        for (int i = tid; i < NB * D; i += NWAVES * 64) cact[i] = siluf(c[i]);
        __syncthreads();
        const int li = vcu / 48, n = (vcu % 48) * 64 + lane; const float* mw = ap->in[I_MODW] + ((size_t)li * D + wave * 128) * 3072 + n;
        float acc[NB];
#pragma unroll
        for (int b = 0; b < NB; ++b) acc[b] = 0.f;
        for (int k0 = 0; k0 < 128; k0 += 16) { float wv[16];
#pragma unroll
            for (int k = 0; k < 16; ++k) wv[k] = mw[(size_t)(k0 + k) * 3072];
#pragma unroll
            for (int k = 0; k < 16; ++k) {
#pragma unroll
                for (int b = 0; b < NB; ++b) acc[b] += cact[b * D + wave * 128 + k0 + k] * wv[k]; } }
#pragma unroll
        for (int b = 0; b < NB; ++b) red[(wave * NB + b) * 64 + lane] = acc[b];
        __syncthreads();
        { const int b = tid >> 6; float s = 0.f;
#pragma unroll
          for (int w = 0; w < NWAVES; ++w) s += red[(w * NB + b) * 64 + lane];
          mod[((size_t)li * NB + b) * 3072 + n] = s + ap->in[I_MODB][li * 3072 + n]; }
        __syncthreads();
    }
    if (vcu == 96 && tid < 128) {
        const int t = tid;
        if (t == 0) { float s1 = 0.f, s2 = 0.f; for (int i = 0; i < 64; ++i) { s1 += ap->in[I_BLQ1][i] * ap->in[I_BLK1][i]; s2 += ap->in[I_BLQ2][i] * ap->in[I_BLK2][i]; } ms->lam = expf(s1) - expf(s2) + LAMBDA_INIT; }
        int bk; if (t < 16) bk = t; else { bk = 16 + (int)(logf((float)t / 16.f) / 2.0794415416798357f * 16.f); if (bk > 31) bk = 31; } ms->lut[t] = bk;
        for (int cix = 0; cix < 16; ++cix) ms->btab[t * 16 + cix] = ap->in[I_RELB][bk * 16 + cix];
    }
}
__device__ __forceinline__ void p0_weights(CArgs* ap, LAS unsigned char* lds, int lane, int wave, int vcu, int G) {
    unsigned char* ws = ap->ws;
    LAS float* scr = (LAS float*)(lds + RING_OFF + wave * 16384);
    const int gw = vcu * NWAVES + wave, NGW = G * NWAVES;
    bf16 *win0 = (bf16*)(ws + WS_WIN0), *wq2 = (bf16*)(ws + WS_WQ2), *wuv = (bf16*)(ws + WS_WUV), *wout0 = (bf16*)(ws + WS_WOUT0), *win1 = (bf16*)(ws + WS_WIN1), *wout1 = (bf16*)(ws + WS_WOUT1);
    constexpr int I_A = 16 * 48, I_QI = 4 * 16, I_O0 = 16 * 32, I_B = 16 * 128, I_O1 = 16 * 32, NITEMS = I_A + I_QI + I_O0 + I_B + I_O1;
    for (int it = gw; it < NITEMS; it += NGW) {
        int r = it;
        if (r < I_B) { p0_transpose_item<false>(ap->in[I_BWIN], D, B_IN, B_IN, nullptr, win1, scr, r, lane); continue; } r -= I_B;
        if (r < I_A) { p0_transpose_item<false>(ap->in[I_AWIN], D, A_IN, A_INP, nullptr, win0, scr, r, lane); continue; } r -= I_A;
        if (r < I_O0) { p0_transpose_item<false>(ap->in[I_AWOUT], D, D, D, nullptr, wout0, scr, r, lane); continue; } r -= I_O0;
        if (r < I_O1) { p0_transpose_item<false>(ap->in[I_BWOUT], D, D, D, nullptr, wout1, scr, r, lane); continue; } r -= I_O1;
        p0_transpose_item<true>(ap->in[I_AWQIDX], QR, 512, 512, ap->in[I_AQN], wq2, scr, r, lane);
    }
    for (int it = gw; it < 16 * 4 * 32; it += NGW) {
        const int h = it >> 7, kt = (it >> 5) & 3, r0 = (it & 31) * 4, k = kt * 64 + lane;
        const float* uq = ap->in[I_AWUQ] + (size_t)k * 1024 + h * 64; float av[64];
#pragma unroll
        for (int d4 = 0; d4 < 16; ++d4) { const f32x4 t4 = *(const f32x4*)(uq + 4 * d4); av[4 * d4] = t4[0]; av[4 * d4 + 1] = t4[1]; av[4 * d4 + 2] = t4[2]; av[4 * d4 + 3] = t4[3]; }
        const float gk = ap->in[I_AQN][k] * C2;
#pragma unroll
        for (int rr = 0; rr < 4; ++rr) { const int r = r0 + rr; const float* uk = ap->in[I_AWUK] + ((size_t)h * 128 + r) * 64; float s = 0.f;
#pragma unroll
            for (int d = 0; d < 64; ++d) s += av[d] * uk[d];
            wq2[(size_t)(512 + h * 128 + r) * 256 + k] = (bf16)f2bf(s * gk); }
    }
    for (int i = gw * 64 + lane; i < 1024 * 512; i += NGW * 64) {
        const int n = i >> 9, kp = i & 511, h = n >> 6, d = n & 63; float v = 0.f;
        if ((kp >> 7) == ((n & 255) >> 6)) v = ap->in[I_AWUV][((size_t)h * 128 + (kp & 127)) * 64 + d];
        wuv[i] = (bf16)f2bf(v);
    }
}
__device__ __forceinline__ void prenorm_rows(const float* x, const float* g, const float* modl, bf16* H, int gw, int NGW, int lane) {
    for (int row = gw; row < M; row += NGW) {
        const int b = row / L; const GAS f32x4* xr = (const GAS f32x4*)(x + (size_t)row * D) + lane;
        f32x4 v[4]; float s = 0.f;
#pragma unroll
        for (int j = 0; j < 4; ++j) { v[j] = xr[64 * j]; s += (v[j].x * v[j].x + v[j].y * v[j].y) + (v[j].z * v[j].z + v[j].w * v[j].w); }
        const float rs = rsqrtf(wave_sum(s) * (1.f / D) + EPS);
        const f32x4* g4 = (const f32x4*)g + lane; const f32x4* sh4 = (const f32x4*)(modl + (size_t)b * 3072) + lane; const f32x4* sc4 = sh4 + 256;
        GAS unsigned long long* o8 = (GAS unsigned long long*)(H + (size_t)row * D) + lane;
#pragma unroll
        for (int j = 0; j < 4; ++j) { const f32x4 o = v[j] * rs * g4[64 * j] * (sc4[64 * j] + 1.f) + sh4[64 * j];
            o8[64 * j] = (unsigned long long)pk2(o.x, o.y) | ((unsigned long long)pk2(o.z, o.w) << 32); }
    }
}
__device__ __forceinline__ void post_rows(const float* xin, const bf16* Y, const float* postg, const float* modc, const float* pregn, const float* modn, float* xout, bf16* H, int gw, int NGW, int lane) {
    for (int row = gw; row < M; row += NGW) {
        const int b = row / L; const GAS unsigned long long* y8 = (const GAS unsigned long long*)(Y + (size_t)row * D) + lane;
        f32x4 yv[4]; float s = 0.f;
#pragma unroll
        for (int j = 0; j < 4; ++j) { const unsigned long long w = y8[64 * j]; const unsigned lo = (unsigned)w, hi = (unsigned)(w >> 32);
            yv[j].x = __uint_as_float(lo << 16); yv[j].y = __uint_as_float(lo & 0xffff0000u); yv[j].z = __uint_as_float(hi << 16); yv[j].w = __uint_as_float(hi & 0xffff0000u);
            s += (yv[j].x * yv[j].x + yv[j].y * yv[j].y) + (yv[j].z * yv[j].z + yv[j].w * yv[j].w); }
        const float rs = rsqrtf(wave_sum(s) * (1.f / D) + EPS);
        const GAS f32x4* xr = (const GAS f32x4*)(xin + (size_t)row * D) + lane; GAS f32x4* xo = (GAS f32x4*)(xout + (size_t)row * D) + lane;
        const f32x4* pg4 = (const f32x4*)postg + lane; const f32x4* rg4 = (const f32x4*)(modc + (size_t)b * 3072 + 2048) + lane;
        f32x4 x1[4]; float s2 = 0.f;
#pragma unroll
        for (int j = 0; j < 4; ++j) { x1[j] = xr[64 * j] + rg4[64 * j] * (yv[j] * rs * pg4[64 * j]); xo[64 * j] = x1[j];
            s2 += (x1[j].x * x1[j].x + x1[j].y * x1[j].y) + (x1[j].z * x1[j].z + x1[j].w * x1[j].w); }
        if (H) { const float r2 = rsqrtf(wave_sum(s2) * (1.f / D) + EPS);
            const f32x4* g4 = (const f32x4*)pregn + lane; const f32x4* sh4 = (const f32x4*)(modn + (size_t)b * 3072) + lane; const f32x4* sc4 = sh4 + 256;
            GAS unsigned long long* o8 = (GAS unsigned long long*)(H + (size_t)row * D) + lane;
#pragma unroll
            for (int j = 0; j < 4; ++j) { const f32x4 o = x1[j] * r2 * g4[64 * j] * (sc4[64 * j] + 1.f) + sh4[64 * j];
                o8[64 * j] = (unsigned long long)pk2(o.x, o.y) | ((unsigned long long)pk2(o.z, o.w) << 32); } }
    }
}
__device__ __forceinline__ void norm_kv_rows(const bf16* proj0, const float* stats, const float* kvg, const float* kig, bf16* ckv, bf16* ki, float* wi, int gw, int NGW, int lane) {
    for (int row = gw; row < M; row += NGW) {
        const float* st = stats + (size_t)row * 16; const bf16* p = proj0 + (size_t)row * A_INP;
        const float rkv = rsqrtf(((st[4] + st[5]) + (st[6] + st[7])) * (1.f / 128.f) + EPS), rki = rsqrtf((st[8] + st[9]) * (1.f / 64.f) + EPS);
        const unsigned w = *(const unsigned*)(p + 256 + 2 * lane);
        const float a0 = __uint_as_float(w << 16) * rkv * kvg[2 * lane], a1 = __uint_as_float(w & 0xffff0000u) * rkv * kvg[2 * lane + 1];
        *(unsigned*)(ckv + (size_t)row * 128 + 2 * lane) = pk2(a0, a1);
        ki[(size_t)row * 64 + lane] = (bf16)f2bf(bf2f(p[384 + lane]) * rki * kig[lane]);
        if (lane < 8) wi[(size_t)row * 8 + lane] = bf2f(p[448 + lane]) * (0.35355339059327373f * 0.125f);
    }
}

__global__ void __launch_bounds__(NWAVES * 64, 2) mk_fwd(Args args) {
    extern __shared__ __attribute__((aligned(16))) unsigned char lds_raw[];
    LAS unsigned char* lds = (LAS unsigned char*)lds_raw;
    const int wave = __builtin_amdgcn_readfirstlane(threadIdx.x >> 6);
    const int G = gridDim.x; const int bx = blockIdx.x; const int vcu = (G % 8 == 0) ? (bx % 8) * (G / 8) + bx / 8 : bx;
    for (int u = wave * 64 + lane_now(0); u < (LDS_BYTES - LDSCTL_OFF) / 4; u += NWAVES * 64) ((LAS unsigned*)(lds + LDSCTL_OFF))[u] = 0u;
    __syncthreads();
    XcdBarrier bar = xcd_barrier_post((unsigned*)((gu32*)(args.ws + WS_CTL) + CW_BAR) + args.li * XCD_BAR_WORDS, (volatile LAS unsigned*)(lds + MISC_OFF) + 8, wave);
    const int lo = args.ph_lo, hi = args.ph_hi;
#define IN(k) (lo <= (k) && (k) < hi)
#ifndef REP_PHASE
#define REP_PHASE (-1)
#endif
#define PHASE_BEGIN(k) if (IN(k)) { for (int rep_ = 0; rep_ < ((k) == REP_PHASE ? 2 : 1); ++rep_) { if (rep_) xcd_barrier(bar);
#define PHASE_END(k) } } SEAM(k);
#define SEAM(k) do { if (IN(k) && IN((k) + 1)) xcd_barrier(bar); } while (0)
    const int gw = vcu * NWAVES + wave, NGW = G * NWAVES;

    PHASE_BEGIN(PH_PRO) const int lane = fresh_lane(); p0_mod(kargs(PH_PRO), lds, wave * 64 + lane, lane, wave, vcu, G); PHASE_END(PH_PRO)
    PHASE_BEGIN(PH_PRE0) CArgs* A = kargs(PH_PRE0); unsigned char* ws = A->ws; prenorm_rows(A->in[I_X], A->in[I_PREG], (const float*)(ws + WS_MOD), (bf16*)(ws + WS_H), gw, NGW, fresh_lane());
#ifndef REP_W
#define REP_W 1
#endif
        for (int rw_ = 0; rw_ < REP_W; ++rw_) p0_weights(A, lds, fresh_lane(1 + rw_), wave, vcu, G); PHASE_END(PH_PRE0)
    PHASE_BEGIN(PH_INPROJ0)
        CArgs* A = kargs(PH_INPROJ0); unsigned char* ws = A->ws;
        pg8::Gemm g{(const bf16*)(ws + WS_H), (const bf16*)(ws + WS_WIN0), M, A_INP, D, D, D, 0}; pg8::StaticOrder S; S.init(M, A_INP, G, bx);
        pg8::Epi<pg8::EM_PROJ0> E{(bf16*)(ws + WS_PROJ0), A_INP, (float*)(ws + WS_STATS), nullptr, 0};
        pg8::gemm_phase<pg8::Epi<pg8::EM_PROJ0>, pg8::StaticOrder, true, true>(lds + RING_OFF, g, S, E, wave);
    PHASE_END(PH_INPROJ0)
    PHASE_BEGIN(PH_QGEMM)
        CArgs* A = kargs(PH_QGEMM); unsigned char* ws = A->ws;
        pg8::Gemm g{(const bf16*)(ws + WS_PROJ0), (const bf16*)(ws + WS_WQ2), M, NQQ, QR, A_INP, QR, 0}; pg8::StaticOrder S; S.init(M, NQQ, G, bx);
        pg8::Epi<pg8::EM_ROWSCALE> E{(bf16*)(ws + WS_QQ), NQQ, (float*)(ws + WS_STATS), nullptr, 0};
        pg8::gemm_phase<pg8::Epi<pg8::EM_ROWSCALE>, pg8::StaticOrder, true, true>(lds + RING_OFF, g, S, E, wave);
        norm_kv_rows((const bf16*)(ws + WS_PROJ0), (const float*)(ws + WS_STATS), A->in[I_AKVN], A->in[I_AKIN], (bf16*)(ws + WS_CKV), (bf16*)(ws + WS_KI), (float*)(ws + WS_WI), gw, NGW, fresh_lane());
    PHASE_END(PH_QGEMM)
    PHASE_BEGIN(PH_TOPK)
        CArgs* A = kargs(PH_TOPK); unsigned char* ws = A->ws;
        unsigned* sel = (unsigned*)(ws + WS_SEL); const int lane = fresh_lane();
        const bf16* qq = (const bf16*)(ws + WS_QQ); const bf16* ki = (const bf16*)(ws + WS_KI); const float* wi = (const float*)(ws + WS_WI);
        for (int p = vcu; p < NB * 64; p += G) {
            const int b = p >> 6, u = p & 63;
            for (int r2 = 0; r2 < 2; ++r2) topk::unit(qq, ki, wi, sel, b, 16 * (r2 ? 127 - u : u), (LAS unsigned*)(lds + RING_OFF), wave, lane);
        }
    PHASE_END(PH_TOPK)
    PHASE_BEGIN(PH_SPARSE)
        CArgs* A = kargs(PH_SPARSE); unsigned char* ws = A->ws; const Misc* ms = (const Misc*)(ws + WS_MISC);
        const int lane = fresh_lane(); float* btl = (float*)((char*)lds_raw + sparse::BT_OFF);
        for (int i = wave * 64 + lane; i < 128 * 16; i += NWAVES * 64) btl[i] = ms->btab[i] * LOG2E;
        __syncthreads();
        const int per = (M + NGW - 1) / NGW;
        const int q0 = gw * per, nq = q0 >= M ? 0 : (q0 + per <= M ? per : M - q0);
        if (nq > 0) sparse::stream((const bf16*)(ws + WS_QQ), (const bf16*)(ws + WS_CKV), (const unsigned*)(ws + WS_SEL), (bf16*)(ws + WS_OLAT), q0, nq, (char*)lds_raw + wave * sparse::WAVE_LDS, btl, lane);
        __syncthreads();
    PHASE_END(PH_SPARSE)
    PHASE_BEGIN(PH_UV)
        CArgs* A = kargs(PH_UV); unsigned char* ws = A->ws;
        pg8::Gemm g{(const bf16*)(ws + WS_OLAT), (const bf16*)(ws + WS_WUV), M, D, 512, 2048, 512, 512}; pg8::StaticOrder S; S.init(M, D, G, bx);
        pg8::Epi<pg8::EM_UVGATE> E{(bf16*)(ws + WS_OG0), D, nullptr, (const bf16*)(ws + WS_PROJ0) + 456, A_INP};
        pg8::gemm_phase<pg8::Epi<pg8::EM_UVGATE>, pg8::StaticOrder, true, true>(lds + RING_OFF, g, S, E, wave);
    PHASE_END(PH_UV)
    PHASE_BEGIN(PH_OUT0)
        CArgs* A = kargs(PH_OUT0); unsigned char* ws = A->ws;
        pg8::Gemm g{(const bf16*)(ws + WS_OG0), (const bf16*)(ws + WS_WOUT0), M, D, D, D, D, 0}; pg8::StaticOrder S; S.init(M, D, G, bx);
        pg8::Epi<pg8::EM_PLAIN> E{(bf16*)(ws + WS_Y0), D, nullptr, nullptr, 0};
        pg8::gemm_phase<pg8::Epi<pg8::EM_PLAIN>, pg8::StaticOrder, true, true>(lds + RING_OFF, g, S, E, wave);
    PHASE_END(PH_OUT0)
    PHASE_BEGIN(PH_POST0) CArgs* A = kargs(PH_POST0); unsigned char* ws = A->ws; const float* mod = (const float*)(ws + WS_MOD);
        post_rows(A->in[I_X], (const bf16*)(ws + WS_Y0), A->in[I_POSTG], mod, A->in[I_PREG] + D, mod + (size_t)NB * 3072, A->out, (bf16*)(ws + WS_H), gw, NGW, fresh_lane()); PHASE_END(PH_POST0)
    PHASE_BEGIN(PH_INPROJ1)
        CArgs* A = kargs(PH_INPROJ1); unsigned char* ws = A->ws;
        pg8::Gemm g{(const bf16*)(ws + WS_H), (const bf16*)(ws + WS_WIN1), M, B_IN, D, D, D, 0}; pg8::StaticOrder S; S.init(M, B_IN, G, bx);
        pg8::Epi<pg8::EM_PROJ1> E{(bf16*)(ws + WS_PROJ1), B_IN, nullptr, nullptr, 0};
        pg8::gemm_phase<pg8::Epi<pg8::EM_PROJ1>, pg8::StaticOrder, true, true>(lds + RING_OFF, g, S, E, wave);
    PHASE_END(PH_INPROJ1)
    PHASE_BEGIN(PH_ATTN1)
        CArgs* A = kargs(PH_ATTN1); unsigned char* ws = A->ws; const Misc* ms = (const Misc*)(ws + WS_MISC);
        const bf16* proj1 = (const bf16*)(ws + WS_PROJ1); bf16* og1 = (bf16*)(ws + WS_OG1); const float* subln = A->in[I_BSUBLN];
        attn_body::bf16* oscr = (attn_body::bf16*)(ws + WS_OSCR);
        const attn_body::bf16* pj = (const attn_body::bf16*)proj1;
        char* shm = (char*)lds_raw + RING_OFF;
        for (int p = vcu; p < 256; p += G) {
            const int bh = p >> 2, s4 = p & 3, b = bh >> 3, h = bh & 7;
            for (int ui = 0; ui < 2; ++ui) {
                const int qb = ui == 0 ? s4 : 7 - s4;
                attn_body::bf16* ob = oscr + ((size_t)bh * L + qb * 256) * attn_body::OPITCH;
                for (int vi = 0; vi < 2; ++vi) {
                    const int mp = 2 * h + vi;
                    attn2::attn_unit<8>(wave, b, qb, (const attn2::bf16*)pj + mp * 64, (const attn2::bf16*)pj + 1024 + mp * 64, (const attn2::bf16*)pj + 2048 + h * 128, (attn2::bf16*)ob + vi * 128, ms->btab + mp, shm);
                }
                asm volatile("s_waitcnt vmcnt(0)" ::: "memory");
                const int lane2 = fresh_lane(qb);
                const int r = wave * 32 + (lane2 & 31), eh = lane2 >> 5, t = qb * 256 + r; const size_t grow = (size_t)b * L + t;
                const v4u* o1p = (const v4u*)((const bf16*)ob + (size_t)r * 256 + eh * 64); const v4u* o2p = o1p + 16;
                const float lam = ms->lam; float o[64]; float ss = 0.f;
#pragma unroll
                for (int c8 = 0; c8 < 8; ++c8) { const v4u a1 = __builtin_nontemporal_load(o1p + c8), a2 = __builtin_nontemporal_load(o2p + c8);
#pragma unroll
                    for (int q = 0; q < 4; ++q) { const float x0 = __uint_as_float(a1[q] << 16) - lam * __uint_as_float(a2[q] << 16), x1 = __uint_as_float(a1[q] & 0xffff0000u) - lam * __uint_as_float(a2[q] & 0xffff0000u);
                        o[c8 * 8 + 2 * q] = x0; o[c8 * 8 + 2 * q + 1] = x1; ss += x0 * x0 + x1 * x1; } }
                ss = xsum32(ss);
                const float rs = rsqrtf(ss * (1.f / 128.f) + EPS) * (1.f - LAMBDA_INIT);
                const v4u* gp = (const v4u*)(proj1 + grow * B_IN + 3072 + h * 128 + eh * 64); const f32x4* sl = (const f32x4*)(subln + eh * 64);
                v4u* op = (v4u*)(og1 + grow * D + h * 128 + eh * 64);
#pragma unroll
                for (int c8 = 0; c8 < 8; ++c8) { const v4u gq = gp[c8]; const f32x4 s0 = sl[2 * c8], s1 = sl[2 * c8 + 1]; v4u w;
#pragma unroll
                    for (int q = 0; q < 4; ++q) { const float g0 = __uint_as_float(gq[q] << 16), g1 = __uint_as_float(gq[q] & 0xffff0000u);
                        const float sa = q < 2 ? s0[2 * q] : s1[2 * q - 4], sb = q < 2 ? s0[2 * q + 1] : s1[2 * q - 3];
                        w[q] = pk2(o[c8 * 8 + 2 * q] * rs * sa * siluf(g0), o[c8 * 8 + 2 * q + 1] * rs * sb * siluf(g1)); }
                    op[c8] = w; }
            }
        }
    PHASE_END(PH_ATTN1)
    PHASE_BEGIN(PH_OUT1)
        CArgs* A = kargs(PH_OUT1); unsigned char* ws = A->ws;
        pg8::Gemm g{(const bf16*)(ws + WS_OG1), (const bf16*)(ws + WS_WOUT1), M, D, D, D, D, 0}; pg8::StaticOrder S; S.init(M, D, G, bx);
        pg8::Epi<pg8::EM_PLAIN> E{(bf16*)(ws + WS_Y1), D, nullptr, nullptr, 0};
        pg8::gemm_phase<pg8::Epi<pg8::EM_PLAIN>, pg8::StaticOrder, true, true>(lds + RING_OFF, g, S, E, wave);
    PHASE_END(PH_OUT1)
    PHASE_BEGIN(PH_FINAL) CArgs* A = kargs(PH_FINAL); unsigned char* ws = A->ws;
        post_rows(A->out, (const bf16*)(ws + WS_Y1), A->in[I_POSTG] + D, (const float*)(ws + WS_MOD) + (size_t)NB * 3072, nullptr, nullptr, A->out, nullptr, gw, NGW, fresh_lane()); } }
#undef IN
#undef SEAM
}

__device__ __forceinline__ float block_sum(float v, float* red) {
    for (int o = 32; o > 0; o >>= 1) v += __shfl_xor(v, o);
    __syncthreads(); if ((threadIdx.x & 63) == 0) red[threadIdx.x >> 6] = v; __syncthreads();
    return red[0] + red[1] + red[2] + red[3];
}
__device__ __forceinline__ unsigned fkey(float f) { unsigned u = __float_as_uint(f); return (u & 0x80000000u) ? ~u : (u | 0x80000000u); }
__global__ void __launch_bounds__(256) k_topk(const bf16_t* qq, const bf16_t* ki, const float* wi, unsigned* sel) {
    __shared__ float qs[512]; __shared__ unsigned keys[2048]; __shared__ unsigned cnts[256]; __shared__ unsigned words[64]; __shared__ float ws[8];
    int row = blockIdx.x, b = row / L, t = row % L, tid = threadIdx.x;
    for (int i = tid; i < 512; i += 256) qs[i] = bf2f(qq[(size_t)row * NQQ + i]);
    if (tid < 8) ws[tid] = wi[(size_t)row * 8 + tid];
    if (tid < 64) words[tid] = 0u;
    __syncthreads();
    for (int s = tid; s < L; s += 256) {
        unsigned kk = 0u;
        if (s <= t) { const bf16_t* kr = ki + ((size_t)b * L + s) * 64; float a0 = 0.f, a1 = 0.f, a2 = 0.f, a3 = 0.f, a4 = 0.f, a5 = 0.f, a6 = 0.f, a7 = 0.f;
            for (int d = 0; d < 64; ++d) { float kf = bf2f(kr[d]); a0 += qs[d] * kf; a1 += qs[64 + d] * kf; a2 += qs[128 + d] * kf; a3 += qs[192 + d] * kf;
                a4 += qs[256 + d] * kf; a5 += qs[320 + d] * kf; a6 += qs[384 + d] * kf; a7 += qs[448 + d] * kf; }
            float sc = ws[0] * fmaxf(a0, 0.f); sc += ws[1] * fmaxf(a1, 0.f); sc += ws[2] * fmaxf(a2, 0.f); sc += ws[3] * fmaxf(a3, 0.f);
            sc += ws[4] * fmaxf(a4, 0.f); sc += ws[5] * fmaxf(a5, 0.f); sc += ws[6] * fmaxf(a6, 0.f); sc += ws[7] * fmaxf(a7, 0.f);
            kk = fkey(sc); }
        keys[s] = kk;
    }
    __syncthreads();
    int nvalid = t + 1;
    if (nvalid <= TOPK) { for (int s = tid; s <= t; s += 256) atomicOr(&words[s >> 5], 1u << (s & 31)); }
    else {
        unsigned prefix = 0u;
        for (int bit = 31; bit >= 0; --bit) {
            unsigned cand = prefix | (1u << bit); unsigned c = 0;
            for (int i = 0; i < 8; ++i) c += keys[tid * 8 + i] >= cand;
            cnts[tid] = c; __syncthreads();
            for (int o = 128; o > 0; o >>= 1) { if (tid < o) cnts[tid] += cnts[tid + o]; __syncthreads(); }
            unsigned tot = cnts[0]; __syncthreads();
            if (tot >= (unsigned)TOPK) prefix = cand;
        }
        unsigned cg = 0, ce = 0; for (int i = 0; i < 8; ++i) { unsigned k = keys[tid * 8 + i]; cg += k > prefix; ce += k == prefix; }
        cnts[tid] = cg; __syncthreads();
        for (int o = 128; o > 0; o >>= 1) { if (tid < o) cnts[tid] += cnts[tid + o]; __syncthreads(); }
        unsigned ngt = cnts[0]; __syncthreads();
        cnts[tid] = ce; __syncthreads();
        if (tid == 0) { unsigned run = 0; for (int i = 0; i < 256; ++i) { unsigned v = cnts[i]; cnts[i] = run; run += v; } }
        __syncthreads();
        unsigned need = TOPK - ngt, rank = cnts[tid];
        for (int i = 0; i < 8; ++i) { int s = tid * 8 + i; unsigned k = keys[s]; bool take = k > prefix; if (k == prefix) { take = rank < need; ++rank; }
            if (take) atomicOr(&words[s >> 5], 1u << (s & 31)); }
    }
    __syncthreads();
    if (tid < 64) sel[(size_t)row * 64 + tid] = words[tid];
}
__global__ void __launch_bounds__(256) k_sparse(const bf16_t* qq, const bf16_t* ckv, const unsigned* sel, const Misc* ms, bf16_t* olat) {
    __shared__ float qa[16 * 128]; __shared__ int idx[256]; __shared__ float lg[16 * 256]; __shared__ int nsel_s;
    int row = blockIdx.x, b = row / L, t = row % L, tid = threadIdx.x;
    for (int i = tid; i < 2048; i += 256) qa[i] = bf2f(qq[(size_t)row * NQQ + 512 + i]);
    if (tid == 0) { int n = 0; for (int w = 0; w < 64; ++w) { unsigned v = sel[(size_t)row * 64 + w]; while (v) { int bpos = __ffs(v) - 1; v &= v - 1; if (n < 256) idx[n] = w * 32 + bpos; ++n; } } nsel_s = n < 256 ? n : 256; }
    __syncthreads();
    int ns = nsel_s;
    for (int p = tid; p < 16 * 256; p += 256) { int h = p >> 8, k = p & 255; float v = -INFINITY;
        if (k < ns) { const bf16_t* kr = ckv + ((size_t)b * L + idx[k]) * 128; float a = 0.f; for (int r = 0; r < 128; ++r) a += qa[h * 128 + r] * bf2f(kr[r]);
            int dd = t - idx[k]; if (dd > 127) dd = 127; v = a + ms->btab[dd * 16 + h] * LOG2E; }
        lg[p] = v; }
    __syncthreads();
    if (tid < 16) { float mx = -INFINITY; for (int k = 0; k < ns; ++k) mx = fmaxf(mx, lg[tid * 256 + k]); float s = 0.f;
        for (int k = 0; k < ns; ++k) { float e = exp2f(lg[tid * 256 + k] - mx); lg[tid * 256 + k] = e; s += e; } float inv = 1.f / s; for (int k = 0; k < ns; ++k) lg[tid * 256 + k] *= inv; }
    __syncthreads();
    for (int o = tid; o < 2048; o += 256) { int h = o >> 7, r = o & 127; float a = 0.f;
        for (int k = 0; k < ns; ++k) a += lg[h * 256 + k] * bf2f(ckv[((size_t)b * L + idx[k]) * 128 + r]);
        olat[(size_t)row * 2048 + o] = f2bf(a); }
}
__global__ void __launch_bounds__(256) k_diffattn(const bf16_t* proj, const Misc* ms, const float* subln, bf16_t* og) {
    __shared__ float q[2][64]; __shared__ float p[2][2048]; __shared__ float red[4]; __shared__ float part[2][128];
    int row = blockIdx.x, h = blockIdx.y, b = row / L, t = row % L, tid = threadIdx.x;
    if (tid < 128) q[tid >> 6][tid & 63] = bf2f(proj[(size_t)row * B_IN + (2 * h + (tid >> 6)) * 64 + (tid & 63)]);
    __syncthreads();
    float mx[2] = {-INFINITY, -INFINITY};
    for (int l = tid; l <= t; l += 256) { int dd = t - l; if (dd > 127) dd = 127;
        for (int j = 0; j < 2; ++j) { const bf16_t* kr = proj + ((size_t)b * L + l) * B_IN + 1024 + (2 * h + j) * 64; float a = 0.f;
            for (int d = 0; d < 64; ++d) a += q[j][d] * bf2f(kr[d]);
            a += ms->btab[dd * 16 + 2 * h + j] * LOG2E; p[j][l] = a; mx[j] = fmaxf(mx[j], a); } }
    float sm[2];
    for (int j = 0; j < 2; ++j) { float m = mx[j]; for (int o = 32; o > 0; o >>= 1) m = fmaxf(m, __shfl_xor(m, o));
        __syncthreads(); if ((tid & 63) == 0) red[tid >> 6] = m; __syncthreads(); m = fmaxf(fmaxf(red[0], red[1]), fmaxf(red[2], red[3]));
        float s = 0.f; for (int l = tid; l <= t; l += 256) { float e = exp2f(p[j][l] - m); p[j][l] = e; s += e; }
        sm[j] = block_sum(s, red); }
    __syncthreads();
    float lam = ms->lam, i0 = 1.f / sm[0], i1 = lam / sm[1];
    int e = tid & 127, half = tid >> 7; float a = 0.f;
    for (int l = half; l <= t; l += 2) a += (p[0][l] * i0 - p[1][l] * i1) * bf2f(proj[((size_t)b * L + l) * B_IN + 2048 + h * 128 + e]);
    part[half][e] = a; __syncthreads();
    float o = part[0][e] + part[1][e];
    float ss = block_sum(half == 0 ? o * o : 0.f, red);
    if (half == 0) { float v = o * rsqrtf(ss / 128.f + EPS) * subln[e] * (1.f - LAMBDA_INIT);
        float gte = bf2f(proj[(size_t)row * B_IN + 3072 + h * 128 + e]);
        og[(size_t)row * D + h * 128 + e] = f2bf(v * siluf(gte)); }
}


extern "C" void kernel_launch(void* const* d_in, const int* in_sizes, int n_in, void* d_out, int out_size, void* d_ws, size_t ws_size, hipStream_t stream) {
    (void)in_sizes; (void)out_size; (void)ws_size;
    static int grid = 0;
    if (grid == 0) {
        int dev = 0, cus = 0;
        if (n_in != N_IN || hipGetDevice(&dev) != hipSuccess || hipDeviceGetAttribute(&cus, hipDeviceAttributeMultiprocessorCount, dev) != hipSuccess) { grid = -1; return; }
        if (hipFuncSetAttribute((const void*)mk_fwd, hipFuncAttributeMaxDynamicSharedMemorySize, LDS_BYTES) != hipSuccess) { grid = -1; return; }
        grid = cus;
    }
    if (grid < 0) return;
    char* ws = (char*)d_ws;
    hipMemsetAsync(ws + WS_CTL, 0, CTL_ZERO_BYTES, stream);
    Args a{};
    for (int i = 0; i < N_IN; ++i) a.in[i] = (const float*)d_in[i];
    a.out = (float*)d_out; a.ws = (unsigned char*)d_ws;
    int li = 0;
    auto run = [&](int lo, int hi) { a.ph_lo = lo; a.ph_hi = hi; a.li = li++; hipLaunchKernelGGL(mk_fwd, dim3(grid), dim3(NWAVES * 64), LDS_BYTES, stream, a); };
    Misc* ms = (Misc*)(ws + WS_MISC);
    bf16_t *ckv = (bf16_t*)(ws + WS_CKV), *ki = (bf16_t*)(ws + WS_KI); float* wi = (float*)(ws + WS_WI); unsigned* sel = (unsigned*)(ws + WS_SEL);
    bf16_t *qq = (bf16_t*)(ws + WS_QQ), *olat = (bf16_t*)(ws + WS_OLAT), *proj1 = (bf16_t*)(ws + WS_PROJ1), *og1 = (bf16_t*)(ws + WS_OG1);
#ifdef PROBE_PHASE
    run(PH_PRO, PROBE_PHASE + 1); run(PROBE_PHASE, PROBE_PHASE + 1); if (PROBE_PHASE + 1 < N_PHASES) run(PROBE_PHASE + 1, PH_FINAL + 1);
#else
    run(PH_PRO, PH_FINAL + 1);
#endif
}
```

```cpp
#include <hip/hip_runtime.h>
#include <stdint.h>
#include <math.h>
#include <cstdio>
#include <hip/hip_bf16.h>

constexpr int NB = 8, L = 2048, D = 1024, M = NB * L;
constexpr int A_IN = 1480, A_INP = 1536, QR = 256, TOPK = 256;
constexpr int NQQ = 512 + 2048;
constexpr int B_IN = 4096, BH = 8;
constexpr float EPS = 1e-6f;
constexpr float LOG2E = 1.4426950408889634f;
constexpr float C2 = 0.125f * LOG2E;
constexpr float LAMBDA_INIT = 0.35550906759096934f;

constexpr size_t MiB = 1u << 20;
constexpr size_t WS_CTL = 0, CTL_ZERO_BYTES = 256 * 1024;
constexpr size_t WS_MOD = 512 * 1024;
constexpr size_t WS_MISC = 768 * 1024;
constexpr size_t WS_WIN0 = 1 * MiB;
constexpr size_t WS_WQ2 = 4 * MiB;
constexpr size_t WS_WUV = 6 * MiB;
constexpr size_t WS_WOUT0 = 7 * MiB;
constexpr size_t WS_WIN1 = 9 * MiB;
constexpr size_t WS_WOUT1 = 17 * MiB;
constexpr size_t WS_STATS = 19 * MiB;
constexpr size_t WS_CKV = 20 * MiB;
constexpr size_t WS_KI = 24 * MiB;
constexpr size_t WS_WI = 26 * MiB;
constexpr size_t WS_SEL = 28 * MiB;
constexpr size_t WS_H = 32 * MiB;
constexpr size_t WS_PROJ0 = 64 * MiB;
constexpr size_t WS_QQ = 112 * MiB;
constexpr size_t WS_OLAT = 192 * MiB;
constexpr size_t WS_OG0 = 112 * MiB;
constexpr size_t WS_Y0 = 144 * MiB;
constexpr size_t WS_PROJ1 = 64 * MiB;
constexpr size_t WS_OSCR = 192 * MiB;
constexpr size_t WS_X1B = 224 * MiB;
constexpr size_t WS_OG1 = 32 * MiB;
constexpr size_t WS_Y1 = 64 * MiB;
constexpr int CW_BAR = 4096;

struct Misc { float lam; int pad[31]; int lut[128]; float btab[128 * 16]; };

enum { I_X = 0, I_C, I_RELB, I_MODW, I_MODB, I_PREG, I_POSTG, I_AWIN, I_AQN, I_AKVN, I_AKIN, I_AWUQ, I_AWQIDX, I_AWUK, I_AWUV, I_AWOUT,
       I_BWIN, I_BLQ1, I_BLK1, I_BLQ2, I_BLK2, I_BSUBLN, I_BWOUT, N_IN };

__device__ __forceinline__ float siluf(float v) { return v * __builtin_amdgcn_rcpf(1.f + __builtin_amdgcn_exp2f(-1.4426950408889634f * v)); }
__device__ __forceinline__ float bf2f(unsigned short v) { return __uint_as_float((unsigned)v << 16); }
__device__ __forceinline__ float xsum32(float v) { auto r = __builtin_amdgcn_permlane32_swap(__float_as_uint(v), __float_as_uint(v), false, false); return __uint_as_float(r[0]) + __uint_as_float(r[1]); }
__device__ __forceinline__ float xsum16(float v) { auto r = __builtin_amdgcn_permlane16_swap(__float_as_uint(v), __float_as_uint(v), false, false); return __uint_as_float(r[0]) + __uint_as_float(r[1]); }
template <int CTRL> __device__ __forceinline__ float dpp_f(float v) { return __uint_as_float((unsigned)__builtin_amdgcn_update_dpp(0, (int)__float_as_uint(v), CTRL, 0xF, 0xF, true)); }
__device__ __forceinline__ float wave_sum_all(float v) {
    v += dpp_f<0xB1>(v);
    v += dpp_f<0x4E>(v);
    v += dpp_f<0x141>(v);
    v += dpp_f<0x140>(v);
    v = xsum16(v); return xsum32(v);
}
typedef unsigned short bf16_t;
#define GAS __attribute__((address_space(1)))
#define LAS __attribute__((address_space(3)))
typedef unsigned short bf16;
typedef unsigned v4u __attribute__((ext_vector_type(4)));
typedef float f32x4 __attribute__((ext_vector_type(4)));
typedef short bf16x8 __attribute__((ext_vector_type(8)));
typedef GAS unsigned gu32;
typedef GAS unsigned long long gu64;
#define RLX_AGENT __ATOMIC_RELAXED, __HIP_MEMORY_SCOPE_AGENT
#define LDS_WAIT() asm volatile("s_waitcnt lgkmcnt(0)" ::: "memory")
#define VM_WAIT() asm volatile("s_waitcnt vmcnt(0)" ::: "memory")
__device__ __forceinline__ unsigned long long rt() { return __builtin_amdgcn_s_memrealtime(); }
__device__ __forceinline__ unsigned f2bf(float f) { unsigned u = __builtin_bit_cast(unsigned, f); return (u + 0x7fffu + ((u >> 16) & 1u)) >> 16; }
__device__ __forceinline__ unsigned pk2(float lo, float hi) { return f2bf(lo) | (f2bf(hi) << 16); }

#define XB_TMO      128
#define XB_XCNT(j)  (256  + 64 * (j))
#define XB_XSUB(j)  (1280 + 64 * (j))
#define XB_XGEN(j)  (2304 + 64 * (j))
#define XB_TOP      3328
#define XB_TOPGEN   3392
#define XCD_BAR_WORDS 3456
#define XB_SPIN_CAP (1u << 18)

__device__ __forceinline__ unsigned xb_ld(unsigned* p)              { return __hip_atomic_load(p, __ATOMIC_RELAXED, __HIP_MEMORY_SCOPE_AGENT); }
__device__ __forceinline__ unsigned xb_add(unsigned* p, unsigned v) { return __hip_atomic_fetch_add(p, v, __ATOMIC_RELAXED, __HIP_MEMORY_SCOPE_AGENT); }
__device__ __forceinline__ unsigned xb_xcc_id() { return (unsigned)__builtin_amdgcn_s_getreg((3 << 11) | 20) & 0xFu; }
#define XB_SPIN(cond, bar) do { unsigned _sp = 0; while (cond) { __builtin_amdgcn_s_sleep(1); \
    if ((++_sp & 255u) == 0u) { if (xb_ld(&(bar)[XB_TMO])) break; if (_sp > XB_SPIN_CAP) { atomicAdd(&(bar)[XB_TMO], 1u); break; } } } } while (0)

__device__ __forceinline__ int lane_now(int dep) { int l; asm volatile("v_mbcnt_lo_u32_b32 %0, -1, 0\n\tv_mbcnt_hi_u32_b32 %0, -1, %0 ; dep %1" : "=v"(l) : "s"(dep)); return l; }
struct XcdBarrier {
    unsigned* bar; unsigned x; int wave;
    volatile LAS unsigned* st;
};

__device__ __forceinline__ XcdBarrier xcd_barrier_post(unsigned* bar, volatile LAS unsigned* st, int wave) {
    XcdBarrier b; b.bar = bar; b.x = xb_xcc_id(); b.st = st; b.wave = wave;
    if (wave == 0 && lane_now(0) == 0) (void)xb_add(&bar[XB_XCNT(b.x)], 1u);
    return b;
}
__device__ __forceinline__ void xcd_barrier_complete(unsigned* bar, unsigned x, unsigned& nloc, unsigned& nx) {
    const unsigned G = gridDim.x * gridDim.y * gridDim.z;
    unsigned sum, cnt, mine, sp = 0u;
    for (;;) {
        sum = 0u; cnt = 0u; mine = 0u;
#pragma unroll
        for (unsigned j = 0; j < 16; ++j) { const unsigned c = xb_ld(&bar[XB_XCNT(j)]); sum += c; cnt += (c > 0u) ? 1u : 0u; mine = (j == x) ? c : mine; }
        if (sum == G) break;
        __builtin_amdgcn_s_sleep(1);
        if ((++sp & 255u) == 0u) { if (xb_ld(&bar[XB_TMO])) break; if (sp > XB_SPIN_CAP) { atomicAdd(&bar[XB_TMO], 1u); break; } }
    }
    nloc = mine > 0u ? mine : 1u; nx = cnt > 0u ? cnt : 1u;
}

__device__ __forceinline__ void xcd_barrier(const XcdBarrier& b) {
    asm volatile("s_waitcnt vmcnt(0)" ::: "memory");
    __syncthreads();
    if (b.wave == 0 && lane_now(1) == 0) {
        unsigned* bar = b.bar;
        __builtin_amdgcn_s_waitcnt(0);
        unsigned nloc = b.st[0], nx = b.st[1];
        if (nloc == 0u) { xcd_barrier_complete(bar, b.x, nloc, nx); b.st[0] = nloc; b.st[1] = nx; }
        const unsigned old = xb_add(&bar[XB_XSUB(b.x)], 1u);
        const unsigned gen = old / nloc;
        if (old + 1u == (gen + 1u) * nloc) {
            __builtin_amdgcn_fence(__ATOMIC_RELEASE, "agent");
            asm volatile("s_waitcnt vmcnt(0)" ::: "memory");
            const unsigned og = xb_add(&bar[XB_TOP], 1u);
            const unsigned tg = og / nx;
            if (og + 1u == (tg + 1u) * nx) xb_add(&bar[XB_TOPGEN], 1u);
            else XB_SPIN(xb_ld(&bar[XB_TOPGEN]) == tg, bar);
            __builtin_amdgcn_fence(__ATOMIC_ACQUIRE, "agent");
            xb_add(&bar[XB_XGEN(b.x)], 1u);
            asm volatile("s_waitcnt vmcnt(0)" ::: "memory");
        } else {
            XB_SPIN(xb_ld(&bar[XB_XGEN(b.x)]) == gen, bar);
            __builtin_amdgcn_fence(__ATOMIC_ACQUIRE, "agent");
            asm volatile("s_waitcnt vmcnt(0)" ::: "memory");
        }
    }
    __syncthreads();
}
namespace pg8 {
#define PG8_LAS __attribute__((address_space(3)))
typedef unsigned short bf16_t;
typedef short bf16x8 __attribute__((ext_vector_type(8)));
typedef float f32x4 __attribute__((ext_vector_type(4)));
typedef unsigned u32x4 __attribute__((ext_vector_type(4)));
constexpr int BM = 256, BK = 64, HALF = 128, HTB = HALF * BK * 2  , STAGE_BYTES = 8 * HTB, NXCD = 8, WGM = 8;

__host__ __device__ __forceinline__ int lds_byte(int r, int c) { const int st = (r >> 4) * 2 + (c >> 5), rr = r & 15, cc = c & 31, ob = rr * 64 + cc * 2; return st * 1024 + (ob ^ (((ob >> 9) & 1) << 5)); }
__host__ __device__ __forceinline__ void stage_rc(int b, int& R, int& C) { const int st = b / 1024, sb = b % 1024, swz = sb ^ (((sb >> 9) & 1) << 5); R = (st >> 1) * 16 + swz / 64; C = (st & 1) * 32 + (swz % 64) / 2; }
__host__ __device__ __forceinline__ int perm32(int rho) { const int n = rho >> 4, i = rho & 15; return 8 * (i >> 2) + 4 * n + (i & 3); }

struct Unit { int pm, pn; };
struct Gemm { const bf16_t* A; const bf16_t* Bt; int M, N, K, lda, ldb, a_koff_pn; };

struct StaticOrder {
    int nM, nN, nwg, G, c;
    __host__ __device__ void init(int M, int N, int G_, int c_) { nM = M / BM; nN = N / BM; nwg = nM * nN; G = G_; c = c_; }
    __host__ __device__ bool next(int i, Unit& u) const {
        const long L = (long)i * G + c; if (L >= nwg) return false;
        int wgid = (int)L; { const int q = nwg / NXCD, r = nwg % NXCD, xcd = wgid % NXCD, off = wgid / NXCD; wgid = (xcd < r ? xcd * (q + 1) : r * (q + 1) + (xcd - r) * q) + off; }
        const int nig = WGM * nN, gid = wgid / nig, fm = gid * WGM, gsz = (nM - fm) < WGM ? (nM - fm) : WGM;
        u.pm = fm + ((wgid % nig) % gsz); u.pn = (wgid % nig) / gsz; return true;
    }
    __device__ __forceinline__ void a_ready(const Unit&) const {}
    __device__ __forceinline__ void done(const Unit&) const {}
};
__device__ __forceinline__ unsigned cvt_pk_bf16(float lo, float hi) { unsigned r; asm volatile("v_cvt_pk_bf16_f32 %0, %1, %2" : "=v"(r) : "v"(lo), "v"(hi)); return r; }
typedef float f32x2 __attribute__((ext_vector_type(2)));
enum { EM_PLAIN = 0, EM_PROJ0 = 1, EM_ROWSCALE = 2, EM_UVGATE = 3, EM_PROJ1 = 4 };
template <int MODE> struct Epi {
    static constexpr bool PERM = true, AFTER_DRAIN = false;
    bf16_t* O; int ldc; float* stats; const bf16_t* gate; int ldg;
    __device__ __forceinline__ void operator()(const f32x4 (&acc)[2][2][4][2], const Unit& u, int wr, int wc, int fr, int fq) const {
        const int row0 = u.pm * BM + wr * 64 + fr, col0 = u.pn * BM + wc * 32 + 8 * fq;
        const __amdgpu_buffer_rsrc_t orsrc = __builtin_amdgcn_make_buffer_rsrc((void*)O, 0, 0x7ffffff0, 0x00020000);
#pragma unroll
        for (int ai = 0; ai < 2; ++ai)
#pragma unroll
            for (int m = 0; m < 4; ++m) {
                const int row = row0 + ai * HALF + m * 16;
                float rs = 1.f;
                if (MODE == EM_ROWSCALE) { const f32x4 s = *(const f32x4*)(stats + (size_t)row * 16); rs = rsqrtf(((s[0] + s[1]) + (s[2] + s[3])) * (1.f / 256.f) + 1e-6f); }
                if (MODE == EM_PROJ1) rs = (u.pn < 4) ? (0.125f * 1.4426950408889634f) : 1.f;
                float ss[2] = {0.f, 0.f};
#pragma unroll
                for (int bj = 0; bj < 2; ++bj) {
                    f32x4 v0 = acc[ai][bj][m][0] * rs, v1 = acc[ai][bj][m][1] * rs;
                    if (MODE == EM_PROJ0) ss[bj] = ((v0[0] * v0[0] + v0[1] * v0[1]) + (v0[2] * v0[2] + v0[3] * v0[3])) + ((v1[0] * v1[0] + v1[1] * v1[1]) + (v1[2] * v1[2] + v1[3] * v1[3]));
                    if (MODE == EM_UVGATE) { const u32x4 gw = *(const u32x4*)(gate + (size_t)row * ldg + col0 + bj * HALF);
#pragma unroll
                        for (int q = 0; q < 4; ++q) { const float g0 = __uint_as_float(gw[q] << 16), g1 = __uint_as_float(gw[q] & 0xffff0000u);
                            const float s0 = g0 * __builtin_amdgcn_rcpf(1.f + __builtin_amdgcn_exp2f(-1.4426950408889634f * g0)), s1 = g1 * __builtin_amdgcn_rcpf(1.f + __builtin_amdgcn_exp2f(-1.4426950408889634f * g1));
                            if (q < 2) { v0[2 * q] *= s0; v0[2 * q + 1] *= s1; } else { v1[2 * q - 4] *= s0; v1[2 * q - 3] *= s1; } } }
                    u32x4 w; w.x = cvt_pk_bf16(v0[0], v0[1]); w.y = cvt_pk_bf16(v0[2], v0[3]); w.z = cvt_pk_bf16(v1[0], v1[1]); w.w = cvt_pk_bf16(v1[2], v1[3]);
                    __builtin_amdgcn_raw_buffer_store_b128(w, orsrc, (int)(((size_t)row * ldc + col0 + bj * HALF) * 2), 0, 16); }
                if (MODE == EM_PROJ0) { if (u.pn < 2) {
                    float a = ss[0], b = ss[1];
                    a = xsum32(xsum16(a)); b = xsum32(xsum16(b));
                    if (fq == 0) { if (u.pn == 0) stats[(size_t)row * 16 + wc] = a + b; else { stats[(size_t)row * 16 + 4 + wc] = a; if (wc < 2) stats[(size_t)row * 16 + 8 + wc] = b; } } } }
            }
    }
};

template <class Epi, class Sched, bool ALIGN_EPI = false, bool SP2 = false>
__device__ __forceinline__ void gemm_phase(PG8_LAS unsigned char* lds, const Gemm g, const Sched& S, const Epi& E, const int wid) {
    const int lane = lane_now(g.N), tid = wid * 64 + lane, wr = wid >> 2, wc = wid & 3, fr = lane & 15, fq = lane >> 4;
    const int K = g.K, nt = K / BK;
    unsigned voffA[2], voffB[2];
#pragma unroll
    for (int i = 0; i < 2; ++i) { int R, C; stage_rc(tid * 16 + i * 8192, R, C); const int Rb = Epi::PERM ? ((R & ~31) + perm32(R & 31)) : R;
        voffA[i] = (unsigned)(R * g.lda + C) * 2u; voffB[i] = (unsigned)(Rb * g.ldb + C) * 2u; }
    const size_t kstep = (size_t)(BK * 2);
    const size_t hstepA = (size_t)HALF * g.lda * 2, hstepB = (size_t)HALF * g.ldb * 2;
    const size_t tstepA = 2 * hstepA, tstepB = 2 * hstepB, aoffpn = (size_t)g.a_koff_pn * 2;
    const unsigned ldsw = (unsigned)wid * 1024u;
    const int aoff = lds_byte(wr * 64 + fr, fq * 8), boff = lds_byte(wc * 32 + fr, fq * 8);
#define PG8_SA(b, h) (((b) * 2 + (h)) * HTB)
#define PG8_SB(b, h) ((4 + (b) * 2 + (h)) * HTB)
#define PG8_STAGE(bufoff, gbase, voff) do { _Pragma("unroll") for (int _i = 0; _i < 2; ++_i) \
        __builtin_amdgcn_global_load_lds((const unsigned*)((const char*)(gbase) + (voff)[_i]), (PG8_LAS unsigned*)(lds + (bufoff) + ldsw + _i * 8192), 16, 0, 0); } while (0)
#define PG8_LDA(dst, b, h) do { _Pragma("unroll") for (int m = 0; m < 4; ++m) _Pragma("unroll") for (int k = 0; k < 2; ++k) dst[m][k] = *(const PG8_LAS bf16x8*)(lds + PG8_SA(b, h) + aoff + m * 2048 + k * 1024); } while (0)
#define PG8_LDB(dst, b, h) do { _Pragma("unroll") for (int n = 0; n < 2; ++n) _Pragma("unroll") for (int k = 0; k < 2; ++k) dst[n][k] = *(const PG8_LAS bf16x8*)(lds + PG8_SB(b, h) + boff + n * 2048 + k * 1024); } while (0)
#define PG8_MMA(ai, bj, At, Bt) do { __builtin_amdgcn_s_setprio(1); _Pragma("unroll") for (int m = 0; m < 4; ++m) _Pragma("unroll") for (int n = 0; n < 2; ++n) _Pragma("unroll") for (int k = 0; k < 2; ++k) \
        acc[ai][bj][m][n] = __builtin_amdgcn_mfma_f32_16x16x32_bf16(Bt[n][k], At[m][k], acc[ai][bj][m][n], 0, 0, 0); __builtin_amdgcn_s_setprio(0); } while (0)
#define PG8_WAIT_V(n) asm volatile("s_waitcnt vmcnt(" #n ")" ::: "memory")
#define PG8_WAIT_L(n) asm volatile("s_waitcnt lgkmcnt(" #n ")" ::: "memory")
#define PG8_BAR __builtin_amdgcn_s_barrier()
#define PG8_SCHED __builtin_amdgcn_sched_barrier(0)
    Unit cur, nxt; int ui = 0;
    if (!S.next(0, cur)) return;
    f32x4 acc[2][2][4][2];
#pragma unroll
    for (int a = 0; a < 2; ++a)
#pragma unroll
        for (int b = 0; b < 2; ++b)
#pragma unroll
            for (int m = 0; m < 4; ++m)
#pragma unroll
                for (int n = 0; n < 2; ++n) acc[a][b][m][n] = (f32x4){0.f, 0.f, 0.f, 0.f};
    bf16x8 At[4][2], B0[2][2], B1[2][2];
    const char* cA = (const char*)g.A + (size_t)cur.pm * tstepA + (size_t)cur.pn * aoffpn; const char* cB = (const char*)g.Bt + (size_t)cur.pn * tstepB;
    S.a_ready(cur);
    if constexpr (SP2) {
        PG8_STAGE(PG8_SB(0, 0), cB, voffB); PG8_STAGE(PG8_SB(0, 1), cB + hstepB, voffB); PG8_STAGE(PG8_SA(0, 0), cA, voffA); PG8_STAGE(PG8_SA(0, 1), cA + hstepA, voffA);
        if (wr == 1) PG8_BAR;
        PG8_WAIT_V(2); PG8_BAR;
        PG8_STAGE(PG8_SB(1, 0), cB + kstep, voffB); PG8_STAGE(PG8_SA(1, 0), cA + kstep, voffA); PG8_STAGE(PG8_SB(1, 1), cB + hstepB + kstep, voffB);
        PG8_WAIT_V(6); PG8_BAR;
    } else {
        PG8_STAGE(PG8_SB(0, 0), cB, voffB); PG8_STAGE(PG8_SA(0, 0), cA, voffA); PG8_STAGE(PG8_SB(0, 1), cB + hstepB, voffB); PG8_STAGE(PG8_SA(0, 1), cA + hstepA, voffA);
        if (wr == 1) PG8_BAR;
        PG8_WAIT_V(4); PG8_BAR;
        PG8_STAGE(PG8_SB(1, 0), cB + kstep, voffB); PG8_STAGE(PG8_SA(1, 0), cA + kstep, voffA); PG8_STAGE(PG8_SB(1, 1), cB + hstepB + kstep, voffB);
        PG8_WAIT_V(6); PG8_BAR;
    }
    for (;;) {
        const bool has_next = S.next(ui + 1, nxt);
        const char* nA = has_next ? (const char*)g.A + (size_t)nxt.pm * tstepA + (size_t)nxt.pn * aoffpn : cA; const char* nB = has_next ? (const char*)g.Bt + (size_t)nxt.pn * tstepB : cB;
        for (int t = 0; t < nt; t += 2) {
            const bool last = (t == nt - 2);
            const char* a1 = cA + (size_t)(t + 1) * kstep;
            const char* a2 = last ? nA : cA + (size_t)(t + 2) * kstep; const char* b2 = last ? nB : cB + (size_t)(t + 2) * kstep;
            const char* a3 = a2 + kstep; const char* b3 = b2 + kstep;
            if (last && has_next) S.a_ready(nxt);
            if constexpr (SP2) {
            PG8_LDB(B0, 0, 0); PG8_LDB(B1, 0, 1); PG8_SCHED; PG8_LDA(At, 0, 0); PG8_STAGE(PG8_SA(1, 1), a1 + hstepA, voffA);
            PG8_WAIT_V(8); PG8_WAIT_L(0); PG8_BAR; PG8_MMA(0, 0, At, B0); PG8_MMA(0, 1, At, B1); PG8_BAR; PG8_SCHED;
            PG8_LDA(At, 0, 1); PG8_STAGE(PG8_SB(0, 0), b2, voffB); PG8_STAGE(PG8_SB(0, 1), b2 + hstepB, voffB); PG8_STAGE(PG8_SA(0, 0), a2, voffA);
            PG8_WAIT_V(8); PG8_WAIT_L(0); PG8_BAR; PG8_MMA(1, 0, At, B0); PG8_MMA(1, 1, At, B1); PG8_BAR; PG8_SCHED;
            PG8_LDB(B0, 1, 0); PG8_LDB(B1, 1, 1); PG8_SCHED; PG8_LDA(At, 1, 0); PG8_STAGE(PG8_SA(0, 1), a2 + hstepA, voffA);
            PG8_WAIT_V(8); PG8_WAIT_L(0); PG8_BAR; PG8_MMA(0, 0, At, B0); PG8_MMA(0, 1, At, B1); PG8_BAR; PG8_SCHED;
            PG8_LDA(At, 1, 1); PG8_STAGE(PG8_SB(1, 0), b3, voffB); PG8_STAGE(PG8_SB(1, 1), b3 + hstepB, voffB); PG8_STAGE(PG8_SA(1, 0), a3, voffA);
            PG8_WAIT_V(8); PG8_WAIT_L(0); PG8_BAR; PG8_MMA(1, 0, At, B0); PG8_MMA(1, 1, At, B1); PG8_BAR; PG8_SCHED;
            } else {
            PG8_LDB(B0, 0, 0); PG8_SCHED; PG8_LDA(At, 0, 0); PG8_STAGE(PG8_SA(1, 1), a1 + hstepA, voffA);
            PG8_WAIT_L(8); PG8_BAR; PG8_WAIT_L(0); PG8_MMA(0, 0, At, B0); PG8_BAR; PG8_SCHED;
            PG8_LDB(B1, 0, 1); PG8_STAGE(PG8_SB(0, 0), b2, voffB);
            PG8_BAR; PG8_WAIT_L(0); PG8_MMA(0, 1, At, B1); PG8_BAR;
            PG8_LDA(At, 0, 1); PG8_STAGE(PG8_SA(0, 0), a2, voffA);
            PG8_BAR; PG8_WAIT_L(0); PG8_MMA(1, 0, At, B0); PG8_BAR; PG8_SCHED;
            PG8_STAGE(PG8_SB(0, 1), b2 + hstepB, voffB);
            PG8_WAIT_V(6); PG8_BAR; PG8_MMA(1, 1, At, B1); PG8_BAR;
            PG8_LDB(B0, 1, 0); PG8_SCHED; PG8_LDA(At, 1, 0); PG8_STAGE(PG8_SA(0, 1), a2 + hstepA, voffA);
            PG8_WAIT_L(8); PG8_BAR; PG8_WAIT_L(0); PG8_MMA(0, 0, At, B0); PG8_BAR; PG8_SCHED;
            PG8_LDB(B1, 1, 1); PG8_STAGE(PG8_SB(1, 0), b3, voffB);
            PG8_BAR; PG8_WAIT_L(0); PG8_MMA(0, 1, At, B1); PG8_BAR;
            PG8_LDA(At, 1, 1); PG8_STAGE(PG8_SA(1, 0), a3, voffA);
            PG8_BAR; PG8_WAIT_L(0); PG8_MMA(1, 0, At, B0); PG8_BAR; PG8_SCHED;
            PG8_STAGE(PG8_SB(1, 1), b3 + hstepB, voffB);
            PG8_WAIT_V(6); PG8_BAR; PG8_MMA(1, 1, At, B1); PG8_BAR;
            }
        }
        if constexpr (ALIGN_EPI) { if (wr == 0) PG8_BAR; }
        if constexpr (!Epi::AFTER_DRAIN) { E(acc, cur, wr, wc, fr, fq); S.done(cur); }
        if (!has_next) break;
#pragma unroll
        for (int a = 0; a < 2; ++a)
#pragma unroll
            for (int b = 0; b < 2; ++b)
#pragma unroll
                for (int m = 0; m < 4; ++m)
#pragma unroll
                    for (int n = 0; n < 2; ++n) acc[a][b][m][n] = (f32x4){0.f, 0.f, 0.f, 0.f};
        cur = nxt; cA = nA; cB = nB; ++ui;
        if constexpr (ALIGN_EPI) { if (wr == 1) PG8_BAR; }
    }
    PG8_WAIT_V(0);
    if constexpr (!ALIGN_EPI) { if (wr == 0) PG8_BAR; }
    PG8_BAR;
    if constexpr (Epi::AFTER_DRAIN) { E.fused(acc, cur, wr, wc, fr, fq, lds, wid, lane); S.done(cur); }
#undef PG8_SA
#undef PG8_SB
#undef PG8_STAGE
#undef PG8_LDA
#undef PG8_LDB
#undef PG8_MMA
#undef PG8_WAIT_V
#undef PG8_WAIT_L
#undef PG8_BAR
#undef PG8_SCHED
}
}
namespace attn_body {
using bf16=__hip_bfloat16;
using bf16x8=__attribute__((ext_vector_type(8)))short;
using s16x4=__attribute__((ext_vector_type(4)))short;
using f32x16=__attribute__((ext_vector_type(16)))float;
using u32x4=__attribute__((ext_vector_type(4)))unsigned;
constexpr int SEQ=2048,D=64,DM=4096,OPITCH=256;
constexpr int NW=8,QBLK=32,QB=QBLK*NW,KVBLK=64,NQB=SEQ/QB;
constexpr int ATTN_UNIT_ROWS=QB;
__device__ __forceinline__ int crow(int r,int hi){return (r&3)+8*(r>>2)+4*hi;}
#define SBAR() __builtin_amdgcn_sched_barrier(0)
__device__ __forceinline__ void cmask(f32x16&p0,f32x16&p1,int jb,int qrel,int hi){
  const float NEG=-INFINITY; int x=qrel-(64*jb+4*hi); asm volatile("":"+v"(x));
  #pragma unroll
  for(int r=0;r<16;++r){const int c=(r&3)+8*(r>>2); if(c>x)p0[r]=NEG; if(c+32>x)p1[r]=NEG;}
}

constexpr int NSLOT=3, SLOTB=8192;
constexpr int LDS_K=0, LDS_V=NSLOT*SLOTB, LDS_WS=2*NSLOT*SLOTB, LDS_OST=LDS_WS+NW*64*4, LDS_BT=LDS_OST+NW*4096, BT_N=704, LDS_BYTES=LDS_BT+BT_N*4;
constexpr float C2=0.125f*1.4426950408889634f;
__device__ __forceinline__ void glds16(const void*gsrc,unsigned lds_dst){unsigned keep;
  asm volatile("s_mov_b32 %0, m0\n\ts_mov_b32 m0, %2\n\ts_nop 0\n\tglobal_load_lds_dwordx4 %1, off\n\ts_mov_b32 m0, %0":"=&s"(keep):"v"(gsrc),"s"(lds_dst):"memory");}
__device__ __forceinline__ float max3f(float a,float b,float c){float r;asm("v_max3_f32 %0, %1, %2, %3":"=v"(r):"v"(a),"v"(b),"v"(c));return r;}
__device__ __forceinline__ float max2f(float a,float b){float r;asm("v_max_f32_e32 %0, %1, %2":"=v"(r):"v"(a),"v"(b));return r;}
__device__ __forceinline__ float fadd_s(float a,float b){float r;asm("v_add_f32_e32 %0, %1, %2":"=v"(r):"v"(a),"v"(b));return r;}
__device__ __forceinline__ float fsub_s(float a,float b){float r;asm("v_sub_f32_e32 %0, %1, %2":"=v"(r):"v"(a),"v"(b));return r;}
typedef float f32x2_t __attribute__((ext_vector_type(2))); typedef __bf16 bf16x2_t __attribute__((ext_vector_type(2)));
__device__ __forceinline__ unsigned cvtpk_s(float lo,float hi){f32x2_t v={lo,hi};bf16x2_t b=__builtin_convertvector(v,bf16x2_t);return __builtin_bit_cast(unsigned,b);}
#define WAIT_BAR(N) asm volatile("s_waitcnt vmcnt(" #N ") lgkmcnt(0)\n\ts_barrier":::"memory")

__device__ __forceinline__ void qkt(f32x16&p0,f32x16&p1,const char*Kslot,const bf16x8*qr,int r32,int hi){
  const char*kb=Kslot+hi*1024+r32*16;
  #pragma unroll
  for(int d0=0;d0<4;++d0){
    const bf16x8 b0=*reinterpret_cast<const bf16x8*>(kb+d0*2048);
    const bf16x8 b1=*reinterpret_cast<const bf16x8*>(kb+d0*2048+512);
    if(d0==0){p0=__builtin_amdgcn_mfma_f32_32x32x16_bf16(b0,qr[0],f32x16{},0,0,0);p1=__builtin_amdgcn_mfma_f32_32x32x16_bf16(b1,qr[0],f32x16{},0,0,0);}
    else{p0=__builtin_amdgcn_mfma_f32_32x32x16_bf16(b0,qr[d0],p0,0,0,0);p1=__builtin_amdgcn_mfma_f32_32x32x16_bf16(b1,qr[d0],p1,0,0,0);}}
}
typedef __attribute__((address_space(3))) const char* lds_cptr;
typedef short v4i16_t __attribute__((ext_vector_type(4)));
__device__ __forceinline__ void kload8(bf16x8*kf,lds_cptr kp){
  kf[0]=*(const __attribute__((address_space(3))) bf16x8*)(kp);      kf[1]=*(const __attribute__((address_space(3))) bf16x8*)(kp+512);
  kf[2]=*(const __attribute__((address_space(3))) bf16x8*)(kp+2048); kf[3]=*(const __attribute__((address_space(3))) bf16x8*)(kp+2560);
  kf[4]=*(const __attribute__((address_space(3))) bf16x8*)(kp+4096); kf[5]=*(const __attribute__((address_space(3))) bf16x8*)(kp+4608);
  kf[6]=*(const __attribute__((address_space(3))) bf16x8*)(kp+6144); kf[7]=*(const __attribute__((address_space(3))) bf16x8*)(kp+6656);
}
__device__ __forceinline__ void kload2(bf16x8*kf,lds_cptr kp,int j){ kf[2*j]=*(const __attribute__((address_space(3))) bf16x8*)(kp+j*2048); kf[2*j+1]=*(const __attribute__((address_space(3))) bf16x8*)(kp+j*2048+512); }
__device__ __forceinline__ s16x4 vtr(lds_cptr p){ return __builtin_bit_cast(s16x4,__builtin_amdgcn_ds_read_tr16_b64_v4i16((__attribute__((address_space(3))) v4i16_t*)p)); }
__device__ __forceinline__ float rowmax(const f32x16&p0,const f32x16&p1){
  float a=max3f(p0[0],p0[1],p1[0]),b=max3f(p0[2],p0[3],p1[1]);a=max3f(a,p1[2],p1[3]);
  #pragma unroll
  for(int r=4;r<16;r+=4){a=max3f(a,p0[r],p0[r+1]);b=max3f(b,p0[r+2],p0[r+3]);a=max3f(a,p1[r],p1[r+1]);b=max3f(b,p1[r+2],p1[r+3]);}
  const float m=max2f(a,b);
  auto rr=__builtin_amdgcn_permlane32_swap(__float_as_uint(m),__float_as_uint(m),false,false);
  return max2f(__uint_as_float(rr[0]),__uint_as_float(rr[1]));
}
__device__ __forceinline__ void pv(f32x16*o,int vb,bf16x8 pa0,bf16x8 pa1,bf16x8 pa2,bf16x8 pa3){
  #pragma unroll
  for(int d0=0;d0<2;++d0){s16x4 lo[4],hi[4];
    #pragma unroll
    for(int ks=0;ks<4;++ks){
      asm volatile("ds_read_b64_tr_b16 %0,%1 offset:%c2":"=&v"(lo[ks]):"v"(vb),"i"(d0*4096+ks*1024):"memory");
      asm volatile("ds_read_b64_tr_b16 %0,%1 offset:%c2":"=&v"(hi[ks]):"v"(vb),"i"(d0*4096+ks*1024+512):"memory");}
    asm volatile("s_waitcnt lgkmcnt(0)":::"memory");SBAR();
    #define PK(k) (bf16x8){lo[k][0],lo[k][1],lo[k][2],lo[k][3],hi[k][0],hi[k][1],hi[k][2],hi[k][3]}
    o[d0]=__builtin_amdgcn_mfma_f32_32x32x16_bf16(pa0,PK(0),o[d0],0,0,0);
    o[d0]=__builtin_amdgcn_mfma_f32_32x32x16_bf16(pa1,PK(1),o[d0],0,0,0);
    o[d0]=__builtin_amdgcn_mfma_f32_32x32x16_bf16(pa2,PK(2),o[d0],0,0,0);
    o[d0]=__builtin_amdgcn_mfma_f32_32x32x16_bf16(pa3,PK(3),o[d0],0,0,0);
    #undef PK
  }
}

#ifndef ATTN_STORE16
#define ATTN_STORE16(p,v) (*(u32x4*)(p)=(v))
#endif
template<int THRL> __device__ __forceinline__ void attn_unit(const int wid,int b,int qb,const bf16*Qc,const bf16*__restrict__ Kc,const bf16*__restrict__ Vc,bf16*Oc,const float*btabm,char*shm){
  int lane; asm volatile("v_mbcnt_lo_u32_b32 %0, -1, 0\n\tv_mbcnt_hi_u32_b32 %0, -1, %0 ; dep %1":"=v"(lane):"s"(qb));
  const int tid=wid*64+lane,r32=lane&31,hi=lane>>5;
  const long rowbase=(long)b*SEQ; const int q0=qb*QB;
  const bf16*Qw=Qc+(rowbase+q0+wid*QBLK)*DM;
  const bf16*Kh=Kc+rowbase*DM,*Vh=Vc+rowbase*DM;
  const unsigned lds0=(unsigned)(uintptr_t)shm;
  float*wsf=(float*)(shm+LDS_WS)+wid*64;
  const float b31n=btabm[127*16]; const float b31l=b31n*1.4426950408889634f;
  { float*R=(float*)(shm+LDS_BT); for(int j=tid;j<BT_N;j+=NW*64){ int d=447-j; float v=0.f; if(d>=0&&d<127) v=(btabm[d*16]-b31n)*1.4426950408889634f; R[j]=v; } }
  const bf16*ksrc=Kh+(long)lane*DM+wid*8;
  const bf16*vsrc=Vh+(long)(16*(wid&3)+(lane>>2))*DM+(wid>>2)*32+(lane&3)*8;
  const unsigned kdst=lds0+LDS_K+wid*1024, vdst=lds0+LDS_V+wid*1024;
  #define DMA_K(t,slot) glds16(ksrc+(long)(t)*KVBLK*DM,(unsigned)__builtin_amdgcn_readfirstlane(kdst+(slot)))
  #define DMA_V(t,slot) glds16(vsrc+(long)(t)*KVBLK*DM,(unsigned)__builtin_amdgcn_readfirstlane(vdst+(slot)))
  const int vb0=(int)(lds0+LDS_V)+((lane>>4)&1)*32+(lane&3)*8+(4*hi+((lane&15)>>2))*64;
  const char*Kbase=shm+LDS_K; bf16x8 kf[8];
  const lds_cptr shm3=(lds_cptr)shm; const lds_cptr kp0=shm3+LDS_K+hi*1024+r32*16; const lds_cptr vp0=shm3+LDS_V+((lane>>4)&1)*32+(lane&3)*8+(4*hi+((lane&15)>>2))*64;
  const int NT=(q0+QB)/KVBLK;
  DMA_K(0,0);DMA_V(0,0);DMA_K(1,SLOTB);
  bf16x8 qr[4];
  #pragma unroll
  for(int d0=0;d0<4;++d0)qr[d0]=*reinterpret_cast<const bf16x8*>(&Qw[(long)r32*DM+d0*16+hi*8]);
  float mhat=0.f,l_reg=0.f;f32x16 o[2];o[0]=f32x16{};o[1]=f32x16{};
  const int qrel=wid*QBLK+r32;
  typedef __attribute__((address_space(3))) const float* lds_fptr;
  const lds_fptr Rl=(lds_fptr)((lds_cptr)shm+LDS_BT)+(447-(q0+qrel-4*hi));
  #define CBIAS(P0,P1,t) do{ const lds_fptr rp_=Rl+64*(t); \
    _Pragma("unroll") for(int g_=0;g_<4;++g_){ SBAR(); _Pragma("unroll") for(int r=4*g_;r<4*g_+4;++r){ P0[r]+=rp_[(r&3)+8*(r>>2)]; P1[r]+=rp_[32+(r&3)+8*(r>>2)]; } } SBAR(); }while(0)
  #define CMASK(P0,P1,t) do{ if((t)>=NT-7){ CBIAS(P0,P1,t); } int jb_=(t)-(NT-4); if(jb_>=0)cmask(P0,P1,jb_,qrel,hi);}while(0)
  bool resc=false;
  #define START(P0,P1) do{ const float rm=rowmax(P0,P1); resc=false; \
    { const float dl=rm; mhat=fadd_s(mhat,dl); \
      _Pragma("unroll") for(int r=0;r<16;++r){P0[r]=fsub_s(P0[r],dl);P1[r]=fsub_s(P1[r],dl);} \
      } \
    _Pragma("unroll") for(int r=0;r<16;++r)P0[r]=__builtin_amdgcn_exp2f(P0[r]); }while(0)
  #define RESC() do{ if(resc){ asm volatile("s_waitcnt lgkmcnt(0)":::"memory"); \
      _Pragma("unroll") for(int d_=0;d_<2;++d_) _Pragma("unroll") for(int r=0;r<16;++r)o[d_][r]*=wsf[crow(r,hi)]; } }while(0)
  f32x16 pA0,pA1,pB0,pB1;
  int sl_prev=0,sl_cur=0,sl_next=SLOTB;
  #define ROT() do{sl_prev=sl_cur;sl_cur=sl_next;sl_next=(sl_next==(NSLOT-1)*SLOTB)?0:sl_next+SLOTB;}while(0)
  DMA_K(2,2*SLOTB);
  WAIT_BAR(3);
  qkt(pA0,pA1,Kbase,qr,r32,hi);asm volatile("s_nop 15\n\ts_nop 7":"+v"(pA0),"+v"(pA1));
  #pragma unroll
  for(int r=0;r<16;++r){pA0[r]+=b31l;pA1[r]+=b31l;}
  CMASK(pA0,pA1,0);
  START(pA0,pA1);
  _Pragma("unroll") for(int r=0;r<16;++r)pA1[r]=__builtin_amdgcn_exp2f(pA1[r]);
  WAIT_BAR(0);
  DMA_K(3,0);DMA_V(1,SLOTB);
  ROT();
  kload8(kf,kp0+sl_cur);
  WAIT_BAR(2);
  s16x4 vlo[8],vhi[8]; u32x4 pw0,pw1,pw2,pw3;
  #define PKW(P,B) cvtpk_s(P[B],P[B+1])
  #define PAF(k) __builtin_bit_cast(bf16x8,pw##k)
  #define VFR(i) (bf16x8){vlo[i][0],vlo[i][1],vlo[i][2],vlo[i][3],vhi[i][0],vhi[i][1],vhi[i][2],vhi[i][3]}
  #define PIN(x) asm volatile("":"+v"(x))
  #define MX3(a,b,c) __builtin_fmaxf(__builtin_fmaxf((a),(b)),(c))
  #define GAPA(MF,A0,A1,A2,A3,W0,W1,PW) do{ MF; sacc+=A0; sacc+=A1; sacc+=A2; sacc+=A3; PIN(sacc); W0; W1; PIN(PW); SBAR(); }while(0)
  #define EX(v) __builtin_amdgcn_exp2f(v)
  #define GAPB(MF,X,B) do{ MF; X[B]=EX(X[B]); X[B+1]=EX(X[B+1]); X[B+2]=EX(X[B+2]); X[B+3]=EX(X[B+3]); PIN(X); SBAR(); }while(0)
  #define VRD(i) do{ vlo[i]=vtr(vp_+(((i)>>2)*4096+((i)&3)*1024)); vhi[i]=vtr(vp_+(((i)>>2)*4096+((i)&3)*1024+512)); }while(0)
  #define KRD(G,j) do{ if(G){ kload2(kf,kp0+sl_next,j); SBAR(); } }while(0)
  #define STEP(C0,C1,P0,P1,t,GK,GV,GL) do{ SBAR(); \
    const lds_cptr vp_=vp0+sl_prev; \
    VRD(0); SBAR(); float sacc=(P0[0]+P0[1]); \
    GAPA(C0=__builtin_amdgcn_mfma_f32_32x32x16_bf16(kf[0],qr[0],f32x16{},0,0,0), P0[2],P0[3],P0[4],P0[5],     pw0[0]=PKW(P0,0), pw0[1]=PKW(P0,2), pw0); \
    VRD(4); SBAR(); GAPA(C1=__builtin_amdgcn_mfma_f32_32x32x16_bf16(kf[1],qr[0],f32x16{},0,0,0), P0[6],P0[7],P0[8],P0[9],     pw0[2]=PKW(P0,4), pw0[3]=PKW(P0,6), pw0); \
    VRD(1); SBAR(); GAPA(C0=__builtin_amdgcn_mfma_f32_32x32x16_bf16(kf[2],qr[1],C0,0,0,0),   P0[10],P0[11],P0[12],P0[13], pw1[0]=PKW(P0,8), pw1[1]=PKW(P0,10), pw1); \
    VRD(5); SBAR(); GAPA(C1=__builtin_amdgcn_mfma_f32_32x32x16_bf16(kf[3],qr[1],C1,0,0,0),   P0[14],P0[15],P1[0],P1[1],   pw1[2]=PKW(P0,12),pw1[3]=PKW(P0,14), pw1); \
    VRD(2); SBAR(); GAPA(C0=__builtin_amdgcn_mfma_f32_32x32x16_bf16(kf[4],qr[2],C0,0,0,0),   P1[2],P1[3],P1[4],P1[5],     pw2[0]=PKW(P1,0), pw2[1]=PKW(P1,2), pw2); \
    VRD(6); SBAR(); GAPA(C1=__builtin_amdgcn_mfma_f32_32x32x16_bf16(kf[5],qr[2],C1,0,0,0),   P1[6],P1[7],P1[8],P1[9],     pw2[2]=PKW(P1,4), pw2[3]=PKW(P1,6), pw2); \
    VRD(3); SBAR(); GAPA(C0=__builtin_amdgcn_mfma_f32_32x32x16_bf16(kf[6],qr[3],C0,0,0,0),   P1[10],P1[11],P1[12],P1[13], pw3[0]=PKW(P1,8), pw3[1]=PKW(P1,10), pw3); \
    VRD(7); SBAR(); GAPA(C1=__builtin_amdgcn_mfma_f32_32x32x16_bf16(kf[7],qr[3],C1,0,0,0),   P1[14],P1[15],0.f,0.f,       pw3[2]=PKW(P1,12),pw3[3]=PKW(P1,14), pw3); \
    l_reg+=sacc; \
    if(GK){DMA_K((t)+3,sl_cur);} if(GV){DMA_V((t)+1,sl_next);} \
    { const float nb_=b31l-mhat; _Pragma("unroll") for(int r=0;r<16;++r){C0[r]+=nb_;C1[r]+=nb_;} } \
    CMASK(C0,C1,t); \
    { float a=MX3(C0[0],C0[1],C1[0]),b=MX3(C0[2],C0[3],C1[1]); a=MX3(a,C1[2],C1[3]); \
      _Pragma("unroll") for(int r=4;r<16;r+=4){a=MX3(a,C0[r],C0[r+1]);b=MX3(b,C0[r+2],C0[r+3]);a=MX3(a,C1[r],C1[r+1]);b=MX3(b,C1[r+2],C1[r+3]);} \
      float rm=__builtin_fmaxf(a,b); { auto rr=__builtin_amdgcn_permlane32_swap(__float_as_uint(rm),__float_as_uint(rm),false,false); rm=__builtin_fmaxf(__uint_as_float(rr[0]),__uint_as_float(rr[1])); } \
      resc=false; \
      if(__builtin_expect(__any(rm>(float)THRL),0)){ const float dl=__builtin_fmaxf(rm,0.f); mhat+=dl; \
        _Pragma("unroll") for(int r=0;r<16;++r){C0[r]-=dl;C1[r]-=dl;} \
        const float f=__builtin_amdgcn_exp2f(-dl); l_reg*=f; { int r32b_=r32; asm volatile("":"+v"(r32b_)); if(hi==0)wsf[r32b_]=f; } resc=true; } } \
    SBAR(); \
    GAPB(o[0]=__builtin_amdgcn_mfma_f32_32x32x16_bf16(PAF(0),VFR(0),o[0],0,0,0), C0,0); \
    GAPB(o[1]=__builtin_amdgcn_mfma_f32_32x32x16_bf16(PAF(0),VFR(4),o[1],0,0,0), C0,4); \
    KRD(GL,0); GAPB(o[0]=__builtin_amdgcn_mfma_f32_32x32x16_bf16(PAF(1),VFR(1),o[0],0,0,0), C0,8); \
    KRD(GL,1); GAPB(o[1]=__builtin_amdgcn_mfma_f32_32x32x16_bf16(PAF(1),VFR(5),o[1],0,0,0), C0,12); \
    KRD(GL,2); GAPB(o[0]=__builtin_amdgcn_mfma_f32_32x32x16_bf16(PAF(2),VFR(2),o[0],0,0,0), C1,0); \
    KRD(GL,3); GAPB(o[1]=__builtin_amdgcn_mfma_f32_32x32x16_bf16(PAF(2),VFR(6),o[1],0,0,0), C1,4); \
    GAPB(o[0]=__builtin_amdgcn_mfma_f32_32x32x16_bf16(PAF(3),VFR(3),o[0],0,0,0), C1,8); \
    GAPB(o[1]=__builtin_amdgcn_mfma_f32_32x32x16_bf16(PAF(3),VFR(7),o[1],0,0,0), C1,12); \
    }while(0)
  int t=1;
  #undef CMASK
  #define CMASK(P0,P1,t) do{}while(0)
  for(;t+7<NT;t+=2){
    STEP(pB0,pB1,pA0,pA1,t,true,true,true);     WAIT_BAR(2); RESC(); ROT();
    STEP(pA0,pA1,pB0,pB1,t+1,true,true,true);   WAIT_BAR(2); RESC(); ROT();
  }
  #undef CMASK
  #define CMASK(P0,P1,t) do{ CBIAS(P0,P1,t); int jb_=(t)-(NT-4); if(jb_>=0)cmask(P0,P1,jb_,qrel,hi);}while(0)
  #define ENDW(tt) do{ if((tt)+3<NT){WAIT_BAR(2);} else if((tt)+2<NT){WAIT_BAR(1);} else {WAIT_BAR(0);} }while(0)
  for(;t+1<NT;t+=2){
    STEP(pB0,pB1,pA0,pA1,t,(t+3<NT),(t+1<NT),(t+1<NT));       ENDW(t);   RESC(); ROT();
    STEP(pA0,pA1,pB0,pB1,t+1,(t+4<NT),(t+2<NT),(t+2<NT));     ENDW(t+1); RESC(); ROT();
  }
  STEP(pB0,pB1,pA0,pA1,NT-1,false,false,false); RESC();
  { float sacc=pB0[0]+pB0[1]; _Pragma("unroll") for(int r=2;r<16;++r)sacc+=pB0[r]; _Pragma("unroll") for(int r=0;r<16;++r)sacc+=pB1[r]; l_reg+=sacc;
    pw0=(u32x4){PKW(pB0,0),PKW(pB0,2),PKW(pB0,4),PKW(pB0,6)};pw1=(u32x4){PKW(pB0,8),PKW(pB0,10),PKW(pB0,12),PKW(pB0,14)};pw2=(u32x4){PKW(pB1,0),PKW(pB1,2),PKW(pB1,4),PKW(pB1,6)};pw3=(u32x4){PKW(pB1,8),PKW(pB1,10),PKW(pB1,12),PKW(pB1,14)};
    SBAR(); pv(o,vb0+sl_cur,PAF(0),PAF(1),PAF(2),PAF(3)); }
  #undef PKW
  #undef PAF
  #undef VFR
  #undef PIN
  #undef MX3
  #undef GAPA
  #undef GAPB
  #undef EX
  #undef VRD
  #undef KRD
  #undef STEP
  #undef ENDW
  {auto rr=__builtin_amdgcn_permlane32_swap(__float_as_uint(l_reg),__float_as_uint(l_reg),false,false);l_reg=__uint_as_float(rr[0])+__uint_as_float(rr[1]);}
  if(hi==0)wsf[32+r32]=l_reg;asm volatile("s_waitcnt lgkmcnt(0)":::"memory");
  float rli[16];
  #pragma unroll
  for(int r=0;r<16;++r)rli[r]=__builtin_amdgcn_rcpf(wsf[32+crow(r,hi)]);
  bf16*Ow=Oc+(long)(wid*QBLK)*OPITCH;
  { bf16*stg=(bf16*)(shm+LDS_OST)+wid*2048;
    #pragma unroll
    for(int r=0;r<16;++r){const int orow=crow(r,hi);
      #pragma unroll
      for(int d0=0;d0<2;++d0)stg[orow*64+d0*32+r32]=__float2bfloat16(o[d0][r]*rli[r]);}
    asm volatile("s_waitcnt lgkmcnt(0)":::"memory");
    #pragma unroll
    for(int i=0;i<4;++i){const int row=i*8+(lane>>3),ch=lane&7; const u32x4 v=*(const u32x4*)(stg+row*64+ch*8); ATTN_STORE16(Ow+(long)row*OPITCH+ch*8,v);} }
  asm volatile("s_waitcnt lgkmcnt(0)\n\ts_barrier":::"memory");
  #undef DMA_K
  #undef DMA_V
  #undef CMASK
  #undef CBIAS
  #undef START
  #undef RESC
  #undef ROT
}
constexpr int ATTN_LDS_BYTES=LDS_BYTES;
#undef SBAR
#undef WAIT_BAR
}

namespace attn2 {
using bf16=__hip_bfloat16;
using bf16x8=__attribute__((ext_vector_type(8)))short;
using s16x4=__attribute__((ext_vector_type(4)))short;
using f32x16=__attribute__((ext_vector_type(16)))float;
using u32x4=__attribute__((ext_vector_type(4)))unsigned;
constexpr int SEQ=2048,D=64,DM=4096,OPITCH=256;
constexpr int NW=8,QBLK=32,QB=QBLK*NW,KVBLK=64,NQB=SEQ/QB;
constexpr int ATTN_UNIT_ROWS=QB;
__device__ __forceinline__ int crow(int r,int hi){return (r&3)+8*(r>>2)+4*hi;}
#define SBAR() __builtin_amdgcn_sched_barrier(0)
__device__ __forceinline__ void cmask(f32x16&p0,f32x16&p1,int jb,int qrel,int hi){
  const float NEG=-INFINITY; int x=qrel-(64*jb+4*hi); asm volatile("":"+v"(x));
  #pragma unroll
  for(int r=0;r<16;++r){const int c=(r&3)+8*(r>>2); if(c>x)p0[r]=NEG; if(c+32>x)p1[r]=NEG;}
}

constexpr int NSLOT=3, SLOTB=8192, VSLOTB=16384;
constexpr int LDS_K=0, LDS_V=NSLOT*SLOTB, LDS_WS=LDS_V+NSLOT*VSLOTB, LDS_OST=LDS_WS+NW*64*4, LDS_BT=LDS_OST+NW*8192, BT_N=704, LDS_BYTES=LDS_BT+BT_N*4;
constexpr float C2=0.125f*1.4426950408889634f;
__device__ __forceinline__ void glds16(const void*gsrc,unsigned lds_dst){unsigned keep;
  asm volatile("s_mov_b32 %0, m0\n\ts_mov_b32 m0, %2\n\ts_nop 0\n\tglobal_load_lds_dwordx4 %1, off\n\ts_mov_b32 m0, %0":"=&s"(keep):"v"(gsrc),"s"(lds_dst):"memory");}
__device__ __forceinline__ float max3f(float a,float b,float c){float r;asm("v_max3_f32 %0, %1, %2, %3":"=v"(r):"v"(a),"v"(b),"v"(c));return r;}
__device__ __forceinline__ float max2f(float a,float b){float r;asm("v_max_f32_e32 %0, %1, %2":"=v"(r):"v"(a),"v"(b));return r;}
__device__ __forceinline__ float fadd_s(float a,float b){float r;asm("v_add_f32_e32 %0, %1, %2":"=v"(r):"v"(a),"v"(b));return r;}
__device__ __forceinline__ float fsub_s(float a,float b){float r;asm("v_sub_f32_e32 %0, %1, %2":"=v"(r):"v"(a),"v"(b));return r;}
typedef float f32x2_t __attribute__((ext_vector_type(2))); typedef __bf16 bf16x2_t __attribute__((ext_vector_type(2)));
__device__ __forceinline__ unsigned cvtpk_s(float lo,float hi){f32x2_t v={lo,hi};bf16x2_t b=__builtin_convertvector(v,bf16x2_t);return __builtin_bit_cast(unsigned,b);}
#define WAIT_BAR(N) asm volatile("s_waitcnt vmcnt(" #N ") lgkmcnt(0)\n\ts_barrier":::"memory")

__device__ __forceinline__ void qkt(f32x16&p0,f32x16&p1,const char*Kslot,const bf16x8*qr,int r32,int hi){
  const char*kb=Kslot+hi*1024+r32*16;
  #pragma unroll
  for(int d0=0;d0<4;++d0){
    const bf16x8 b0=*reinterpret_cast<const bf16x8*>(kb+d0*2048);
    const bf16x8 b1=*reinterpret_cast<const bf16x8*>(kb+d0*2048+512);
    if(d0==0){p0=__builtin_amdgcn_mfma_f32_32x32x16_bf16(b0,qr[0],f32x16{},0,0,0);p1=__builtin_amdgcn_mfma_f32_32x32x16_bf16(b1,qr[0],f32x16{},0,0,0);}
    else{p0=__builtin_amdgcn_mfma_f32_32x32x16_bf16(b0,qr[d0],p0,0,0,0);p1=__builtin_amdgcn_mfma_f32_32x32x16_bf16(b1,qr[d0],p1,0,0,0);}}
}
typedef __attribute__((address_space(3))) const char* lds_cptr;
typedef short v4i16_t __attribute__((ext_vector_type(4)));
__device__ __forceinline__ void kload8(bf16x8*kf,lds_cptr kp){
  kf[0]=*(const __attribute__((address_space(3))) bf16x8*)(kp);      kf[1]=*(const __attribute__((address_space(3))) bf16x8*)(kp+512);
  kf[2]=*(const __attribute__((address_space(3))) bf16x8*)(kp+2048); kf[3]=*(const __attribute__((address_space(3))) bf16x8*)(kp+2560);
  kf[4]=*(const __attribute__((address_space(3))) bf16x8*)(kp+4096); kf[5]=*(const __attribute__((address_space(3))) bf16x8*)(kp+4608);
  kf[6]=*(const __attribute__((address_space(3))) bf16x8*)(kp+6144); kf[7]=*(const __attribute__((address_space(3))) bf16x8*)(kp+6656);
}
__device__ __forceinline__ void kload2(bf16x8*kf,lds_cptr kp,int j){ kf[2*j]=*(const __attribute__((address_space(3))) bf16x8*)(kp+j*2048); kf[2*j+1]=*(const __attribute__((address_space(3))) bf16x8*)(kp+j*2048+512); }
__device__ __forceinline__ s16x4 vtr(lds_cptr p){ return __builtin_bit_cast(s16x4,__builtin_amdgcn_ds_read_tr16_b64_v4i16((__attribute__((address_space(3))) v4i16_t*)p)); }
__device__ __forceinline__ float rowmax(const f32x16&p0,const f32x16&p1){
  float a=max3f(p0[0],p0[1],p1[0]),b=max3f(p0[2],p0[3],p1[1]);a=max3f(a,p1[2],p1[3]);
  #pragma unroll
  for(int r=4;r<16;r+=4){a=max3f(a,p0[r],p0[r+1]);b=max3f(b,p0[r+2],p0[r+3]);a=max3f(a,p1[r],p1[r+1]);b=max3f(b,p1[r+2],p1[r+3]);}
  const float m=max2f(a,b);
  auto rr=__builtin_amdgcn_permlane32_swap(__float_as_uint(m),__float_as_uint(m),false,false);
  return max2f(__uint_as_float(rr[0]),__uint_as_float(rr[1]));
}
__device__ __forceinline__ void pv(f32x16*o,int vb,bf16x8 pa0,bf16x8 pa1,bf16x8 pa2,bf16x8 pa3){
  #pragma unroll
  for(int d0=0;d0<4;++d0){s16x4 lo[4],hi[4];
    #pragma unroll
    for(int ks=0;ks<4;++ks){
      asm volatile("ds_read_b64_tr_b16 %0,%1 offset:%c2":"=&v"(lo[ks]):"v"(vb),"i"(d0*4096+ks*1024):"memory");
      asm volatile("ds_read_b64_tr_b16 %0,%1 offset:%c2":"=&v"(hi[ks]):"v"(vb),"i"(d0*4096+ks*1024+512):"memory");}
    asm volatile("s_waitcnt lgkmcnt(0)":::"memory");SBAR();
    #define PK(k) (bf16x8){lo[k][0],lo[k][1],lo[k][2],lo[k][3],hi[k][0],hi[k][1],hi[k][2],hi[k][3]}
    o[d0]=__builtin_amdgcn_mfma_f32_32x32x16_bf16(pa0,PK(0),o[d0],0,0,0);
    o[d0]=__builtin_amdgcn_mfma_f32_32x32x16_bf16(pa1,PK(1),o[d0],0,0,0);
    o[d0]=__builtin_amdgcn_mfma_f32_32x32x16_bf16(pa2,PK(2),o[d0],0,0,0);
    o[d0]=__builtin_amdgcn_mfma_f32_32x32x16_bf16(pa3,PK(3),o[d0],0,0,0);
    #undef PK
  }
}

#ifndef ATTN_STORE16
#define ATTN_STORE16(p,v) (*(u32x4*)(p)=(v))
#endif
template<int THRL> __device__ __forceinline__ void attn_unit(const int wid,int b,int qb,const bf16*Qc,const bf16*__restrict__ Kc,const bf16*__restrict__ Vc,bf16*Oc,const float*btabm,char*shm){
  int lane; asm volatile("v_mbcnt_lo_u32_b32 %0, -1, 0\n\tv_mbcnt_hi_u32_b32 %0, -1, %0 ; dep %1":"=v"(lane):"s"(qb));
  const int tid=wid*64+lane,r32=lane&31,hi=lane>>5;
  const long rowbase=(long)b*SEQ; const int q0=qb*QB;
  const bf16*Qw=Qc+(rowbase+q0+wid*QBLK)*DM;
  const bf16*Kh=Kc+rowbase*DM,*Vh=Vc+rowbase*DM;
  const unsigned lds0=(unsigned)(uintptr_t)shm;
  float*wsf=(float*)(shm+LDS_WS)+wid*64;
  const float b31n=btabm[127*16]; const float b31l=b31n*1.4426950408889634f;
  { float*R=(float*)(shm+LDS_BT); for(int j=tid;j<BT_N;j+=NW*64){ int d=447-j; float v=0.f; if(d>=0&&d<127) v=(btabm[d*16]-b31n)*1.4426950408889634f; R[j]=v; } }
  const bf16*ksrc=Kh+(long)lane*DM+wid*8;
  const bf16*vsrc=Vh+(long)(16*(wid&3)+(lane>>2))*DM+(wid>>2)*32+(lane&3)*8;
  const unsigned kdst=lds0+LDS_K+wid*1024, vdst=lds0+LDS_V+wid*1024;
  #define DMA_K(t,slot) glds16(ksrc+(long)(t)*KVBLK*DM,(unsigned)__builtin_amdgcn_readfirstlane(kdst+(slot)))
  #define DMA_V(t,slot) do{ glds16(vsrc+(long)(t)*KVBLK*DM,(unsigned)__builtin_amdgcn_readfirstlane(vdst+2*(slot))); glds16(vsrc+64+(long)(t)*KVBLK*DM,(unsigned)__builtin_amdgcn_readfirstlane(vdst+2*(slot)+8192)); }while(0)
  const int vb0=(int)(lds0+LDS_V)+((lane>>4)&1)*32+(lane&3)*8+(4*hi+((lane&15)>>2))*64;
  const char*Kbase=shm+LDS_K; bf16x8 kf[8];
  const lds_cptr shm3=(lds_cptr)shm; const lds_cptr kp0=shm3+LDS_K+hi*1024+r32*16; const lds_cptr vp0=shm3+LDS_V+((lane>>4)&1)*32+(lane&3)*8+(4*hi+((lane&15)>>2))*64;
  const int NT=(q0+QB)/KVBLK;
  DMA_K(0,0);DMA_V(0,0);DMA_K(1,SLOTB);
  bf16x8 qr[4];
  #pragma unroll
  for(int d0=0;d0<4;++d0)qr[d0]=*reinterpret_cast<const bf16x8*>(&Qw[(long)r32*DM+d0*16+hi*8]);
  float mhat=0.f,l_reg=0.f;f32x16 o[4];o[0]=f32x16{};o[1]=f32x16{};o[2]=f32x16{};o[3]=f32x16{};
  const int qrel=wid*QBLK+r32;
  typedef __attribute__((address_space(3))) const float* lds_fptr;
  const lds_fptr Rl=(lds_fptr)((lds_cptr)shm+LDS_BT)+(447-(q0+qrel-4*hi));
  #define CBIAS(P0,P1,t) do{ const lds_fptr rp_=Rl+64*(t); \
    _Pragma("unroll") for(int g_=0;g_<4;++g_){ SBAR(); _Pragma("unroll") for(int r=4*g_;r<4*g_+4;++r){ P0[r]+=rp_[(r&3)+8*(r>>2)]; P1[r]+=rp_[32+(r&3)+8*(r>>2)]; } } SBAR(); }while(0)
  #define CMASK(P0,P1,t) do{ if((t)>=NT-7){ CBIAS(P0,P1,t); } int jb_=(t)-(NT-4); if(jb_>=0)cmask(P0,P1,jb_,qrel,hi);}while(0)
  bool resc=false;
  #define START(P0,P1) do{ const float rm=rowmax(P0,P1); resc=false; \
    { const float dl=rm; mhat=fadd_s(mhat,dl); \
      _Pragma("unroll") for(int r=0;r<16;++r){P0[r]=fsub_s(P0[r],dl);P1[r]=fsub_s(P1[r],dl);} \
      } \
    _Pragma("unroll") for(int r=0;r<16;++r)P0[r]=__builtin_amdgcn_exp2f(P0[r]); }while(0)
  #define RESC() do{ if(resc){ asm volatile("s_waitcnt lgkmcnt(0)":::"memory"); \
      _Pragma("unroll") for(int d_=0;d_<4;++d_) _Pragma("unroll") for(int r=0;r<16;++r)o[d_][r]*=wsf[crow(r,hi)]; } }while(0)
  f32x16 pA0,pA1,pB0,pB1;
  int sl_prev=0,sl_cur=0,sl_next=SLOTB;
  #define ROT() do{sl_prev=sl_cur;sl_cur=sl_next;sl_next=(sl_next==(NSLOT-1)*SLOTB)?0:sl_next+SLOTB;}while(0)
  DMA_K(2,2*SLOTB);
  WAIT_BAR(3);
  qkt(pA0,pA1,Kbase,qr,r32,hi);asm volatile("s_nop 15\n\ts_nop 7":"+v"(pA0),"+v"(pA1));
  #pragma unroll
  for(int r=0;r<16;++r){pA0[r]+=b31l;pA1[r]+=b31l;}
  CMASK(pA0,pA1,0);
  START(pA0,pA1);
  _Pragma("unroll") for(int r=0;r<16;++r)pA1[r]=__builtin_amdgcn_exp2f(pA1[r]);
  WAIT_BAR(0);
  DMA_K(3,0);DMA_V(1,SLOTB);
  ROT();
  kload8(kf,kp0+sl_cur);
  WAIT_BAR(3);
  s16x4 vfl0,vfl1,vfl2,vfl3,vfh0,vfh1,vfh2,vfh3; u32x4 pw0,pw1,pw2,pw3;
  #define PKW(P,B) cvtpk_s(P[B],P[B+1])
  #define PAF(k) __builtin_bit_cast(bf16x8,pw##k)
  #define VFRS(s_) (bf16x8){vfl##s_[0],vfl##s_[1],vfl##s_[2],vfl##s_[3],vfh##s_[0],vfh##s_[1],vfh##s_[2],vfh##s_[3]}
  #define PIN(x) asm volatile("":"+v"(x))
  #define MX3(a,b,c) __builtin_fmaxf(__builtin_fmaxf((a),(b)),(c))
  #define GAPA(MF,A0,A1,A2,A3,W0,W1,PW) do{ MF; sacc+=A0; sacc+=A1; sacc+=A2; sacc+=A3; PIN(sacc); W0; W1; PIN(PW); SBAR(); }while(0)
  #define EX(v) __builtin_amdgcn_exp2f(v)
  #define GAPB(MF,X,B) do{ MF; X[B]=EX(X[B]); X[B+1]=EX(X[B+1]); PIN(X); SBAR(); }while(0)
  #define VRF(s_,i) do{ vfl##s_=vtr(vp_+(((i)>>2)*4096+((i)&3)*1024)); vfh##s_=vtr(vp_+(((i)>>2)*4096+((i)&3)*1024+512)); }while(0)
  #define KRD(G,j) do{ if(G){ kload2(kf,kp0+sl_next,j); SBAR(); } }while(0)
  #define STEP(C0,C1,P0,P1,t,GK,GV,GL) do{ SBAR(); \
    const lds_cptr vp_=vp0+2*sl_prev; \
    float sacc=(P0[0]+P0[1]); \
    GAPA(C0=__builtin_amdgcn_mfma_f32_32x32x16_bf16(kf[0],qr[0],f32x16{},0,0,0), P0[2],P0[3],P0[4],P0[5],     pw0[0]=PKW(P0,0), pw0[1]=PKW(P0,2), pw0); \
    GAPA(C1=__builtin_amdgcn_mfma_f32_32x32x16_bf16(kf[1],qr[0],f32x16{},0,0,0), P0[6],P0[7],P0[8],P0[9],     pw0[2]=PKW(P0,4), pw0[3]=PKW(P0,6), pw0); \
    GAPA(C0=__builtin_amdgcn_mfma_f32_32x32x16_bf16(kf[2],qr[1],C0,0,0,0),   P0[10],P0[11],P0[12],P0[13], pw1[0]=PKW(P0,8), pw1[1]=PKW(P0,10), pw1); \
    GAPA(C1=__builtin_amdgcn_mfma_f32_32x32x16_bf16(kf[3],qr[1],C1,0,0,0),   P0[14],P0[15],P1[0],P1[1],   pw1[2]=PKW(P0,12),pw1[3]=PKW(P0,14), pw1); \
    GAPA(C0=__builtin_amdgcn_mfma_f32_32x32x16_bf16(kf[4],qr[2],C0,0,0,0),   P1[2],P1[3],P1[4],P1[5],     pw2[0]=PKW(P1,0), pw2[1]=PKW(P1,2), pw2); \
    GAPA(C1=__builtin_amdgcn_mfma_f32_32x32x16_bf16(kf[5],qr[2],C1,0,0,0),   P1[6],P1[7],P1[8],P1[9],     pw2[2]=PKW(P1,4), pw2[3]=PKW(P1,6), pw2); \
    GAPA(C0=__builtin_amdgcn_mfma_f32_32x32x16_bf16(kf[6],qr[3],C0,0,0,0),   P1[10],P1[11],P1[12],P1[13], pw3[0]=PKW(P1,8), pw3[1]=PKW(P1,10), pw3); \
    GAPA(C1=__builtin_amdgcn_mfma_f32_32x32x16_bf16(kf[7],qr[3],C1,0,0,0),   P1[14],P1[15],0.f,0.f,       pw3[2]=PKW(P1,12),pw3[3]=PKW(P1,14), pw3); \
    l_reg+=sacc; \
    VRF(0,0); VRF(1,4); VRF(2,8); SBAR(); \
    if(GK){DMA_K((t)+3,sl_cur);} if(GV){DMA_V((t)+1,sl_next);} \
    { const float nb_=b31l-mhat; _Pragma("unroll") for(int r=0;r<16;++r){C0[r]+=nb_;C1[r]+=nb_;} } \
    CMASK(C0,C1,t); \
    { float a=MX3(C0[0],C0[1],C1[0]),b=MX3(C0[2],C0[3],C1[1]); a=MX3(a,C1[2],C1[3]); \
      _Pragma("unroll") for(int r=4;r<16;r+=4){a=MX3(a,C0[r],C0[r+1]);b=MX3(b,C0[r+2],C0[r+3]);a=MX3(a,C1[r],C1[r+1]);b=MX3(b,C1[r+2],C1[r+3]);} \
      float rm=__builtin_fmaxf(a,b); { auto rr=__builtin_amdgcn_permlane32_swap(__float_as_uint(rm),__float_as_uint(rm),false,false); rm=__builtin_fmaxf(__uint_as_float(rr[0]),__uint_as_float(rr[1])); } \
      resc=false; \
      if(__builtin_expect(__any(rm>(float)THRL),0)){ const float dl=__builtin_fmaxf(rm,0.f); mhat+=dl; \
        _Pragma("unroll") for(int r=0;r<16;++r){C0[r]-=dl;C1[r]-=dl;} \
        const float f=__builtin_amdgcn_exp2f(-dl); l_reg*=f; { int r32b_=r32; asm volatile("":"+v"(r32b_)); if(hi==0)wsf[r32b_]=f; } resc=true; } } \
    SBAR(); \
    VRF(3,12); GAPB(o[0]=__builtin_amdgcn_mfma_f32_32x32x16_bf16(PAF(0),VFRS(0),o[0],0,0,0), C0,0); \
    VRF(0,1); GAPB(o[1]=__builtin_amdgcn_mfma_f32_32x32x16_bf16(PAF(0),VFRS(1),o[1],0,0,0), C0,2); \
    VRF(1,5); GAPB(o[2]=__builtin_amdgcn_mfma_f32_32x32x16_bf16(PAF(0),VFRS(2),o[2],0,0,0), C0,4); \
    VRF(2,9); GAPB(o[3]=__builtin_amdgcn_mfma_f32_32x32x16_bf16(PAF(0),VFRS(3),o[3],0,0,0), C0,6); \
    VRF(3,13); KRD(GL,0); GAPB(o[0]=__builtin_amdgcn_mfma_f32_32x32x16_bf16(PAF(1),VFRS(0),o[0],0,0,0), C0,8); \
    VRF(0,2); GAPB(o[1]=__builtin_amdgcn_mfma_f32_32x32x16_bf16(PAF(1),VFRS(1),o[1],0,0,0), C0,10); \
    VRF(1,6); KRD(GL,1); GAPB(o[2]=__builtin_amdgcn_mfma_f32_32x32x16_bf16(PAF(1),VFRS(2),o[2],0,0,0), C0,12); \
    VRF(2,10); GAPB(o[3]=__builtin_amdgcn_mfma_f32_32x32x16_bf16(PAF(1),VFRS(3),o[3],0,0,0), C0,14); \
    VRF(3,14); KRD(GL,2); GAPB(o[0]=__builtin_amdgcn_mfma_f32_32x32x16_bf16(PAF(2),VFRS(0),o[0],0,0,0), C1,0); \
    VRF(0,3); GAPB(o[1]=__builtin_amdgcn_mfma_f32_32x32x16_bf16(PAF(2),VFRS(1),o[1],0,0,0), C1,2); \
    VRF(1,7); KRD(GL,3); GAPB(o[2]=__builtin_amdgcn_mfma_f32_32x32x16_bf16(PAF(2),VFRS(2),o[2],0,0,0), C1,4); \
    VRF(2,11); GAPB(o[3]=__builtin_amdgcn_mfma_f32_32x32x16_bf16(PAF(2),VFRS(3),o[3],0,0,0), C1,6); \
    VRF(3,15); GAPB(o[0]=__builtin_amdgcn_mfma_f32_32x32x16_bf16(PAF(3),VFRS(0),o[0],0,0,0), C1,8); \
    GAPB(o[1]=__builtin_amdgcn_mfma_f32_32x32x16_bf16(PAF(3),VFRS(1),o[1],0,0,0), C1,10); \
    GAPB(o[2]=__builtin_amdgcn_mfma_f32_32x32x16_bf16(PAF(3),VFRS(2),o[2],0,0,0), C1,12); \
    GAPB(o[3]=__builtin_amdgcn_mfma_f32_32x32x16_bf16(PAF(3),VFRS(3),o[3],0,0,0), C1,14); \
    }while(0)
  int t=1;
  #undef CMASK
  #define CMASK(P0,P1,t) do{}while(0)
  for(;t+7<NT;t+=2){
    STEP(pB0,pB1,pA0,pA1,t,true,true,true);     WAIT_BAR(3); RESC(); ROT();
    STEP(pA0,pA1,pB0,pB1,t+1,true,true,true);   WAIT_BAR(3); RESC(); ROT();
  }
  #undef CMASK
  #define CMASK(P0,P1,t) do{ CBIAS(P0,P1,t); int jb_=(t)-(NT-4); if(jb_>=0)cmask(P0,P1,jb_,qrel,hi);}while(0)
  #define ENDW(tt) do{ if((tt)+3<NT){WAIT_BAR(3);} else if((tt)+2<NT){WAIT_BAR(2);} else {WAIT_BAR(0);} }while(0)
  for(;t+1<NT;t+=2){
    STEP(pB0,pB1,pA0,pA1,t,(t+3<NT),(t+1<NT),(t+1<NT));       ENDW(t);   RESC(); ROT();
    STEP(pA0,pA1,pB0,pB1,t+1,(t+4<NT),(t+2<NT),(t+2<NT));     ENDW(t+1); RESC(); ROT();
  }
  STEP(pB0,pB1,pA0,pA1,NT-1,false,false,false); RESC();
  { float sacc=pB0[0]+pB0[1]; _Pragma("unroll") for(int r=2;r<16;++r)sacc+=pB0[r]; _Pragma("unroll") for(int r=0;r<16;++r)sacc+=pB1[r]; l_reg+=sacc;
    pw0=(u32x4){PKW(pB0,0),PKW(pB0,2),PKW(pB0,4),PKW(pB0,6)};pw1=(u32x4){PKW(pB0,8),PKW(pB0,10),PKW(pB0,12),PKW(pB0,14)};pw2=(u32x4){PKW(pB1,0),PKW(pB1,2),PKW(pB1,4),PKW(pB1,6)};pw3=(u32x4){PKW(pB1,8),PKW(pB1,10),PKW(pB1,12),PKW(pB1,14)};
    SBAR(); pv(o,vb0+2*sl_cur,PAF(0),PAF(1),PAF(2),PAF(3)); }
  #undef PKW
  #undef PAF
  #undef VFRS
  #undef PIN
  #undef MX3
  #undef GAPA
  #undef GAPB
  #undef EX
  #undef VRF
  #undef KRD
  #undef STEP
  #undef ENDW
  {auto rr=__builtin_amdgcn_permlane32_swap(__float_as_uint(l_reg),__float_as_uint(l_reg),false,false);l_reg=__uint_as_float(rr[0])+__uint_as_float(rr[1]);}
  if(hi==0)wsf[32+r32]=l_reg;asm volatile("s_waitcnt lgkmcnt(0)":::"memory");
  float rli[16];
  #pragma unroll
  for(int r=0;r<16;++r)rli[r]=__builtin_amdgcn_rcpf(wsf[32+crow(r,hi)]);
  bf16*Ow=Oc+(long)(wid*QBLK)*OPITCH;
  { bf16*stg=(bf16*)(shm+LDS_OST)+wid*4096;
    #pragma unroll
    for(int r=0;r<16;++r){const int orow=crow(r,hi);
      #pragma unroll
      for(int d0=0;d0<4;++d0)stg[orow*128+d0*32+r32]=__float2bfloat16(o[d0][r]*rli[r]);}
    asm volatile("s_waitcnt lgkmcnt(0)":::"memory");
    #pragma unroll
    for(int i=0;i<8;++i){const int row=i*4+(lane>>4),ch=lane&15; const u32x4 v=*(const u32x4*)(stg+row*128+ch*8); ATTN_STORE16(Ow+(long)row*OPITCH+ch*8,v);} }
  asm volatile("s_waitcnt lgkmcnt(0)\n\ts_barrier":::"memory");
  #undef DMA_K
  #undef DMA_V
  #undef CMASK
  #undef CBIAS
  #undef START
  #undef RESC
  #undef ROT
}
constexpr int ATTN_LDS_BYTES=LDS_BYTES;
#undef SBAR
#undef WAIT_BAR
}

namespace topk {
typedef short bf16x8 __attribute__((ext_vector_type(8)));
typedef float f32x16 __attribute__((ext_vector_type(16)));
#define TK_WL4(wa_, wb_, a0_, a1_, b0_, b1_, j0) asm volatile("s_nop 3\n\tv_writelane_b32 %0, %2, %6\n\tv_writelane_b32 %0, %3, %7\n\tv_writelane_b32 %1, %4, %6\n\tv_writelane_b32 %1, %5, %7" : "+v"(wa_), "+v"(wb_) : "s"(a0_), "s"(a1_), "s"(b0_), "s"(b1_), "n"(j0), "n"((j0) + 1))
__device__ __forceinline__ unsigned fkey(float f) { const unsigned u = __float_as_uint(f); return (u & 0x80000000u) ? ~u : (u | 0x80000000u); }
template <int CTRL> __device__ __forceinline__ unsigned dpp_u(unsigned v) { return (unsigned)__builtin_amdgcn_update_dpp(0, (int)v, CTRL, 0xF, 0xF, true); }
__device__ __forceinline__ unsigned wsum_u(unsigned v) {
    v += dpp_u<0xB1>(v); v += dpp_u<0x4E>(v); v += dpp_u<0x141>(v); v += dpp_u<0x140>(v);
    auto r = __builtin_amdgcn_permlane16_swap(v, v, false, false); v = r[0] + r[1];
    auto r2 = __builtin_amdgcn_permlane32_swap(v, v, false, false); return r2[0] + r2[1];
}
__device__ __forceinline__ void unit(const bf16* __restrict__ qq, const bf16* __restrict__ ki, const float* __restrict__ wi, unsigned* __restrict__ sel, int b, int t0, LAS unsigned* keys, int wave, int lane) {
    if (t0 + 15 < TOPK) {
#pragma unroll
        for (int q = 0; q < 2; ++q) { const int t = t0 + 2 * wave + q, lo = 32 * lane; unsigned w = 0u; if (lo + 31 <= t) w = 0xffffffffu; else if (lo <= t) w = (2u << (t - lo)) - 1u;
            sel[((size_t)b * L + t) * 64 + lane] = w; }
        return;
    }
    const int jd = (t0 + 15) >> 5;
#ifndef TK_REP_SCORE
#define TK_REP_SCORE 1
#endif
#ifndef TK_REP_SEL
#define TK_REP_SEL 1
#endif
    for (int rs_ = 0; rs_ < TK_REP_SCORE; ++rs_) {
        const int c = lane & 31, hf = lane >> 5;
        const int qa = ((c >> 4) << 1) | ((c >> 2) & 1), ha = (c & 3) | (((c >> 3) & 1) << 2);
        bf16x8 af[4][4]; float wA[4][8], wB[4][8];
#pragma unroll
        for (int rg = 0; rg < 4; ++rg) {
            const bf16* ap = qq + ((size_t)b * L + t0 + 4 * rg + qa) * NQQ + ha * 64 + 32 * hf;
#pragma unroll
            for (int s = 0; s < 4; ++s) af[rg][s] = *(const bf16x8*)(ap + 8 * s);
            const f32x4* wp = (const f32x4*)(wi + ((size_t)b * L + t0 + 4 * rg + hf) * 8); const f32x4 w0 = wp[0], w1 = wp[1], w2 = wp[4], w3 = wp[5];
#pragma unroll
            for (int k = 0; k < 4; ++k) { wA[rg][k] = w0[k]; wA[rg][4 + k] = w1[k]; wB[rg][k] = w2[k]; wB[rg][4 + k] = w3[k]; }
        }
        const bf16* kp = ki + ((size_t)b * L + c) * 64 + 32 * hf;
        bf16x8 bn[4];
        if (wave <= jd) {
#pragma unroll
            for (int s = 0; s < 4; ++s) bn[s] = *(const bf16x8*)(kp + (size_t)wave * 32 * 64 + 8 * s);
        }
        for (int j = wave; j <= jd; j += 8) {
            bf16x8 bc[4];
#pragma unroll
            for (int s = 0; s < 4; ++s) bc[s] = bn[s];
            if (j + 8 <= jd) {
#pragma unroll
                for (int s = 0; s < 4; ++s) bn[s] = *(const bf16x8*)(kp + (size_t)(j + 8) * 32 * 64 + 8 * s);
            }
            const int key = 32 * j + c;
#pragma unroll
            for (int rg = 0; rg < 4; ++rg) {
                f32x16 acc = {};
#pragma unroll
                for (int s = 0; s < 4; ++s) acc = __builtin_amdgcn_mfma_f32_32x32x16_bf16(af[rg][s], bc[s], acc, 0, 0, 0);
                float sa = 0.f, sb = 0.f;
#pragma unroll
                for (int h = 0; h < 8; ++h) { sa += wA[rg][h] * __builtin_amdgcn_fmed3f(acc[h], 0.f, __builtin_inff()); sb += wB[rg][h] * __builtin_amdgcn_fmed3f(acc[8 + h], 0.f, __builtin_inff()); }
                const int tA = t0 + 4 * rg + hf, tB = tA + 2;
                LAS unsigned* kA = keys + (4 * rg + hf) * 2048 + key;
                kA[0] = key > tA ? 0u : fkey(sa); kA[2 * 2048] = key > tB ? 0u : fkey(sb);
            }
        }
    }
    __syncthreads();
    for (int rs_ = 0; rs_ < TK_REP_SEL; ++rs_) {
        const int nvalid = 32 * (jd + 1);
        unsigned kA[32], kB[32];
        const LAS unsigned* pa = keys + (2 * wave) * 2048 + lane; const LAS unsigned* pb = pa + 2048;
#pragma unroll
        for (int i = 0; i < 32; ++i) { const bool ok = 64 * i + lane < nvalid; kA[i] = ok ? pa[64 * i] : 0u; kB[i] = ok ? pb[64 * i] : 0u; }
        const int ilim = (nvalid + 63) >> 6;
        unsigned pA = 0u, pB = 0u; bool doneA = false, doneB = false;
        for (int bit = 31; bit >= 0; --bit) {
            const unsigned cA = pA | (1u << bit), cB = pB | (1u << bit); unsigned cnt = 0u;
#pragma unroll
            for (int g4 = 0; g4 < 8; ++g4) { if (4 * g4 < ilim) {
#pragma unroll
                for (int i = 4 * g4; i < 4 * g4 + 4; ++i) { cnt += (kA[i] >= cA) ? 1u : 0u; cnt += (kB[i] >= cB) ? 0x10000u : 0u; } __builtin_amdgcn_sched_barrier(0); } }
            cnt = wsum_u(cnt);
            const unsigned nA = cnt & 0xffffu, nB = cnt >> 16;
            if (!doneA && nA >= (unsigned)TOPK) pA = cA;
            if (!doneB && nB >= (unsigned)TOPK) pB = cB;
            doneA = doneA || nA == (unsigned)TOPK; doneB = doneB || nB == (unsigned)TOPK;
            if (doneA && doneB) break;
        }
        unsigned cge = 0u, cgt = 0u;
#pragma unroll
        for (int i = 0; i < 32; ++i) { cge += (kA[i] >= pA) ? 1u : 0u; cge += (kB[i] >= pB) ? 0x10000u : 0u; cgt += (kA[i] > pA) ? 1u : 0u; cgt += (kB[i] > pB) ? 0x10000u : 0u; if ((i & 3) == 3) __builtin_amdgcn_sched_barrier(0); }
        cge = wsum_u(cge); cgt = wsum_u(cgt);
        asm volatile("" : "+v"(pA), "+v"(pB));
        const bool tie = (cge & 0xffffu) != (unsigned)TOPK || (cge >> 16) != (unsigned)TOPK;
        unsigned wa = 0u, wb = 0u;
        if (!tie) {
#pragma unroll
            for (int i = 0; i < 32; ++i) {
                const unsigned long long mA = __builtin_amdgcn_ballot_w64(kA[i] >= pA), mB = __builtin_amdgcn_ballot_w64(kB[i] >= pB);
                const unsigned a0 = (unsigned)mA, a1 = (unsigned)(mA >> 32), b0 = (unsigned)mB, b1 = (unsigned)(mB >> 32);
                TK_WL4(wa, wb, a0, a1, b0, b1, 2 * i); __builtin_amdgcn_sched_barrier(0);
            }
        } else {
            const unsigned needA = (unsigned)TOPK - (cgt & 0xffffu), needB = (unsigned)TOPK - (cgt >> 16); unsigned runA = 0u, runB = 0u;
            const unsigned long long below = (1ull << lane) - 1ull;
#pragma unroll
            for (int i = 0; i < 32; ++i) {
                const unsigned long long eA = __builtin_amdgcn_ballot_w64(kA[i] == pA), eB = __builtin_amdgcn_ballot_w64(kB[i] == pB);
                const bool tkA = kA[i] > pA || (kA[i] == pA && runA + (unsigned)__builtin_popcountll(eA & below) < needA);
                const bool tkB = kB[i] > pB || (kB[i] == pB && runB + (unsigned)__builtin_popcountll(eB & below) < needB);
                runA += (unsigned)__builtin_popcountll(eA); runB += (unsigned)__builtin_popcountll(eB);
                const unsigned long long mA = __builtin_amdgcn_ballot_w64(tkA), mB = __builtin_amdgcn_ballot_w64(tkB);
                const unsigned a0 = (unsigned)mA, a1 = (unsigned)(mA >> 32), b0 = (unsigned)mB, b1 = (unsigned)(mB >> 32);
                TK_WL4(wa, wb, a0, a1, b0, b1, 2 * i); __builtin_amdgcn_sched_barrier(0);
            }
        }
        unsigned* so = sel + ((size_t)b * L + t0 + 2 * wave) * 64 + lane;
        so[0] = wa; so[64] = wb;
    }
    __syncthreads();
}
#undef TK_WL4
}

namespace sparse {
typedef short bf16x8 __attribute__((ext_vector_type(8)));
typedef short s16x4 __attribute__((ext_vector_type(4)));
typedef float f32x4 __attribute__((ext_vector_type(4)));
typedef int i32x4 __attribute__((ext_vector_type(4)));
typedef unsigned u32x4 __attribute__((ext_vector_type(4)));
typedef __attribute__((address_space(3))) const char* lds_cptr;
typedef short v4i16_t __attribute__((ext_vector_type(4)));
constexpr int BUF = 8192, LIST = 1024, WAVE_LDS = 2 * BUF + 2 * LIST, BT_OFF = 8 * WAVE_LDS, LDS_NEED = BT_OFF + 8192;
__device__ __forceinline__ int fsw(int r) { return ((((r & 7) ^ ((r >> 3) << 2))) << 1) | (r >> 3); }
__device__ __forceinline__ void glds16(const void* gsrc, unsigned lds_dst) { unsigned keep;
    asm volatile("s_mov_b32 %0, m0\n\ts_mov_b32 m0, %2\n\ts_nop 0\n\tglobal_load_lds_dwordx4 %1, off\n\ts_mov_b32 m0, %0" : "=&s"(keep) : "v"(gsrc), "s"(lds_dst) : "memory"); }
__device__ __forceinline__ s16x4 vtr(lds_cptr p) { return __builtin_bit_cast(s16x4, __builtin_amdgcn_ds_read_tr16_b64_v4i16((__attribute__((address_space(3))) v4i16_t*)p)); }
__device__ __forceinline__ float xmax16(float v) { auto r = __builtin_amdgcn_permlane16_swap(__float_as_uint(v), __float_as_uint(v), false, false); return fmaxf(__uint_as_float(r[0]), __uint_as_float(r[1])); }
__device__ __forceinline__ float xmax32(float v) { auto r = __builtin_amdgcn_permlane32_swap(__float_as_uint(v), __float_as_uint(v), false, false); return fmaxf(__uint_as_float(r[0]), __uint_as_float(r[1])); }
__device__ __forceinline__ unsigned cvtpk(float lo, float hi) { typedef float f2 __attribute__((ext_vector_type(2))); typedef __bf16 b2 __attribute__((ext_vector_type(2))); f2 v = {lo, hi}; b2 b = __builtin_convertvector(v, b2); return __builtin_bit_cast(unsigned, b); }
template <int CTRL> __device__ __forceinline__ int dpp_i(int v) { return __builtin_amdgcn_update_dpp(0, v, CTRL, 0xF, 0xF, true); }

__device__ __forceinline__ int expand(unsigned word, int t, unsigned* list, int lane) {
    const int cntl = __builtin_popcount(word);
    int v = cntl;
    v += __builtin_amdgcn_update_dpp(0, v, 0x111, 0xF, 0xF, true);
    v += __builtin_amdgcn_update_dpp(0, v, 0x112, 0xF, 0xF, true);
    v += __builtin_amdgcn_update_dpp(0, v, 0x114, 0xF, 0xF, true);
    v += __builtin_amdgcn_update_dpp(0, v, 0x118, 0xF, 0xF, true);
    v += __builtin_amdgcn_update_dpp(0, v, 0x142, 0xA, 0xF, true);
    v += __builtin_amdgcn_update_dpp(0, v, 0x143, 0xC, 0xF, true);
    const int total = __builtin_amdgcn_readlane(v, 63);
    int slot = v - cntl; unsigned w = word;
    const int maxc = total;
    while (__builtin_amdgcn_ballot_w64(w != 0u) != 0ull) {
        if (w != 0u) { const int bpos = __builtin_ctz(w); w &= w - 1u; const int key = 32 * lane + bpos;
            if (slot < 256) { int d = t - key; d = d > 127 ? 127 : d; list[slot] = ((unsigned)key << 8) | ((unsigned)d << 24); }
            ++slot; }
    }
    (void)maxc;
    { const int s = total + (lane & 31); if (lane < 32 && s < 256) list[s] = 0u; }
    return total < 256 ? total : 256;
}

__device__ __forceinline__ void stream(const bf16* __restrict__ qq, const bf16* __restrict__ ckv, const unsigned* __restrict__ sel, bf16* __restrict__ olat, int q0, int nq, char* wl, const float* btl, int lane) {
    const int hd = lane & 15, quad = lane >> 4;
    const unsigned lds0 = (unsigned)(uintptr_t)wl; const lds_cptr wl3 = (lds_cptr)wl;
    unsigned* lists = (unsigned*)(wl + 2 * BUF);
    const int fk = fsw(hd);
    const int qp_ = hd >> 2, pp_ = hd & 3, rv = 4 * quad + qp_, fv = fsw(rv);
    int swz[4];
#pragma unroll
    for (int i = 0; i < 4; ++i) swz[i] = 16 * (hd ^ fsw(4 * i + quad));
    const lds_cptr btl3 = (lds_cptr)(const char*)btl + 4 * hd;
#define SP_DMA(gb, li, ch, bufoff) do { const unsigned* l_ = lists + (li) * 256 + 32 * (ch) + quad; _Pragma("unroll") for (int i_ = 0; i_ < 8; ++i_) { \
        glds16((const char*)(gb) + ((l_[4 * i_] & 0xffffffu) + (unsigned)swz[i_ & 3]), (unsigned)__builtin_amdgcn_readfirstlane(lds0 + (bufoff) + 1024 * i_)); } } while (0)
#define SP_LOADQ(dst, row) do { const bf16* qp__ = qq + (size_t)(row) * NQQ + 512 + hd * 128 + 8 * quad; _Pragma("unroll") for (int s_ = 0; s_ < 4; ++s_) dst[s_] = *(const bf16x8*)(qp__ + 32 * s_); } while (0)
    bf16x8 qf[4], qfn[4]; unsigned wnext = 0u; int ncur, nnext = 0, li = 0, bufsel = 0;
    {
        SP_LOADQ(qf, q0);
        const unsigned w0 = sel[(size_t)q0 * 64 + lane];
        if (nq > 1) wnext = sel[(size_t)(q0 + 1) * 64 + lane];
        ncur = expand(w0, q0 % L, lists, lane);
        asm volatile("s_waitcnt lgkmcnt(0)" ::: "memory");
        SP_DMA(ckv + (size_t)(q0 / L) * L * 128, 0, 0, 0);
    }
    for (int qi = 0; qi < nq; ++qi) {
        const int row = q0 + qi, b = row / L, t = row % L, nch = (ncur + 31) >> 5;
        if (qi + 1 < nq) {
            nnext = expand(wnext, (row + 1) % L, lists + (li ^ 1) * 256, lane);
            SP_LOADQ(qfn, row + 1);
            if (qi + 2 < nq) wnext = sel[(size_t)(row + 2) * 64 + lane];
            asm volatile("s_waitcnt lgkmcnt(0)" ::: "memory");
        }
        f32x4 o[8];
#pragma unroll
        for (int rb = 0; rb < 8; ++rb) o[rb] = (f32x4){0.f, 0.f, 0.f, 0.f};
        float mref = -INFINITY, lsum = 0.f;
        const unsigned* dl = lists + li * 256 + 4 * quad;
        for (int ch = 0; ch < nch; ++ch) {
            const int bo = bufsel * BUF;
            if (ch + 1 < nch) { SP_DMA(ckv + (size_t)b * L * 128, li, ch + 1, BUF - bo); asm volatile("s_waitcnt vmcnt(8)" ::: "memory"); }
            else if (qi + 1 < nq) { SP_DMA(ckv + (size_t)((row + 1) / L) * L * 128, li ^ 1, 0, BUF - bo); asm volatile("s_waitcnt vmcnt(8)" ::: "memory"); }
            else asm volatile("s_waitcnt vmcnt(0)" ::: "memory");
            f32x4 sc[2];
#pragma unroll
            for (int T = 0; T < 2; ++T) { f32x4 acc = {0.f, 0.f, 0.f, 0.f}; const lds_cptr kr = wl3 + bo + 256 * (16 * T + hd);
#pragma unroll
                for (int s = 0; s < 4; ++s) { const bf16x8 kf = *(const __attribute__((address_space(3))) bf16x8*)(kr + 16 * ((4 * s + quad) ^ fk));
                    acc = __builtin_amdgcn_mfma_f32_16x16x32_bf16(kf, qf[s], acc, 0, 0, 0); }
                sc[T] = acc; }
#pragma unroll
            for (int T = 0; T < 2; ++T) { const u32x4 dx = *(const u32x4*)(dl + 32 * ch + 16 * T);
#pragma unroll
                for (int r = 0; r < 4; ++r) sc[T][r] += *(const __attribute__((address_space(3))) float*)(btl3 + ((dx[r] >> 18) & 0x3fc0u)); }
            if (ch == nch - 1 && (ncur & 31)) {
#pragma unroll
                for (int T = 0; T < 2; ++T)
#pragma unroll
                    for (int r = 0; r < 4; ++r) if (32 * ch + 16 * T + 4 * quad + r >= ncur) sc[T][r] = -INFINITY;
            }
            float mloc = fmaxf(fmaxf(fmaxf(sc[0][0], sc[0][1]), fmaxf(sc[0][2], sc[0][3])), fmaxf(fmaxf(sc[1][0], sc[1][1]), fmaxf(sc[1][2], sc[1][3])));
            mloc = xmax32(xmax16(mloc));
            if (__builtin_amdgcn_ballot_w64(mloc > mref + 8.f) != 0ull) {
                const float mn = fmaxf(mref, mloc), f = __builtin_amdgcn_exp2f(mref - mn); mref = mn; lsum *= f;
#pragma unroll
                for (int rb = 0; rb < 8; ++rb) o[rb] = o[rb] * f;
            }
            float p0[4], p1[4];
#pragma unroll
            for (int r = 0; r < 4; ++r) { p0[r] = __builtin_amdgcn_exp2f(sc[0][r] - mref); p1[r] = __builtin_amdgcn_exp2f(sc[1][r] - mref); lsum += p0[r] + p1[r]; }
            const u32x4 pw = {cvtpk(p0[0], p0[1]), cvtpk(p0[2], p0[3]), cvtpk(p1[0], p1[1]), cvtpk(p1[2], p1[3])};
            const bf16x8 pb = __builtin_bit_cast(bf16x8, pw);
            const lds_cptr v0p = wl3 + bo + 256 * rv + 8 * (pp_ & 1), v1p = v0p + 256 * 16;
#pragma unroll
            for (int rb = 0; rb < 8; ++rb) { const int pos = 16 * ((2 * rb + (pp_ >> 1)) ^ fv);
                const s16x4 a0 = vtr(v0p + pos), a1 = vtr(v1p + pos);
                const bf16x8 va = {a0[0], a0[1], a0[2], a0[3], a1[0], a1[1], a1[2], a1[3]};
                o[rb] = __builtin_amdgcn_mfma_f32_16x16x32_bf16(va, pb, o[rb], 0, 0, 0); }
            bufsel ^= 1;
        }
        lsum = xsum32(xsum16(lsum));
        const float inv = __builtin_amdgcn_rcpf(lsum);
        bf16* op = olat + (size_t)row * 2048 + hd * 128 + 4 * quad;
#pragma unroll
        for (int rb = 0; rb < 8; ++rb) { typedef unsigned u32x2v __attribute__((ext_vector_type(2)));
            const u32x2v w = {cvtpk(o[rb][0] * inv, o[rb][1] * inv), cvtpk(o[rb][2] * inv, o[rb][3] * inv)};
            *(u32x2v*)(op + 16 * rb) = w; }
        li ^= 1; ncur = nnext;
#pragma unroll
        for (int s = 0; s < 4; ++s) qf[s] = qfn[s];
    }
    asm volatile("s_waitcnt lgkmcnt(0)" ::: "memory");
#undef SP_DMA
#undef SP_LOADQ
}
}

namespace topk2 {
typedef short bf16x8 __attribute__((ext_vector_type(8)));
typedef float f32x4 __attribute__((ext_vector_type(4)));
__device__ __forceinline__ unsigned fkey(float f) { const unsigned u = __float_as_uint(f); return (u & 0x80000000u) ? ~u : (u | 0x80000000u); }
__device__ __forceinline__ float relu(float v) { return __builtin_amdgcn_fmed3f(v, 0.f, __builtin_inff()); }
template <int CTRL> __device__ __forceinline__ unsigned dpp_u(unsigned v) { return (unsigned)__builtin_amdgcn_update_dpp(0, (int)v, CTRL, 0xF, 0xF, true); }
__device__ __forceinline__ unsigned half_sum(unsigned v) {
    v += dpp_u<0xB1>(v); v += dpp_u<0x4E>(v); v += dpp_u<0x141>(v); v += dpp_u<0x140>(v);
    auto r = __builtin_amdgcn_permlane16_swap(v, v, false, false); return r[0] + r[1];
}
#define TK2_WL2(w0_, w1_, a0_, a1_, j0) asm volatile("s_nop 3\n\tv_writelane_b32 %0, %2, %4\n\tv_writelane_b32 %1, %3, %4" : "+v"(w0_), "+v"(w1_) : "s"(a0_), "s"(a1_), "n"(j0))
__device__ __forceinline__ void pair(const bf16* __restrict__ qq, const bf16* __restrict__ ki, const float* __restrict__ wi, unsigned* __restrict__ sel, int b, int t0, int lane) {
    const int hd16 = lane & 15, quad = lane >> 4, hf = lane >> 5, qd1 = quad & 1;
    unsigned* so = sel + ((size_t)b * L + t0) * 64 + lane;
    if (t0 + 1 < TOPK) {
#pragma unroll
        for (int q = 0; q < 2; ++q) { const int t = t0 + q, lo = 32 * lane; unsigned w = 0u; if (lo + 31 <= t) w = 0xffffffffu; else if (lo <= t) w = (2u << (t - lo)) - 1u; so[q * 64] = w; }
        return;
    }
    bf16x8 af[2];
    { const bf16* ap = qq + ((size_t)b * L + t0 + (hd16 >> 3)) * NQQ + (hd16 & 7) * 64 + 16 * quad; af[0] = *(const bf16x8*)ap; af[1] = *(const bf16x8*)(ap + 8); }
    const f32x4 w4 = *(const f32x4*)(wi + ((size_t)b * L + t0 + hf) * 8 + 4 * qd1);
    const int tq = t0 + hf, tmax = t0 + 1;
    const bf16* kp = ki + ((size_t)b * L + hd16) * 64 + 16 * quad;
    unsigned kr[64];
    bf16x8 bb[2][4][2];
#define TK2_LOADG(g, buf) do { _Pragma("unroll") for (int tt_ = 0; tt_ < 4; ++tt_) { bb[buf][tt_][0] = *(const bf16x8*)(kp + (size_t)(4 * (g) + tt_) * 1024); bb[buf][tt_][1] = *(const bf16x8*)(kp + (size_t)(4 * (g) + tt_) * 1024 + 8); } } while (0)
#ifndef TK2_REP_SCORE
#define TK2_REP_SCORE 1
#endif
#ifndef TK2_REP_SEL
#define TK2_REP_SEL 1
#endif
    for (int rs_ = 0; rs_ < TK2_REP_SCORE; ++rs_) {
    TK2_LOADG(0, 0);
#pragma unroll
    for (int g = 0; g < 32; ++g) {
        if (64 * g <= tmax) {
            if (g + 1 < 32) { if (64 * (g + 1) <= tmax) TK2_LOADG(g + 1, (g + 1) & 1); }
#pragma unroll
            for (int pr = 0; pr < 2; ++pr) {
                f32x4 aE = {0.f, 0.f, 0.f, 0.f}, aO = {0.f, 0.f, 0.f, 0.f};
                aE = __builtin_amdgcn_mfma_f32_16x16x32_bf16(af[0], bb[g & 1][2 * pr][0], aE, 0, 0, 0); aO = __builtin_amdgcn_mfma_f32_16x16x32_bf16(af[0], bb[g & 1][2 * pr + 1][0], aO, 0, 0, 0);
                aE = __builtin_amdgcn_mfma_f32_16x16x32_bf16(af[1], bb[g & 1][2 * pr][1], aE, 0, 0, 0); aO = __builtin_amdgcn_mfma_f32_16x16x32_bf16(af[1], bb[g & 1][2 * pr + 1][1], aO, 0, 0, 0);
                float pE = w4[0] * relu(aE[0]), pO = w4[0] * relu(aO[0]);
#pragma unroll
                for (int r = 1; r < 4; ++r) { pE += w4[r] * relu(aE[r]); pO += w4[r] * relu(aO[r]); }
                pE = xsum16(pE); pO = xsum16(pO);
                const float sv = qd1 ? pO : pE;
                const int key = 32 * (2 * g + pr) + (lane & 31);
                kr[2 * g + pr] = key > tq ? 0u : fkey(sv);
            }
        } else { kr[2 * g] = 0u; kr[2 * g + 1] = 0u; }
    }
    }
#undef TK2_LOADG
    const int ilim = (tmax + 32) >> 5;
    unsigned pfx = 0u; bool done = false;
    for (int rs_ = 0; rs_ < TK2_REP_SEL; ++rs_) { pfx = 0u; done = false; asm volatile("" : "+v"(pfx));
    for (int bit = 31; bit >= 0; --bit) {
        const unsigned cand = pfx | (1u << bit); unsigned cnt = 0u;
#pragma unroll
        for (int g4 = 0; g4 < 16; ++g4) { if (4 * g4 < ilim) {
#pragma unroll
            for (int i = 4 * g4; i < 4 * g4 + 4; ++i) cnt += (kr[i] >= cand) ? 1u : 0u; } }
        cnt = half_sum(cnt);
        if (!done && cnt >= (unsigned)TOPK) pfx = cand;
        done = done || cnt == (unsigned)TOPK;
        if (__builtin_amdgcn_ballot_w64(!done) == 0ull) break;
    }
    }
    unsigned cge = 0u, cgt = 0u;
#pragma unroll
    for (int i = 0; i < 64; ++i) { cge += (kr[i] >= pfx) ? 1u : 0u; cgt += (kr[i] > pfx) ? 1u : 0u; }
    cge = half_sum(cge); cgt = half_sum(cgt);
    asm volatile("" : "+v"(pfx));
    const bool tie = __builtin_amdgcn_ballot_w64(cge != (unsigned)TOPK) != 0ull;
    unsigned w0 = 0u, w1 = 0u;
    if (!tie) {
#pragma unroll
        for (int i = 0; i < 64; ++i) { const unsigned long long m = __builtin_amdgcn_ballot_w64(kr[i] >= pfx); const unsigned m0 = (unsigned)m, m1 = (unsigned)(m >> 32);
            TK2_WL2(w0, w1, m0, m1, i); __builtin_amdgcn_sched_barrier(0); }
    } else {
        const unsigned need = (unsigned)TOPK - cgt; unsigned run = 0u; const unsigned below = (1u << (lane & 31)) - 1u;
#pragma unroll
        for (int i = 0; i < 64; ++i) { const unsigned long long e = __builtin_amdgcn_ballot_w64(kr[i] == pfx); const unsigned eh = hf ? (unsigned)(e >> 32) : (unsigned)e;
            const bool tk = kr[i] > pfx || (kr[i] == pfx && run + (unsigned)__builtin_popcount(eh & below) < need);
            run += (unsigned)__builtin_popcount(eh);
            const unsigned long long m = __builtin_amdgcn_ballot_w64(tk); const unsigned m0 = (unsigned)m, m1 = (unsigned)(m >> 32);
            TK2_WL2(w0, w1, m0, m1, i); __builtin_amdgcn_sched_barrier(0); }
    }
    so[0] = w0; so[64] = w1;
}
#undef TK2_WL2
}

constexpr int NWAVES = 8;
constexpr int RING_OFF = 0, RING_BYTES = 131072;
constexpr int LDSCTL_OFF = 162816, MISC_OFF = LDSCTL_OFF + 320;
constexpr int LDS_BYTES = 163840;
static_assert(sparse::LDS_NEED <= LDSCTL_OFF && attn2::ATTN_LDS_BYTES <= LDSCTL_OFF, "phase LDS");
enum { PH_PRO = 0, PH_PRE0, PH_INPROJ0, PH_QGEMM, PH_TOPK, PH_SPARSE, PH_UV, PH_OUT0, PH_POST0, PH_INPROJ1, PH_ATTN1, PH_OUT1, PH_FINAL, N_PHASES };

struct Args { const float* in[N_IN]; float* out; unsigned char* ws; int ph_lo, ph_hi, li, pad; };

__device__ __forceinline__ int fresh_lane(int dep = 0) { int l; asm volatile("v_mbcnt_lo_u32_b32 %0, -1, 0\n\tv_mbcnt_hi_u32_b32 %0, -1, %0 ; dep %1" : "=v"(l) : "s"(dep)); return l; }
__device__ __forceinline__ float wave_sum(float v) { return wave_sum_all(v); }
template <bool HAS_G> __device__ __forceinline__ void p0_transpose_item(const float* W, int K, int N, int Npad, const float* g, bf16* WT, LAS float* scr, int item, int lane) {
    const int nblk = Npad / 32, kb = item / nblk, nb = item % nblk, k0 = 64 * kb, n0 = 32 * nb;
    const bool ok = (n0 + (lane & 31)) < N; const int nc = ok ? n0 + (lane & 31) : N - 1;
    const float* wp = W + (size_t)(k0 + (lane >> 5)) * N + nc; float v[32];
#pragma unroll
    for (int i = 0; i < 32; ++i) v[i] = wp[(size_t)(2 * i) * N];
    if (HAS_G) {
#pragma unroll
        for (int i = 0; i < 32; ++i) v[i] *= g[k0 + 2 * i + (lane >> 5)];
    }
#pragma unroll
    for (int i = 0; i < 32; ++i) scr[(2 * i + (lane >> 5)) * 33 + (lane & 31)] = ok ? v[i] : 0.f;
    LDS_WAIT(); asm volatile("" ::: "memory");
    const int c = lane & 7;
#pragma unroll
    for (int j = 0; j < 4; ++j) { const int n = (lane >> 3) + 8 * j; const LAS float* s = scr + (8 * c) * 33 + n;
        v4u o; o.x = pk2(s[0 * 33], s[1 * 33]); o.y = pk2(s[2 * 33], s[3 * 33]); o.z = pk2(s[4 * 33], s[5 * 33]); o.w = pk2(s[6 * 33], s[7 * 33]);
        *(GAS v4u*)(WT + (size_t)(n0 + n) * K + k0 + 8 * c) = o; }
    LDS_WAIT(); asm volatile("" ::: "memory");
}
typedef const __attribute__((address_space(4))) Args CArgs;
__device__ __forceinline__ CArgs* kargs(int dep) { CArgs* p = (CArgs*)__builtin_amdgcn_kernarg_segment_ptr(); asm volatile("; kargs %1" : "+s"(p) : "s"(dep)); return p; }
__device__ __forceinline__ void p0_mod(CArgs* ap, LAS unsigned char* lds, int tid, int lane, int wave, int vcu, int G) {
    unsigned char* ws = ap->ws;
    float* mod = (float*)(ws + WS_MOD); Misc* ms = (Misc*)(ws + WS_MISC);
    if (vcu < 96) {
        LAS float* cact = (LAS float*)lds;
        LAS float* red = (LAS float*)(lds + 32768);
        const float* c = ap->in[I_C];
        for (int i = tid; i < NB * D; i += NWAVES * 64) cact[i] = siluf(c[i]);
        __syncthreads();
        const int li = vcu / 48, n = (vcu % 48) * 64 + lane; const float* mw = ap->in[I_MODW] + ((size_t)li * D + wave * 128) * 3072 + n;
        float acc[NB];
#pragma unroll
        for (int b = 0; b < NB; ++b) acc[b] = 0.f;
        for (int k0 = 0; k0 < 128; k0 += 16) { float wv[16];
#pragma unroll
            for (int k = 0; k < 16; ++k) wv[k] = mw[(size_t)(k0 + k) * 3072];
#pragma unroll
            for (int k = 0; k < 16; ++k) {
#pragma unroll
                for (int b = 0; b < NB; ++b) acc[b] += cact[b * D + wave * 128 + k0 + k] * wv[k]; } }
#pragma unroll
        for (int b = 0; b < NB; ++b) red[(wave * NB + b) * 64 + lane] = acc[b];
        __syncthreads();
        { const int b = tid >> 6; float s = 0.f;
#pragma unroll
          for (int w = 0; w < NWAVES; ++w) s += red[(w * NB + b) * 64 + lane];
          mod[((size_t)li * NB + b) * 3072 + n] = s + ap->in[I_MODB][li * 3072 + n]; }
        __syncthreads();
    }
    if (vcu == 96 && tid < 128) {
        const int t = tid;
        if (t == 0) { float s1 = 0.f, s2 = 0.f; for (int i = 0; i < 64; ++i) { s1 += ap->in[I_BLQ1][i] * ap->in[I_BLK1][i]; s2 += ap->in[I_BLQ2][i] * ap->in[I_BLK2][i]; } ms->lam = expf(s1) - expf(s2) + LAMBDA_INIT; }
        int bk; if (t < 16) bk = t; else { bk = 16 + (int)(logf((float)t / 16.f) / 2.0794415416798357f * 16.f); if (bk > 31) bk = 31; } ms->lut[t] = bk;
        for (int cix = 0; cix < 16; ++cix) ms->btab[t * 16 + cix] = ap->in[I_RELB][bk * 16 + cix];
    }
}
__device__ __forceinline__ void p0_weights(CArgs* ap, LAS unsigned char* lds, int lane, int wave, int vcu, int G) {
    unsigned char* ws = ap->ws;
    LAS float* scr = (LAS float*)(lds + RING_OFF + wave * 16384);
    const int gw = vcu * NWAVES + wave, NGW = G * NWAVES;
    bf16 *win0 = (bf16*)(ws + WS_WIN0), *wq2 = (bf16*)(ws + WS_WQ2), *wuv = (bf16*)(ws + WS_WUV), *wout0 = (bf16*)(ws + WS_WOUT0), *win1 = (bf16*)(ws + WS_WIN1), *wout1 = (bf16*)(ws + WS_WOUT1);
    constexpr int I_A = 16 * 48, I_QI = 4 * 16, I_O0 = 16 * 32, I_B = 16 * 128, I_O1 = 16 * 32, NITEMS = I_A + I_QI + I_O0 + I_B + I_O1;
    for (int it = gw; it < NITEMS; it += NGW) {
        int r = it;
        if (r < I_B) { p0_transpose_item<false>(ap->in[I_BWIN], D, B_IN, B_IN, nullptr, win1, scr, r, lane); continue; } r -= I_B;
        if (r < I_A) { p0_transpose_item<false>(ap->in[I_AWIN], D, A_IN, A_INP, nullptr, win0, scr, r, lane); continue; } r -= I_A;
        if (r < I_O0) { p0_transpose_item<false>(ap->in[I_AWOUT], D, D, D, nullptr, wout0, scr, r, lane); continue; } r -= I_O0;
        if (r < I_O1) { p0_transpose_item<false>(ap->in[I_BWOUT], D, D, D, nullptr, wout1, scr, r, lane); continue; } r -= I_O1;
        p0_transpose_item<true>(ap->in[I_AWQIDX], QR, 512, 512, ap->in[I_AQN], wq2, scr, r, lane);
    }
    for (int it = gw; it < 16 * 4 * 32; it += NGW) {
        const int h = it >> 7, kt = (it >> 5) & 3, r0 = (it & 31) * 4, k = kt * 64 + lane;
        const float* uq = ap->in[I_AWUQ] + (size_t)k * 1024 + h * 64; float av[64];
#pragma unroll
        for (int d4 = 0; d4 < 16; ++d4) { const f32x4 t4 = *(const f32x4*)(uq + 4 * d4); av[4 * d4] = t4[0]; av[4 * d4 + 1] = t4[1]; av[4 * d4 + 2] = t4[2]; av[4 * d4 + 3] = t4[3]; }
        const float gk = ap->in[I_AQN][k] * C2;
#pragma unroll
        for (int rr = 0; rr < 4; ++rr) { const int r = r0 + rr; const float* uk = ap->in[I_AWUK] + ((size_t)h * 128 + r) * 64; float s = 0.f;
#pragma unroll
            for (int d = 0; d < 64; ++d) s += av[d] * uk[d];
            wq2[(size_t)(512 + h * 128 + r) * 256 + k] = (bf16)f2bf(s * gk); }
    }
    for (int i = gw * 64 + lane; i < 1024 * 512; i += NGW * 64) {
        const int n = i >> 9, kp = i & 511, h = n >> 6, d = n & 63; float v = 0.f;
        if ((kp >> 7) == ((n & 255) >> 6)) v = ap->in[I_AWUV][((size_t)h * 128 + (kp & 127)) * 64 + d];
        wuv[i] = (bf16)f2bf(v);
    }
}
__device__ __forceinline__ void prenorm_rows(const float* x, const float* g, const float* modl, bf16* H, int gw, int NGW, int lane) {
    for (int row = gw; row < M; row += NGW) {
        const int b = row / L; const GAS f32x4* xr = (const GAS f32x4*)(x + (size_t)row * D) + lane;
        f32x4 v[4]; float s = 0.f;
#pragma unroll
        for (int j = 0; j < 4; ++j) { v[j] = xr[64 * j]; s += (v[j].x * v[j].x + v[j].y * v[j].y) + (v[j].z * v[j].z + v[j].w * v[j].w); }
        const float rs = rsqrtf(wave_sum(s) * (1.f / D) + EPS);
        const f32x4* g4 = (const f32x4*)g + lane; const f32x4* sh4 = (const f32x4*)(modl + (size_t)b * 3072) + lane; const f32x4* sc4 = sh4 + 256;
        GAS unsigned long long* o8 = (GAS unsigned long long*)(H + (size_t)row * D) + lane;
#pragma unroll
        for (int j = 0; j < 4; ++j) { const f32x4 o = v[j] * rs * g4[64 * j] * (sc4[64 * j] + 1.f) + sh4[64 * j];
            o8[64 * j] = (unsigned long long)pk2(o.x, o.y) | ((unsigned long long)pk2(o.z, o.w) << 32); }
    }
}
template <bool XIN_BF16, bool XOUT_BF16> __device__ __forceinline__ void post_rows(const void* xin, const bf16* Y, const float* postg, const float* modc, const float* pregn, const float* modn, void* xout, bf16* H, int gw, int NGW, int lane) {
    for (int row = gw; row < M; row += NGW) {
        const int b = row / L; const GAS unsigned long long* y8 = (const GAS unsigned long long*)(Y + (size_t)row * D) + lane;
        f32x4 yv[4]; float s = 0.f;
#pragma unroll
        for (int j = 0; j < 4; ++j) { const unsigned long long w = y8[64 * j]; const unsigned lo = (unsigned)w, hi = (unsigned)(w >> 32);
            yv[j].x = __uint_as_float(lo << 16); yv[j].y = __uint_as_float(lo & 0xffff0000u); yv[j].z = __uint_as_float(hi << 16); yv[j].w = __uint_as_float(hi & 0xffff0000u);
            s += (yv[j].x * yv[j].x + yv[j].y * yv[j].y) + (yv[j].z * yv[j].z + yv[j].w * yv[j].w); }
        const float rs = rsqrtf(wave_sum(s) * (1.f / D) + EPS);
        const GAS f32x4* xr = (const GAS f32x4*)((const float*)xin + (size_t)row * D) + lane; GAS f32x4* xo = (GAS f32x4*)((float*)xout + (size_t)row * D) + lane;
        const GAS unsigned long long* xrb = (const GAS unsigned long long*)((const bf16*)xin + (size_t)row * D) + lane; GAS unsigned long long* xob = (GAS unsigned long long*)((bf16*)xout + (size_t)row * D) + lane;
        const f32x4* pg4 = (const f32x4*)postg + lane; const f32x4* rg4 = (const f32x4*)(modc + (size_t)b * 3072 + 2048) + lane;
        f32x4 x1[4]; float s2 = 0.f;
#pragma unroll
        for (int j = 0; j < 4; ++j) { f32x4 xi;
            if (XIN_BF16) { const unsigned long long w = xrb[64 * j]; const unsigned lo = (unsigned)w, hi = (unsigned)(w >> 32); xi.x = __uint_as_float(lo << 16); xi.y = __uint_as_float(lo & 0xffff0000u); xi.z = __uint_as_float(hi << 16); xi.w = __uint_as_float(hi & 0xffff0000u); }
            else xi = xr[64 * j];
            x1[j] = xi + rg4[64 * j] * (yv[j] * rs * pg4[64 * j]);
            if (XOUT_BF16) xob[64 * j] = (unsigned long long)pk2(x1[j].x, x1[j].y) | ((unsigned long long)pk2(x1[j].z, x1[j].w) << 32); else xo[64 * j] = x1[j];
            s2 += (x1[j].x * x1[j].x + x1[j].y * x1[j].y) + (x1[j].z * x1[j].z + x1[j].w * x1[j].w); }
        if (H) { const float r2 = rsqrtf(wave_sum(s2) * (1.f / D) + EPS);
            const f32x4* g4 = (const f32x4*)pregn + lane; const f32x4* sh4 = (const f32x4*)(modn + (size_t)b * 3072) + lane; const f32x4* sc4 = sh4 + 256;
            GAS unsigned long long* o8 = (GAS unsigned long long*)(H + (size_t)row * D) + lane;
#pragma unroll
            for (int j = 0; j < 4; ++j) { const f32x4 o = x1[j] * r2 * g4[64 * j] * (sc4[64 * j] + 1.f) + sh4[64 * j];
                o8[64 * j] = (unsigned long long)pk2(o.x, o.y) | ((unsigned long long)pk2(o.z, o.w) << 32); } }
    }
}
__device__ __forceinline__ void norm_kv_rows(const bf16* proj0, const float* stats, const float* kvg, const float* kig, bf16* ckv, bf16* ki, float* wi, int gw, int NGW, int lane) {
    for (int row = gw; row < M; row += NGW) {
        const float* st = stats + (size_t)row * 16; const bf16* p = proj0 + (size_t)row * A_INP;
        const float rkv = rsqrtf(((st[4] + st[5]) + (st[6] + st[7])) * (1.f / 128.f) + EPS), rki = rsqrtf((st[8] + st[9]) * (1.f / 64.f) + EPS);
        const unsigned w = *(const unsigned*)(p + 256 + 2 * lane);
        const float a0 = __uint_as_float(w << 16) * rkv * kvg[2 * lane], a1 = __uint_as_float(w & 0xffff0000u) * rkv * kvg[2 * lane + 1];
        *(unsigned*)(ckv + (size_t)row * 128 + 2 * lane) = pk2(a0, a1);
        ki[(size_t)row * 64 + lane] = (bf16)f2bf(bf2f(p[384 + lane]) * rki * kig[lane]);
        if (lane < 8) wi[(size_t)row * 8 + lane] = bf2f(p[448 + lane]) * (0.35355339059327373f * 0.125f);
    }
}

__global__ void __launch_bounds__(NWAVES * 64, 2) mk_fwd(Args args) {
    extern __shared__ __attribute__((aligned(16))) unsigned char lds_raw[];
    LAS unsigned char* lds = (LAS unsigned char*)lds_raw;
    const int wave = __builtin_amdgcn_readfirstlane(threadIdx.x >> 6);
    const int G = gridDim.x; const int bx = blockIdx.x; const int vcu = (G % 8 == 0) ? (bx % 8) * (G / 8) + bx / 8 : bx;
    for (int u = wave * 64 + lane_now(0); u < (LDS_BYTES - LDSCTL_OFF) / 4; u += NWAVES * 64) ((LAS unsigned*)(lds + LDSCTL_OFF))[u] = 0u;
    __syncthreads();
    XcdBarrier bar = xcd_barrier_post((unsigned*)((gu32*)(args.ws + WS_CTL) + CW_BAR) + args.li * XCD_BAR_WORDS, (volatile LAS unsigned*)(lds + MISC_OFF) + 8, wave);
    const int lo = args.ph_lo, hi = args.ph_hi;
#define IN(k) (lo <= (k) && (k) < hi)
#ifndef REP_PHASE
#define REP_PHASE (-1)
#endif
#define PHASE_BEGIN(k) if (IN(k)) { for (int rep_ = 0; rep_ < ((k) == REP_PHASE ? 2 : 1); ++rep_) { if (rep_) xcd_barrier(bar);
#define PHASE_END(k) } } SEAM(k);
#define SEAM(k) do { if (IN(k) && IN((k) + 1)) xcd_barrier(bar); } while (0)
    const int gw = vcu * NWAVES + wave, NGW = G * NWAVES;

    PHASE_BEGIN(PH_PRO) const int lane = fresh_lane(); p0_mod(kargs(PH_PRO), lds, wave * 64 + lane, lane, wave, vcu, G); PHASE_END(PH_PRO)
    PHASE_BEGIN(PH_PRE0) CArgs* A = kargs(PH_PRE0); unsigned char* ws = A->ws; prenorm_rows(A->in[I_X], A->in[I_PREG], (const float*)(ws + WS_MOD), (bf16*)(ws + WS_H), gw, NGW, fresh_lane());
#ifndef REP_W
#define REP_W 1
#endif
        for (int rw_ = 0; rw_ < REP_W; ++rw_) p0_weights(A, lds, fresh_lane(1 + rw_), wave, vcu, G); PHASE_END(PH_PRE0)
    PHASE_BEGIN(PH_INPROJ0)
        CArgs* A = kargs(PH_INPROJ0); unsigned char* ws = A->ws;
        pg8::Gemm g{(const bf16*)(ws + WS_H), (const bf16*)(ws + WS_WIN0), M, A_INP, D, D, D, 0}; pg8::StaticOrder S; S.init(M, A_INP, G, bx);
        pg8::Epi<pg8::EM_PROJ0> E{(bf16*)(ws + WS_PROJ0), A_INP, (float*)(ws + WS_STATS), nullptr, 0};
        pg8::gemm_phase<pg8::Epi<pg8::EM_PROJ0>, pg8::StaticOrder, true, true>(lds + RING_OFF, g, S, E, wave);
    PHASE_END(PH_INPROJ0)
    PHASE_BEGIN(PH_QGEMM)
        CArgs* A = kargs(PH_QGEMM); unsigned char* ws = A->ws;
        pg8::Gemm g{(const bf16*)(ws + WS_PROJ0), (const bf16*)(ws + WS_WQ2), M, NQQ, QR, A_INP, QR, 0}; pg8::StaticOrder S; S.init(M, NQQ, G, bx);
        pg8::Epi<pg8::EM_ROWSCALE> E{(bf16*)(ws + WS_QQ), NQQ, (float*)(ws + WS_STATS), nullptr, 0};
        pg8::gemm_phase<pg8::Epi<pg8::EM_ROWSCALE>, pg8::StaticOrder, true, true>(lds + RING_OFF, g, S, E, wave);
        norm_kv_rows((const bf16*)(ws + WS_PROJ0), (const float*)(ws + WS_STATS), A->in[I_AKVN], A->in[I_AKIN], (bf16*)(ws + WS_CKV), (bf16*)(ws + WS_KI), (float*)(ws + WS_WI), gw, NGW, fresh_lane());
    PHASE_END(PH_QGEMM)
    PHASE_BEGIN(PH_TOPK)
        CArgs* A = kargs(PH_TOPK); unsigned char* ws = A->ws;
        unsigned* sel = (unsigned*)(ws + WS_SEL); const int lane = fresh_lane();
        const bf16* qq = (const bf16*)(ws + WS_QQ); const bf16* ki = (const bf16*)(ws + WS_KI); const float* wi = (const float*)(ws + WS_WI);
        for (int p = vcu; p < NB * 64; p += G) {
            const int b = p >> 6, u = p & 63;
            for (int r2 = 0; r2 < 2; ++r2) topk::unit(qq, ki, wi, sel, b, 16 * (r2 ? 127 - u : u), (LAS unsigned*)(lds + RING_OFF), wave, lane);
        }
    PHASE_END(PH_TOPK)
    PHASE_BEGIN(PH_SPARSE)
        CArgs* A = kargs(PH_SPARSE); unsigned char* ws = A->ws; const Misc* ms = (const Misc*)(ws + WS_MISC);
        const int lane = fresh_lane(); float* btl = (float*)((char*)lds_raw + sparse::BT_OFF);
        for (int i = wave * 64 + lane; i < 128 * 16; i += NWAVES * 64) btl[i] = ms->btab[i] * LOG2E;
        __syncthreads();
        const int per = (M + NGW - 1) / NGW;
        const int q0 = gw * per, nq = q0 >= M ? 0 : (q0 + per <= M ? per : M - q0);
        if (nq > 0) sparse::stream((const bf16*)(ws + WS_QQ), (const bf16*)(ws + WS_CKV), (const unsigned*)(ws + WS_SEL), (bf16*)(ws + WS_OLAT), q0, nq, (char*)lds_raw + wave * sparse::WAVE_LDS, btl, lane);
        __syncthreads();
    PHASE_END(PH_SPARSE)
    PHASE_BEGIN(PH_UV)
        CArgs* A = kargs(PH_UV); unsigned char* ws = A->ws;
        pg8::Gemm g{(const bf16*)(ws + WS_OLAT), (const bf16*)(ws + WS_WUV), M, D, 512, 2048, 512, 512}; pg8::StaticOrder S; S.init(M, D, G, bx);
        pg8::Epi<pg8::EM_UVGATE> E{(bf16*)(ws + WS_OG0), D, nullptr, (const bf16*)(ws + WS_PROJ0) + 456, A_INP};
        pg8::gemm_phase<pg8::Epi<pg8::EM_UVGATE>, pg8::StaticOrder, true, true>(lds + RING_OFF, g, S, E, wave);
    PHASE_END(PH_UV)
    PHASE_BEGIN(PH_OUT0)
        CArgs* A = kargs(PH_OUT0); unsigned char* ws = A->ws;
        pg8::Gemm g{(const bf16*)(ws + WS_OG0), (const bf16*)(ws + WS_WOUT0), M, D, D, D, D, 0}; pg8::StaticOrder S; S.init(M, D, G, bx);
        pg8::Epi<pg8::EM_PLAIN> E{(bf16*)(ws + WS_Y0), D, nullptr, nullptr, 0};
        pg8::gemm_phase<pg8::Epi<pg8::EM_PLAIN>, pg8::StaticOrder, true, true>(lds + RING_OFF, g, S, E, wave);
    PHASE_END(PH_OUT0)
    PHASE_BEGIN(PH_POST0) CArgs* A = kargs(PH_POST0); unsigned char* ws = A->ws; const float* mod = (const float*)(ws + WS_MOD);
        post_rows<false, true>(A->in[I_X], (const bf16*)(ws + WS_Y0), A->in[I_POSTG], mod, A->in[I_PREG] + D, mod + (size_t)NB * 3072, ws + WS_X1B, (bf16*)(ws + WS_H), gw, NGW, fresh_lane()); PHASE_END(PH_POST0)
    PHASE_BEGIN(PH_INPROJ1)
        CArgs* A = kargs(PH_INPROJ1); unsigned char* ws = A->ws;
        pg8::Gemm g{(const bf16*)(ws + WS_H), (const bf16*)(ws + WS_WIN1), M, B_IN, D, D, D, 0}; pg8::StaticOrder S; S.init(M, B_IN, G, bx);
        pg8::Epi<pg8::EM_PROJ1> E{(bf16*)(ws + WS_PROJ1), B_IN, nullptr, nullptr, 0};
        pg8::gemm_phase<pg8::Epi<pg8::EM_PROJ1>, pg8::StaticOrder, true, true>(lds + RING_OFF, g, S, E, wave);
    PHASE_END(PH_INPROJ1)
    PHASE_BEGIN(PH_ATTN1)
        CArgs* A = kargs(PH_ATTN1); unsigned char* ws = A->ws; const Misc* ms = (const Misc*)(ws + WS_MISC);
        const bf16* proj1 = (const bf16*)(ws + WS_PROJ1); bf16* og1 = (bf16*)(ws + WS_OG1); const float* subln = A->in[I_BSUBLN];
        attn_body::bf16* oscr = (attn_body::bf16*)(ws + WS_OSCR);
        const attn_body::bf16* pj = (const attn_body::bf16*)proj1;
        char* shm = (char*)lds_raw + RING_OFF;
        for (int p = vcu; p < 256; p += G) {
            const int bh = p >> 2, s4 = p & 3, b = bh >> 3, h = bh & 7;
            for (int ui = 0; ui < 2; ++ui) {
                const int qb = ui == 0 ? s4 : 7 - s4;
                attn_body::bf16* ob = oscr + (size_t)vcu * 256 * attn_body::OPITCH;
                for (int vi = 0; vi < 2; ++vi) {
                    const int mp = 2 * h + vi;
                    attn2::attn_unit<8>(wave, b, qb, (const attn2::bf16*)pj + mp * 64, (const attn2::bf16*)pj + 1024 + mp * 64, (const attn2::bf16*)pj + 2048 + h * 128, (attn2::bf16*)ob + vi * 128, ms->btab + mp, shm);
                }
                asm volatile("s_waitcnt vmcnt(0)" ::: "memory");
                const int lane2 = fresh_lane(qb);
                const int r = wave * 32 + (lane2 & 31), eh = lane2 >> 5, t = qb * 256 + r; const size_t grow = (size_t)b * L + t;
                const v4u* o1p = (const v4u*)((const bf16*)ob + (size_t)r * 256 + eh * 64); const v4u* o2p = o1p + 16;
                const float lam = ms->lam; float o[64]; float ss = 0.f;
#pragma unroll
                for (int c8 = 0; c8 < 8; ++c8) { const v4u a1 = __builtin_nontemporal_load(o1p + c8), a2 = __builtin_nontemporal_load(o2p + c8);
#pragma unroll
                    for (int q = 0; q < 4; ++q) { const float x0 = __uint_as_float(a1[q] << 16) - lam * __uint_as_float(a2[q] << 16), x1 = __uint_as_float(a1[q] & 0xffff0000u) - lam * __uint_as_float(a2[q] & 0xffff0000u);
                        o[c8 * 8 + 2 * q] = x0; o[c8 * 8 + 2 * q + 1] = x1; ss += x0 * x0 + x1 * x1; } }
                ss = xsum32(ss);
                const float rs = rsqrtf(ss * (1.f / 128.f) + EPS) * (1.f - LAMBDA_INIT);
                const v4u* gp = (const v4u*)(proj1 + grow * B_IN + 3072 + h * 128 + eh * 64); const f32x4* sl = (const f32x4*)(subln + eh * 64);
                v4u* op = (v4u*)(og1 + grow * D + h * 128 + eh * 64);
#pragma unroll
                for (int c8 = 0; c8 < 8; ++c8) { const v4u gq = gp[c8]; const f32x4 s0 = sl[2 * c8], s1 = sl[2 * c8 + 1]; v4u w;
#pragma unroll
                    for (int q = 0; q < 4; ++q) { const float g0 = __uint_as_float(gq[q] << 16), g1 = __uint_as_float(gq[q] & 0xffff0000u);
                        const float sa = q < 2 ? s0[2 * q] : s1[2 * q - 4], sb = q < 2 ? s0[2 * q + 1] : s1[2 * q - 3];
                        w[q] = pk2(o[c8 * 8 + 2 * q] * rs * sa * siluf(g0), o[c8 * 8 + 2 * q + 1] * rs * sb * siluf(g1)); }
                    op[c8] = w; }
            }
        }
    PHASE_END(PH_ATTN1)
    PHASE_BEGIN(PH_OUT1)
        CArgs* A = kargs(PH_OUT1); unsigned char* ws = A->ws;
        pg8::Gemm g{(const bf16*)(ws + WS_OG1), (const bf16*)(ws + WS_WOUT1), M, D, D, D, D, 0}; pg8::StaticOrder S; S.init(M, D, G, bx);
        pg8::Epi<pg8::EM_PLAIN> E{(bf16*)(ws + WS_Y1), D, nullptr, nullptr, 0};
        pg8::gemm_phase<pg8::Epi<pg8::EM_PLAIN>, pg8::StaticOrder, true, true>(lds + RING_OFF, g, S, E, wave);
    PHASE_END(PH_OUT1)
    PHASE_BEGIN(PH_FINAL) CArgs* A = kargs(PH_FINAL); unsigned char* ws = A->ws;
        post_rows<true, false>(ws + WS_X1B, (const bf16*)(ws + WS_Y1), A->in[I_POSTG] + D, (const float*)(ws + WS_MOD) + (size_t)NB * 3072, nullptr, nullptr, A->out, nullptr, gw, NGW, fresh_lane()); } }
#undef IN
#undef SEAM
}

__device__ __forceinline__ float block_sum(float v, float* red) {
    for (int o = 32; o > 0; o >>= 1) v += __shfl_xor(v, o);
    __syncthreads(); if ((threadIdx.x & 63) == 0) red[threadIdx.x >> 6] = v; __syncthreads();
    return red[0] + red[1] + red[2] + red[3];
}
__device__ __forceinline__ unsigned fkey(float f) { unsigned u = __float_as_uint(f); return (u & 0x80000000u) ? ~u : (u | 0x80000000u); }
__global__ void __launch_bounds__(256) k_topk(const bf16_t* qq, const bf16_t* ki, const float* wi, unsigned* sel) {
    __shared__ float qs[512]; __shared__ unsigned keys[2048]; __shared__ unsigned cnts[256]; __shared__ unsigned words[64]; __shared__ float ws[8];
    int row = blockIdx.x, b = row / L, t = row % L, tid = threadIdx.x;
    for (int i = tid; i < 512; i += 256) qs[i] = bf2f(qq[(size_t)row * NQQ + i]);
    if (tid < 8) ws[tid] = wi[(size_t)row * 8 + tid];
    if (tid < 64) words[tid] = 0u;
    __syncthreads();
    for (int s = tid; s < L; s += 256) {
        unsigned kk = 0u;
        if (s <= t) { const bf16_t* kr = ki + ((size_t)b * L + s) * 64; float a0 = 0.f, a1 = 0.f, a2 = 0.f, a3 = 0.f, a4 = 0.f, a5 = 0.f, a6 = 0.f, a7 = 0.f;
            for (int d = 0; d < 64; ++d) { float kf = bf2f(kr[d]); a0 += qs[d] * kf; a1 += qs[64 + d] * kf; a2 += qs[128 + d] * kf; a3 += qs[192 + d] * kf;
                a4 += qs[256 + d] * kf; a5 += qs[320 + d] * kf; a6 += qs[384 + d] * kf; a7 += qs[448 + d] * kf; }
            float sc = ws[0] * fmaxf(a0, 0.f); sc += ws[1] * fmaxf(a1, 0.f); sc += ws[2] * fmaxf(a2, 0.f); sc += ws[3] * fmaxf(a3, 0.f);
            sc += ws[4] * fmaxf(a4, 0.f); sc += ws[5] * fmaxf(a5, 0.f); sc += ws[6] * fmaxf(a6, 0.f); sc += ws[7] * fmaxf(a7, 0.f);
            kk = fkey(sc); }
        keys[s] = kk;
    }
    __syncthreads();
    int nvalid = t + 1;
    if (nvalid <= TOPK) { for (int s = tid; s <= t; s += 256) atomicOr(&words[s >> 5], 1u << (s & 31)); }
    else {
        unsigned prefix = 0u;
        for (int bit = 31; bit >= 0; --bit) {
            unsigned cand = prefix | (1u << bit); unsigned c = 0;
            for (int i = 0; i < 8; ++i) c += keys[tid * 8 + i] >= cand;
            cnts[tid] = c; __syncthreads();
            for (int o = 128; o > 0; o >>= 1) { if (tid < o) cnts[tid] += cnts[tid + o]; __syncthreads(); }
            unsigned tot = cnts[0]; __syncthreads();
            if (tot >= (unsigned)TOPK) prefix = cand;
        }
        unsigned cg = 0, ce = 0; for (int i = 0; i < 8; ++i) { unsigned k = keys[tid * 8 + i]; cg += k > prefix; ce += k == prefix; }
        cnts[tid] = cg; __syncthreads();
        for (int o = 128; o > 0; o >>= 1) { if (tid < o) cnts[tid] += cnts[tid + o]; __syncthreads(); }
        unsigned ngt = cnts[0]; __syncthreads();
        cnts[tid] = ce; __syncthreads();
        if (tid == 0) { unsigned run = 0; for (int i = 0; i < 256; ++i) { unsigned v = cnts[i]; cnts[i] = run; run += v; } }
        __syncthreads();
        unsigned need = TOPK - ngt, rank = cnts[tid];
        for (int i = 0; i < 8; ++i) { int s = tid * 8 + i; unsigned k = keys[s]; bool take = k > prefix; if (k == prefix) { take = rank < need; ++rank; }
            if (take) atomicOr(&words[s >> 5], 1u << (s & 31)); }
    }
    __syncthreads();
    if (tid < 64) sel[(size_t)row * 64 + tid] = words[tid];
}
__global__ void __launch_bounds__(256) k_sparse(const bf16_t* qq, const bf16_t* ckv, const unsigned* sel, const Misc* ms, bf16_t* olat) {
    __shared__ float qa[16 * 128]; __shared__ int idx[256]; __shared__ float lg[16 * 256]; __shared__ int nsel_s;
    int row = blockIdx.x, b = row / L, t = row % L, tid = threadIdx.x;
    for (int i = tid; i < 2048; i += 256) qa[i] = bf2f(qq[(size_t)row * NQQ + 512 + i]);
    if (tid == 0) { int n = 0; for (int w = 0; w < 64; ++w) { unsigned v = sel[(size_t)row * 64 + w]; while (v) { int bpos = __ffs(v) - 1; v &= v - 1; if (n < 256) idx[n] = w * 32 + bpos; ++n; } } nsel_s = n < 256 ? n : 256; }
    __syncthreads();
    int ns = nsel_s;
    for (int p = tid; p < 16 * 256; p += 256) { int h = p >> 8, k = p & 255; float v = -INFINITY;
        if (k < ns) { const bf16_t* kr = ckv + ((size_t)b * L + idx[k]) * 128; float a = 0.f; for (int r = 0; r < 128; ++r) a += qa[h * 128 + r] * bf2f(kr[r]);
            int dd = t - idx[k]; if (dd > 127) dd = 127; v = a + ms->btab[dd * 16 + h] * LOG2E; }
        lg[p] = v; }
    __syncthreads();
    if (tid < 16) { float mx = -INFINITY; for (int k = 0; k < ns; ++k) mx = fmaxf(mx, lg[tid * 256 + k]); float s = 0.f;
        for (int k = 0; k < ns; ++k) { float e = exp2f(lg[tid * 256 + k] - mx); lg[tid * 256 + k] = e; s += e; } float inv = 1.f / s; for (int k = 0; k < ns; ++k) lg[tid * 256 + k] *= inv; }
    __syncthreads();
    for (int o = tid; o < 2048; o += 256) { int h = o >> 7, r = o & 127; float a = 0.f;
        for (int k = 0; k < ns; ++k) a += lg[h * 256 + k] * bf2f(ckv[((size_t)b * L + idx[k]) * 128 + r]);
        olat[(size_t)row * 2048 + o] = f2bf(a); }
}
__global__ void __launch_bounds__(256) k_diffattn(const bf16_t* proj, const Misc* ms, const float* subln, bf16_t* og) {
    __shared__ float q[2][64]; __shared__ float p[2][2048]; __shared__ float red[4]; __shared__ float part[2][128];
    int row = blockIdx.x, h = blockIdx.y, b = row / L, t = row % L, tid = threadIdx.x;
    if (tid < 128) q[tid >> 6][tid & 63] = bf2f(proj[(size_t)row * B_IN + (2 * h + (tid >> 6)) * 64 + (tid & 63)]);
    __syncthreads();
    float mx[2] = {-INFINITY, -INFINITY};
    for (int l = tid; l <= t; l += 256) { int dd = t - l; if (dd > 127) dd = 127;
        for (int j = 0; j < 2; ++j) { const bf16_t* kr = proj + ((size_t)b * L + l) * B_IN + 1024 + (2 * h + j) * 64; float a = 0.f;
            for (int d = 0; d < 64; ++d) a += q[j][d] * bf2f(kr[d]);
            a += ms->btab[dd * 16 + 2 * h + j] * LOG2E; p[j][l] = a; mx[j] = fmaxf(mx[j], a); } }
    float sm[2];
    for (int j = 0; j < 2; ++j) { float m = mx[j]; for (int o = 32; o > 0; o >>= 1) m = fmaxf(m, __shfl_xor(m, o));
        __syncthreads(); if ((tid & 63) == 0) red[tid >> 6] = m; __syncthreads(); m = fmaxf(fmaxf(red[0], red[1]), fmaxf(red[2], red[3]));
        float s = 0.f; for (int l = tid; l <= t; l += 256) { float e = exp2f(p[j][l] - m); p[j][l] = e; s += e; }
        sm[j] = block_sum(s, red); }
    __syncthreads();
    float lam = ms->lam, i0 = 1.f / sm[0], i1 = lam / sm[1];
    int e = tid & 127, half = tid >> 7; float a = 0.f;
    for (int l = half; l <= t; l += 2) a += (p[0][l] * i0 - p[1][l] * i1) * bf2f(proj[((size_t)b * L + l) * B_IN + 2048 + h * 128 + e]);
    part[half][e] = a; __syncthreads();
    float o = part[0][e] + part[1][e];
    float ss = block_sum(half == 0 ? o * o : 0.f, red);
    if (half == 0) { float v = o * rsqrtf(ss / 128.f + EPS) * subln[e] * (1.f - LAMBDA_INIT);
        float gte = bf2f(proj[(size_t)row * B_IN + 3072 + h * 128 + e]);
        og[(size_t)row * D + h * 128 + e] = f2bf(v * siluf(gte)); }
}


extern "C" void kernel_launch(void* const* d_in, const int* in_sizes, int n_in, void* d_out, int out_size, void* d_ws, size_t ws_size, hipStream_t stream) {
    (void)in_sizes; (void)out_size; (void)ws_size;
    static int grid = 0;
    if (grid == 0) {
        int dev = 0, cus = 0;
        if (n_in != N_IN || hipGetDevice(&dev) != hipSuccess || hipDeviceGetAttribute(&cus, hipDeviceAttributeMultiprocessorCount, dev) != hipSuccess) { grid = -1; return; }
        if (hipFuncSetAttribute((const void*)mk_fwd, hipFuncAttributeMaxDynamicSharedMemorySize, LDS_BYTES) != hipSuccess) { grid = -1; return; }
        grid = cus;
    }
    if (grid < 0) return;
    char* ws = (char*)d_ws;
    hipMemsetAsync(ws + WS_CTL, 0, CTL_ZERO_BYTES, stream);
    Args a{};
    for (int i = 0; i < N_IN; ++i) a.in[i] = (const float*)d_in[i];
    a.out = (float*)d_out; a.ws = (unsigned char*)d_ws;
    int li = 0;
    auto run = [&](int lo, int hi) { a.ph_lo = lo; a.ph_hi = hi; a.li = li++; hipLaunchKernelGGL(mk_fwd, dim3(grid), dim3(NWAVES * 64), LDS_BYTES, stream, a); };
    Misc* ms = (Misc*)(ws + WS_MISC);
    bf16_t *ckv = (bf16_t*)(ws + WS_CKV), *ki = (bf16_t*)(ws + WS_KI); float* wi = (float*)(ws + WS_WI); unsigned* sel = (unsigned*)(ws + WS_SEL);
    bf16_t *qq = (bf16_t*)(ws + WS_QQ), *olat = (bf16_t*)(ws + WS_OLAT), *proj1 = (bf16_t*)(ws + WS_PROJ1), *og1 = (bf16_t*)(ws + WS_OG1);
#ifdef PROBE_PHASE
    run(PH_PRO, PROBE_PHASE + 1); run(PROBE_PHASE, PROBE_PHASE + 1); if (PROBE_PHASE + 1 < N_PHASES) run(PROBE_PHASE + 1, PH_FINAL + 1);
#else
    run(PH_PRO, PH_FINAL + 1);
#endif
}
```

```cpp
#include <hip/hip_runtime.h>
#include <stdint.h>
#include <math.h>
#include <cstdio>
#include <hip/hip_bf16.h>

constexpr int NB = 8, L = 2048, D = 1024, M = NB * L;
constexpr int A_IN = 1480, A_INP = 1536, QR = 256, TOPK = 256;
constexpr int NQQ = 512 + 2048;
constexpr int B_IN = 4096, BH = 8;
constexpr float EPS = 1e-6f;
constexpr float LOG2E = 1.4426950408889634f;
constexpr float C2 = 0.125f * LOG2E;
constexpr float LAMBDA_INIT = 0.35550906759096934f;

constexpr size_t MiB = 1u << 20;
constexpr size_t WS_CTL = 0, CTL_ZERO_BYTES = 256 * 1024;
constexpr size_t WS_MOD = 512 * 1024;
constexpr size_t WS_MISC = 768 * 1024;
constexpr size_t WS_WIN0 = 1 * MiB;
constexpr size_t WS_WQ2 = 4 * MiB;
constexpr size_t WS_WUV = 6 * MiB;
constexpr size_t WS_WOUT0 = 7 * MiB;
constexpr size_t WS_WIN1 = 9 * MiB;
constexpr size_t WS_WOUT1 = 17 * MiB;
constexpr size_t WS_STATS = 19 * MiB;
constexpr size_t WS_CKV = 20 * MiB;
constexpr size_t WS_KI = 24 * MiB;
constexpr size_t WS_WI = 26 * MiB;
constexpr size_t WS_SEL = 28 * MiB;
constexpr size_t WS_H = 32 * MiB;
constexpr size_t WS_PROJ0 = 64 * MiB;
constexpr size_t WS_QQ = 112 * MiB;
constexpr size_t WS_OLAT = 192 * MiB;
constexpr size_t WS_OG0 = 112 * MiB;
constexpr size_t WS_Y0 = 144 * MiB;
constexpr size_t WS_PROJ1 = 64 * MiB;
constexpr size_t WS_OSCR = 192 * MiB;
constexpr size_t WS_X1B = 224 * MiB;
constexpr size_t WS_OG1 = 32 * MiB;
constexpr size_t WS_Y1 = 64 * MiB;
constexpr int CW_BAR = 4096;

struct Misc { float lam; int pad[31]; int lut[128]; float btab[128 * 16]; };

enum { I_X = 0, I_C, I_RELB, I_MODW, I_MODB, I_PREG, I_POSTG, I_AWIN, I_AQN, I_AKVN, I_AKIN, I_AWUQ, I_AWQIDX, I_AWUK, I_AWUV, I_AWOUT,
       I_BWIN, I_BLQ1, I_BLK1, I_BLQ2, I_BLK2, I_BSUBLN, I_BWOUT, N_IN };

__device__ __forceinline__ float siluf(float v) { return v * __builtin_amdgcn_rcpf(1.f + __builtin_amdgcn_exp2f(-1.4426950408889634f * v)); }
__device__ __forceinline__ float bf2f(unsigned short v) { return __uint_as_float((unsigned)v << 16); }
__device__ __forceinline__ float xsum32(float v) { auto r = __builtin_amdgcn_permlane32_swap(__float_as_uint(v), __float_as_uint(v), false, false); return __uint_as_float(r[0]) + __uint_as_float(r[1]); }
__device__ __forceinline__ float xsum16(float v) { auto r = __builtin_amdgcn_permlane16_swap(__float_as_uint(v), __float_as_uint(v), false, false); return __uint_as_float(r[0]) + __uint_as_float(r[1]); }
template <int CTRL> __device__ __forceinline__ float dpp_f(float v) { return __uint_as_float((unsigned)__builtin_amdgcn_update_dpp(0, (int)__float_as_uint(v), CTRL, 0xF, 0xF, true)); }
__device__ __forceinline__ float wave_sum_all(float v) {
    v += dpp_f<0xB1>(v);
    v += dpp_f<0x4E>(v);
    v += dpp_f<0x141>(v);
    v += dpp_f<0x140>(v);
    v = xsum16(v); return xsum32(v);
}
typedef unsigned short bf16_t;
#define GAS __attribute__((address_space(1)))
#define LAS __attribute__((address_space(3)))
typedef unsigned short bf16;
typedef unsigned v4u __attribute__((ext_vector_type(4)));
typedef float f32x4 __attribute__((ext_vector_type(4)));
typedef short bf16x8 __attribute__((ext_vector_type(8)));
typedef GAS unsigned gu32;
typedef GAS unsigned long long gu64;
#define RLX_AGENT __ATOMIC_RELAXED, __HIP_MEMORY_SCOPE_AGENT
#define LDS_WAIT() asm volatile("s_waitcnt lgkmcnt(0)" ::: "memory")
#define VM_WAIT() asm volatile("s_waitcnt vmcnt(0)" ::: "memory")
__device__ __forceinline__ unsigned long long rt() { return __builtin_amdgcn_s_memrealtime(); }
__device__ __forceinline__ unsigned f2bf(float f) { unsigned u = __builtin_bit_cast(unsigned, f); return (u + 0x7fffu + ((u >> 16) & 1u)) >> 16; }
__device__ __forceinline__ unsigned pk2(float lo, float hi) { return f2bf(lo) | (f2bf(hi) << 16); }

#define XB_TMO      128
#define XB_XCNT(j)  (256  + 64 * (j))
#define XB_XSUB(j)  (1280 + 64 * (j))
#define XB_XGEN(j)  (2304 + 64 * (j))
#define XB_TOP      3328
#define XB_TOPGEN   3392
#define XCD_BAR_WORDS 3456
#define XB_SPIN_CAP (1u << 18)

__device__ __forceinline__ unsigned xb_ld(unsigned* p)              { return __hip_atomic_load(p, __ATOMIC_RELAXED, __HIP_MEMORY_SCOPE_AGENT); }
__device__ __forceinline__ unsigned xb_add(unsigned* p, unsigned v) { return __hip_atomic_fetch_add(p, v, __ATOMIC_RELAXED, __HIP_MEMORY_SCOPE_AGENT); }
__device__ __forceinline__ unsigned xb_xcc_id() { return (unsigned)__builtin_amdgcn_s_getreg((3 << 11) | 20) & 0xFu; }
#define XB_SPIN(cond, bar) do { unsigned _sp = 0; while (cond) { __builtin_amdgcn_s_sleep(1); \
    if ((++_sp & 255u) == 0u) { if (xb_ld(&(bar)[XB_TMO])) break; if (_sp > XB_SPIN_CAP) { atomicAdd(&(bar)[XB_TMO], 1u); break; } } } } while (0)

__device__ __forceinline__ int lane_now(int dep) { int l; asm volatile("v_mbcnt_lo_u32_b32 %0, -1, 0\n\tv_mbcnt_hi_u32_b32 %0, -1, %0 ; dep %1" : "=v"(l) : "s"(dep)); return l; }
struct XcdBarrier {
    unsigned* bar; unsigned x; int wave;
    volatile LAS unsigned* st;
};

__device__ __forceinline__ XcdBarrier xcd_barrier_post(unsigned* bar, volatile LAS unsigned* st, int wave) {
    XcdBarrier b; b.bar = bar; b.x = xb_xcc_id(); b.st = st; b.wave = wave;
    if (wave == 0 && lane_now(0) == 0) (void)xb_add(&bar[XB_XCNT(b.x)], 1u);
    return b;
}
__device__ __forceinline__ void xcd_barrier_complete(unsigned* bar, unsigned x, unsigned& nloc, unsigned& nx) {
    const unsigned G = gridDim.x * gridDim.y * gridDim.z;
    unsigned sum, cnt, mine, sp = 0u;
    for (;;) {
        sum = 0u; cnt = 0u; mine = 0u;
#pragma unroll
        for (unsigned j = 0; j < 16; ++j) { const unsigned c = xb_ld(&bar[XB_XCNT(j)]); sum += c; cnt += (c > 0u) ? 1u : 0u; mine = (j == x) ? c : mine; }
        if (sum == G) break;
        __builtin_amdgcn_s_sleep(1);
        if ((++sp & 255u) == 0u) { if (xb_ld(&bar[XB_TMO])) break; if (sp > XB_SPIN_CAP) { atomicAdd(&bar[XB_TMO], 1u); break; } }
    }
    nloc = mine > 0u ? mine : 1u; nx = cnt > 0u ? cnt : 1u;
}

__device__ __forceinline__ void xcd_barrier(const XcdBarrier& b) {
    asm volatile("s_waitcnt vmcnt(0)" ::: "memory");
    __syncthreads();
    if (b.wave == 0 && lane_now(1) == 0) {
        unsigned* bar = b.bar;
        __builtin_amdgcn_s_waitcnt(0);
        unsigned nloc = b.st[0], nx = b.st[1];
        if (nloc == 0u) { xcd_barrier_complete(bar, b.x, nloc, nx); b.st[0] = nloc; b.st[1] = nx; }
        const unsigned old = xb_add(&bar[XB_XSUB(b.x)], 1u);
        const unsigned gen = old / nloc;
        if (old + 1u == (gen + 1u) * nloc) {
            __builtin_amdgcn_fence(__ATOMIC_RELEASE, "agent");
            asm volatile("s_waitcnt vmcnt(0)" ::: "memory");
            const unsigned og = xb_add(&bar[XB_TOP], 1u);
            const unsigned tg = og / nx;
            if (og + 1u == (tg + 1u) * nx) xb_add(&bar[XB_TOPGEN], 1u);
            else XB_SPIN(xb_ld(&bar[XB_TOPGEN]) == tg, bar);
            __builtin_amdgcn_fence(__ATOMIC_ACQUIRE, "agent");
            xb_add(&bar[XB_XGEN(b.x)], 1u);
            asm volatile("s_waitcnt vmcnt(0)" ::: "memory");
        } else {
            XB_SPIN(xb_ld(&bar[XB_XGEN(b.x)]) == gen, bar);
            __builtin_amdgcn_fence(__ATOMIC_ACQUIRE, "agent");
            asm volatile("s_waitcnt vmcnt(0)" ::: "memory");
        }
    }
    __syncthreads();
}
namespace pg8 {
#define PG8_LAS __attribute__((address_space(3)))
typedef unsigned short bf16_t;
typedef short bf16x8 __attribute__((ext_vector_type(8)));
typedef float f32x4 __attribute__((ext_vector_type(4)));
typedef unsigned u32x4 __attribute__((ext_vector_type(4)));
constexpr int BM = 256, BK = 64, HALF = 128, HTB = HALF * BK * 2  , STAGE_BYTES = 8 * HTB, NXCD = 8, WGM = 8;

__host__ __device__ __forceinline__ int lds_byte(int r, int c) { const int st = (r >> 4) * 2 + (c >> 5), rr = r & 15, cc = c & 31, ob = rr * 64 + cc * 2; return st * 1024 + (ob ^ (((ob >> 9) & 1) << 5)); }
__host__ __device__ __forceinline__ void stage_rc(int b, int& R, int& C) { const int st = b / 1024, sb = b % 1024, swz = sb ^ (((sb >> 9) & 1) << 5); R = (st >> 1) * 16 + swz / 64; C = (st & 1) * 32 + (swz % 64) / 2; }
__host__ __device__ __forceinline__ int perm32(int rho) { const int n = rho >> 4, i = rho & 15; return 8 * (i >> 2) + 4 * n + (i & 3); }

struct Unit { int pm, pn; };
struct Gemm { const bf16_t* A; const bf16_t* Bt; int M, N, K, lda, ldb, a_koff_pn; };

struct StaticOrder {
    int nM, nN, nwg, G, c;
    __host__ __device__ void init(int M, int N, int G_, int c_) { nM = M / BM; nN = N / BM; nwg = nM * nN; G = G_; c = c_; }
    __host__ __device__ bool next(int i, Unit& u) const {
        const long L = (long)i * G + c; if (L >= nwg) return false;
        int wgid = (int)L; { const int q = nwg / NXCD, r = nwg % NXCD, xcd = wgid % NXCD, off = wgid / NXCD; wgid = (xcd < r ? xcd * (q + 1) : r * (q + 1) + (xcd - r) * q) + off; }
        const int nig = WGM * nN, gid = wgid / nig, fm = gid * WGM, gsz = (nM - fm) < WGM ? (nM - fm) : WGM;
        u.pm = fm + ((wgid % nig) % gsz); u.pn = (wgid % nig) / gsz; return true;
    }
    __device__ __forceinline__ void a_ready(const Unit&) const {}
    __device__ __forceinline__ void done(const Unit&) const {}
};
__device__ __forceinline__ unsigned cvt_pk_bf16(float lo, float hi) { unsigned r; asm volatile("v_cvt_pk_bf16_f32 %0, %1, %2" : "=v"(r) : "v"(lo), "v"(hi)); return r; }
typedef float f32x2 __attribute__((ext_vector_type(2)));
enum { EM_PLAIN = 0, EM_PROJ0 = 1, EM_ROWSCALE = 2, EM_UVGATE = 3, EM_PROJ1 = 4 };
template <int MODE> struct Epi {
    static constexpr bool PERM = true, AFTER_DRAIN = false;
    bf16_t* O; int ldc; float* stats; const bf16_t* gate; int ldg;
    __device__ __forceinline__ void operator()(const f32x4 (&acc)[2][2][4][2], const Unit& u, int wr, int wc, int fr, int fq) const {
        const int row0 = u.pm * BM + wr * 64 + fr, col0 = u.pn * BM + wc * 32 + 8 * fq;
        const __amdgpu_buffer_rsrc_t orsrc = __builtin_amdgcn_make_buffer_rsrc((void*)O, 0, 0x7ffffff0, 0x00020000);
#pragma unroll
        for (int ai = 0; ai < 2; ++ai)
#pragma unroll
            for (int m = 0; m < 4; ++m) {
                const int row = row0 + ai * HALF + m * 16;
                float rs = 1.f;
                if (MODE == EM_ROWSCALE) { const f32x4 s = *(const f32x4*)(stats + (size_t)row * 16); rs = rsqrtf(((s[0] + s[1]) + (s[2] + s[3])) * (1.f / 256.f) + 1e-6f); }
                if (MODE == EM_PROJ1) rs = (u.pn < 4) ? (0.125f * 1.4426950408889634f) : 1.f;
                float ss[2] = {0.f, 0.f};
#pragma unroll
                for (int bj = 0; bj < 2; ++bj) {
                    f32x4 v0 = acc[ai][bj][m][0] * rs, v1 = acc[ai][bj][m][1] * rs;
                    if (MODE == EM_PROJ0) ss[bj] = ((v0[0] * v0[0] + v0[1] * v0[1]) + (v0[2] * v0[2] + v0[3] * v0[3])) + ((v1[0] * v1[0] + v1[1] * v1[1]) + (v1[2] * v1[2] + v1[3] * v1[3]));
                    if (MODE == EM_UVGATE) { const u32x4 gw = *(const u32x4*)(gate + (size_t)row * ldg + col0 + bj * HALF);
#pragma unroll
                        for (int q = 0; q < 4; ++q) { const float g0 = __uint_as_float(gw[q] << 16), g1 = __uint_as_float(gw[q] & 0xffff0000u);
                            const float s0 = g0 * __builtin_amdgcn_rcpf(1.f + __builtin_amdgcn_exp2f(-1.4426950408889634f * g0)), s1 = g1 * __builtin_amdgcn_rcpf(1.f + __builtin_amdgcn_exp2f(-1.4426950408889634f * g1));
                            if (q < 2) { v0[2 * q] *= s0; v0[2 * q + 1] *= s1; } else { v1[2 * q - 4] *= s0; v1[2 * q - 3] *= s1; } } }
                    u32x4 w; w.x = cvt_pk_bf16(v0[0], v0[1]); w.y = cvt_pk_bf16(v0[2], v0[3]); w.z = cvt_pk_bf16(v1[0], v1[1]); w.w = cvt_pk_bf16(v1[2], v1[3]);
                    __builtin_amdgcn_raw_buffer_store_b128(w, orsrc, (int)(((size_t)row * ldc + col0 + bj * HALF) * 2), 0, 16); }
                if (MODE == EM_PROJ0) { if (u.pn < 2) {
                    float a = ss[0], b = ss[1];
                    a = xsum32(xsum16(a)); b = xsum32(xsum16(b));
                    if (fq == 0) { if (u.pn == 0) stats[(size_t)row * 16 + wc] = a + b; else { stats[(size_t)row * 16 + 4 + wc] = a; if (wc < 2) stats[(size_t)row * 16 + 8 + wc] = b; } } } }
            }
    }
};

template <class Epi, class Sched, bool ALIGN_EPI = false, bool SP2 = false>
__device__ __forceinline__ void gemm_phase(PG8_LAS unsigned char* lds, const Gemm g, const Sched& S, const Epi& E, const int wid) {
    const int lane = lane_now(g.N), tid = wid * 64 + lane, wr = wid >> 2, wc = wid & 3, fr = lane & 15, fq = lane >> 4;
    const int K = g.K, nt = K / BK;
    unsigned voffA[2], voffB[2];
#pragma unroll
    for (int i = 0; i < 2; ++i) { int R, C; stage_rc(tid * 16 + i * 8192, R, C); const int Rb = Epi::PERM ? ((R & ~31) + perm32(R & 31)) : R;
        voffA[i] = (unsigned)(R * g.lda + C) * 2u; voffB[i] = (unsigned)(Rb * g.ldb + C) * 2u; }
    const size_t kstep = (size_t)(BK * 2);
    const size_t hstepA = (size_t)HALF * g.lda * 2, hstepB = (size_t)HALF * g.ldb * 2;
    const size_t tstepA = 2 * hstepA, tstepB = 2 * hstepB, aoffpn = (size_t)g.a_koff_pn * 2;
    const unsigned ldsw = (unsigned)wid * 1024u;
    const int aoff = lds_byte(wr * 64 + fr, fq * 8), boff = lds_byte(wc * 32 + fr, fq * 8);
#define PG8_SA(b, h) (((b) * 2 + (h)) * HTB)
#define PG8_SB(b, h) ((4 + (b) * 2 + (h)) * HTB)
#define PG8_STAGE(bufoff, gbase, voff) do { _Pragma("unroll") for (int _i = 0; _i < 2; ++_i) \
        __builtin_amdgcn_global_load_lds((const unsigned*)((const char*)(gbase) + (voff)[_i]), (PG8_LAS unsigned*)(lds + (bufoff) + ldsw + _i * 8192), 16, 0, 0); } while (0)
#define PG8_LDA(dst, b, h) do { _Pragma("unroll") for (int m = 0; m < 4; ++m) _Pragma("unroll") for (int k = 0; k < 2; ++k) dst[m][k] = *(const PG8_LAS bf16x8*)(lds + PG8_SA(b, h) + aoff + m * 2048 + k * 1024); } while (0)
#define PG8_LDB(dst, b, h) do { _Pragma("unroll") for (int n = 0; n < 2; ++n) _Pragma("unroll") for (int k = 0; k < 2; ++k) dst[n][k] = *(const PG8_LAS bf16x8*)(lds + PG8_SB(b, h) + boff + n * 2048 + k * 1024); } while (0)
#define PG8_MMA(ai, bj, At, Bt) do { __builtin_amdgcn_s_setprio(1); _Pragma("unroll") for (int m = 0; m < 4; ++m) _Pragma("unroll") for (int n = 0; n < 2; ++n) _Pragma("unroll") for (int k = 0; k < 2; ++k) \
        acc[ai][bj][m][n] = __builtin_amdgcn_mfma_f32_16x16x32_bf16(Bt[n][k], At[m][k], acc[ai][bj][m][n], 0, 0, 0); __builtin_amdgcn_s_setprio(0); } while (0)
#define PG8_WAIT_V(n) asm volatile("s_waitcnt vmcnt(" #n ")" ::: "memory")
#define PG8_WAIT_L(n) asm volatile("s_waitcnt lgkmcnt(" #n ")" ::: "memory")
#define PG8_BAR __builtin_amdgcn_s_barrier()
#define PG8_SCHED __builtin_amdgcn_sched_barrier(0)
    Unit cur, nxt; int ui = 0;
    if (!S.next(0, cur)) return;
    f32x4 acc[2][2][4][2];
#pragma unroll
    for (int a = 0; a < 2; ++a)
#pragma unroll
        for (int b = 0; b < 2; ++b)
#pragma unroll
            for (int m = 0; m < 4; ++m)
#pragma unroll
                for (int n = 0; n < 2; ++n) acc[a][b][m][n] = (f32x4){0.f, 0.f, 0.f, 0.f};
    bf16x8 At[4][2], B0[2][2], B1[2][2];
    const char* cA = (const char*)g.A + (size_t)cur.pm * tstepA + (size_t)cur.pn * aoffpn; const char* cB = (const char*)g.Bt + (size_t)cur.pn * tstepB;
    S.a_ready(cur);
    if constexpr (SP2) {
        PG8_STAGE(PG8_SB(0, 0), cB, voffB); PG8_STAGE(PG8_SB(0, 1), cB + hstepB, voffB); PG8_STAGE(PG8_SA(0, 0), cA, voffA); PG8_STAGE(PG8_SA(0, 1), cA + hstepA, voffA);
        if (wr == 1) PG8_BAR;
        PG8_WAIT_V(2); PG8_BAR;
        PG8_STAGE(PG8_SB(1, 0), cB + kstep, voffB); PG8_STAGE(PG8_SA(1, 0), cA + kstep, voffA); PG8_STAGE(PG8_SB(1, 1), cB + hstepB + kstep, voffB);
        PG8_WAIT_V(6); PG8_BAR;
    } else {
        PG8_STAGE(PG8_SB(0, 0), cB, voffB); PG8_STAGE(PG8_SA(0, 0), cA, voffA); PG8_STAGE(PG8_SB(0, 1), cB + hstepB, voffB); PG8_STAGE(PG8_SA(0, 1), cA + hstepA, voffA);
        if (wr == 1) PG8_BAR;
        PG8_WAIT_V(4); PG8_BAR;
        PG8_STAGE(PG8_SB(1, 0), cB + kstep, voffB); PG8_STAGE(PG8_SA(1, 0), cA + kstep, voffA); PG8_STAGE(PG8_SB(1, 1), cB + hstepB + kstep, voffB);
        PG8_WAIT_V(6); PG8_BAR;
    }
    for (;;) {
        const bool has_next = S.next(ui + 1, nxt);
        const char* nA = has_next ? (const char*)g.A + (size_t)nxt.pm * tstepA + (size_t)nxt.pn * aoffpn : cA; const char* nB = has_next ? (const char*)g.Bt + (size_t)nxt.pn * tstepB : cB;
        for (int t = 0; t < nt; t += 2) {
            const bool last = (t == nt - 2);
            const char* a1 = cA + (size_t)(t + 1) * kstep;
            const char* a2 = last ? nA : cA + (size_t)(t + 2) * kstep; const char* b2 = last ? nB : cB + (size_t)(t + 2) * kstep;
            const char* a3 = a2 + kstep; const char* b3 = b2 + kstep;
            if (last && has_next) S.a_ready(nxt);
            if constexpr (SP2) {
            PG8_LDB(B0, 0, 0); PG8_LDB(B1, 0, 1); PG8_SCHED; PG8_LDA(At, 0, 0); PG8_STAGE(PG8_SA(1, 1), a1 + hstepA, voffA);
            PG8_WAIT_V(8); PG8_WAIT_L(0); PG8_BAR; PG8_MMA(0, 0, At, B0); PG8_MMA(0, 1, At, B1); PG8_BAR; PG8_SCHED;
            PG8_LDA(At, 0, 1); PG8_STAGE(PG8_SB(0, 0), b2, voffB); PG8_STAGE(PG8_SB(0, 1), b2 + hstepB, voffB); PG8_STAGE(PG8_SA(0, 0), a2, voffA);
            PG8_WAIT_V(8); PG8_WAIT_L(0); PG8_BAR; PG8_MMA(1, 0, At, B0); PG8_MMA(1, 1, At, B1); PG8_BAR; PG8_SCHED;
            PG8_LDB(B0, 1, 0); PG8_LDB(B1, 1, 1); PG8_SCHED; PG8_LDA(At, 1, 0); PG8_STAGE(PG8_SA(0, 1), a2 + hstepA, voffA);
            PG8_WAIT_V(8); PG8_WAIT_L(0); PG8_BAR; PG8_MMA(0, 0, At, B0); PG8_MMA(0, 1, At, B1); PG8_BAR; PG8_SCHED;
            PG8_LDA(At, 1, 1); PG8_STAGE(PG8_SB(1, 0), b3, voffB); PG8_STAGE(PG8_SB(1, 1), b3 + hstepB, voffB); PG8_STAGE(PG8_SA(1, 0), a3, voffA);
            PG8_WAIT_V(8); PG8_WAIT_L(0); PG8_BAR; PG8_MMA(1, 0, At, B0); PG8_MMA(1, 1, At, B1); PG8_BAR; PG8_SCHED;
            } else {
            PG8_LDB(B0, 0, 0); PG8_SCHED; PG8_LDA(At, 0, 0); PG8_STAGE(PG8_SA(1, 1), a1 + hstepA, voffA);
            PG8_WAIT_L(8); PG8_BAR; PG8_WAIT_L(0); PG8_MMA(0, 0, At, B0); PG8_BAR; PG8_SCHED;
            PG8_LDB(B1, 0, 1); PG8_STAGE(PG8_SB(0, 0), b2, voffB);
            PG8_BAR; PG8_WAIT_L(0); PG8_MMA(0, 1, At, B1); PG8_BAR;
            PG8_LDA(At, 0, 1); PG8_STAGE(PG8_SA(0, 0), a2, voffA);
            PG8_BAR; PG8_WAIT_L(0); PG8_MMA(1, 0, At, B0); PG8_BAR; PG8_SCHED;
            PG8_STAGE(PG8_SB(0, 1), b2 + hstepB, voffB);
            PG8_WAIT_V(6); PG8_BAR; PG8_MMA(1, 1, At, B1); PG8_BAR;
            PG8_LDB(B0, 1, 0); PG8_SCHED; PG8_LDA(At, 1, 0); PG8_STAGE(PG8_SA(0, 1), a2 + hstepA, voffA);
            PG8_WAIT_L(8); PG8_BAR; PG8_WAIT_L(0); PG8_MMA(0, 0, At, B0); PG8_BAR; PG8_SCHED;
            PG8_LDB(B1, 1, 1); PG8_STAGE(PG8_SB(1, 0), b3, voffB);
            PG8_BAR; PG8_WAIT_L(0); PG8_MMA(0, 1, At, B1); PG8_BAR;
            PG8_LDA(At, 1, 1); PG8_STAGE(PG8_SA(1, 0), a3, voffA);
            PG8_BAR; PG8_WAIT_L(0); PG8_MMA(1, 0, At, B0); PG8_BAR; PG8_SCHED;
            PG8_STAGE(PG8_SB(1, 1), b3 + hstepB, voffB);
            PG8_WAIT_V(6); PG8_BAR; PG8_MMA(1, 1, At, B1); PG8_BAR;
            }
        }
        if constexpr (ALIGN_EPI) { if (wr == 0) PG8_BAR; }
        if constexpr (!Epi::AFTER_DRAIN) { E(acc, cur, wr, wc, fr, fq); S.done(cur); }
        if (!has_next) break;
#pragma unroll
        for (int a = 0; a < 2; ++a)
#pragma unroll
            for (int b = 0; b < 2; ++b)
#pragma unroll
                for (int m = 0; m < 4; ++m)
#pragma unroll
                    for (int n = 0; n < 2; ++n) acc[a][b][m][n] = (f32x4){0.f, 0.f, 0.f, 0.f};
        cur = nxt; cA = nA; cB = nB; ++ui;
        if constexpr (ALIGN_EPI) { if (wr == 1) PG8_BAR; }
    }
    PG8_WAIT_V(0);
    if constexpr (!ALIGN_EPI) { if (wr == 0) PG8_BAR; }
    PG8_BAR;
    if constexpr (Epi::AFTER_DRAIN) { E.fused(acc, cur, wr, wc, fr, fq, lds, wid, lane); S.done(cur); }
#undef PG8_SA
#undef PG8_SB
#undef PG8_STAGE
#undef PG8_LDA
#undef PG8_LDB
#undef PG8_MMA
#undef PG8_WAIT_V
#undef PG8_WAIT_L
#undef PG8_BAR
#undef PG8_SCHED
}
}
namespace attn_body {
using bf16=__hip_bfloat16;
using bf16x8=__attribute__((ext_vector_type(8)))short;
using s16x4=__attribute__((ext_vector_type(4)))short;
using f32x16=__attribute__((ext_vector_type(16)))float;
using u32x4=__attribute__((ext_vector_type(4)))unsigned;
constexpr int SEQ=2048,D=64,DM=4096,OPITCH=256;
constexpr int NW=8,QBLK=32,QB=QBLK*NW,KVBLK=64,NQB=SEQ/QB;
constexpr int ATTN_UNIT_ROWS=QB;
__device__ __forceinline__ int crow(int r,int hi){return (r&3)+8*(r>>2)+4*hi;}
#define SBAR() __builtin_amdgcn_sched_barrier(0)
__device__ __forceinline__ void cmask(f32x16&p0,f32x16&p1,int jb,int qrel,int hi){
  const float NEG=-INFINITY; int x=qrel-(64*jb+4*hi); asm volatile("":"+v"(x));
  #pragma unroll
  for(int r=0;r<16;++r){const int c=(r&3)+8*(r>>2); if(c>x)p0[r]=NEG; if(c+32>x)p1[r]=NEG;}
}

constexpr int NSLOT=3, SLOTB=8192;
constexpr int LDS_K=0, LDS_V=NSLOT*SLOTB, LDS_WS=2*NSLOT*SLOTB, LDS_OST=LDS_WS+NW*64*4, LDS_BT=LDS_OST+NW*4096, BT_N=704, LDS_BYTES=LDS_BT+BT_N*4;
constexpr float C2=0.125f*1.4426950408889634f;
__device__ __forceinline__ void glds16(const void*gsrc,unsigned lds_dst){unsigned keep;
  asm volatile("s_mov_b32 %0, m0\n\ts_mov_b32 m0, %2\n\ts_nop 0\n\tglobal_load_lds_dwordx4 %1, off\n\ts_mov_b32 m0, %0":"=&s"(keep):"v"(gsrc),"s"(lds_dst):"memory");}
__device__ __forceinline__ float max3f(float a,float b,float c){float r;asm("v_max3_f32 %0, %1, %2, %3":"=v"(r):"v"(a),"v"(b),"v"(c));return r;}
__device__ __forceinline__ float max2f(float a,float b){float r;asm("v_max_f32_e32 %0, %1, %2":"=v"(r):"v"(a),"v"(b));return r;}
__device__ __forceinline__ float fadd_s(float a,float b){float r;asm("v_add_f32_e32 %0, %1, %2":"=v"(r):"v"(a),"v"(b));return r;}
__device__ __forceinline__ float fsub_s(float a,float b){float r;asm("v_sub_f32_e32 %0, %1, %2":"=v"(r):"v"(a),"v"(b));return r;}
typedef float f32x2_t __attribute__((ext_vector_type(2))); typedef __bf16 bf16x2_t __attribute__((ext_vector_type(2)));
__device__ __forceinline__ unsigned cvtpk_s(float lo,float hi){f32x2_t v={lo,hi};bf16x2_t b=__builtin_convertvector(v,bf16x2_t);return __builtin_bit_cast(unsigned,b);}
#define WAIT_BAR(N) asm volatile("s_waitcnt vmcnt(" #N ") lgkmcnt(0)\n\ts_barrier":::"memory")

__device__ __forceinline__ void qkt(f32x16&p0,f32x16&p1,const char*Kslot,const bf16x8*qr,int r32,int hi){
  const char*kb=Kslot+hi*1024+r32*16;
  #pragma unroll
  for(int d0=0;d0<4;++d0){
    const bf16x8 b0=*reinterpret_cast<const bf16x8*>(kb+d0*2048);
    const bf16x8 b1=*reinterpret_cast<const bf16x8*>(kb+d0*2048+512);
    if(d0==0){p0=__builtin_amdgcn_mfma_f32_32x32x16_bf16(b0,qr[0],f32x16{},0,0,0);p1=__builtin_amdgcn_mfma_f32_32x32x16_bf16(b1,qr[0],f32x16{},0,0,0);}
    else{p0=__builtin_amdgcn_mfma_f32_32x32x16_bf16(b0,qr[d0],p0,0,0,0);p1=__builtin_amdgcn_mfma_f32_32x32x16_bf16(b1,qr[d0],p1,0,0,0);}}
}
typedef __attribute__((address_space(3))) const char* lds_cptr;
typedef short v4i16_t __attribute__((ext_vector_type(4)));
__device__ __forceinline__ void kload8(bf16x8*kf,lds_cptr kp){
  kf[0]=*(const __attribute__((address_space(3))) bf16x8*)(kp);      kf[1]=*(const __attribute__((address_space(3))) bf16x8*)(kp+512);
  kf[2]=*(const __attribute__((address_space(3))) bf16x8*)(kp+2048); kf[3]=*(const __attribute__((address_space(3))) bf16x8*)(kp+2560);
  kf[4]=*(const __attribute__((address_space(3))) bf16x8*)(kp+4096); kf[5]=*(const __attribute__((address_space(3))) bf16x8*)(kp+4608);
  kf[6]=*(const __attribute__((address_space(3))) bf16x8*)(kp+6144); kf[7]=*(const __attribute__((address_space(3))) bf16x8*)(kp+6656);
}
__device__ __forceinline__ void kload2(bf16x8*kf,lds_cptr kp,int j){ kf[2*j]=*(const __attribute__((address_space(3))) bf16x8*)(kp+j*2048); kf[2*j+1]=*(const __attribute__((address_space(3))) bf16x8*)(kp+j*2048+512); }
__device__ __forceinline__ s16x4 vtr(lds_cptr p){ return __builtin_bit_cast(s16x4,__builtin_amdgcn_ds_read_tr16_b64_v4i16((__attribute__((address_space(3))) v4i16_t*)p)); }
__device__ __forceinline__ float rowmax(const f32x16&p0,const f32x16&p1){
  float a=max3f(p0[0],p0[1],p1[0]),b=max3f(p0[2],p0[3],p1[1]);a=max3f(a,p1[2],p1[3]);
  #pragma unroll
  for(int r=4;r<16;r+=4){a=max3f(a,p0[r],p0[r+1]);b=max3f(b,p0[r+2],p0[r+3]);a=max3f(a,p1[r],p1[r+1]);b=max3f(b,p1[r+2],p1[r+3]);}
  const float m=max2f(a,b);
  auto rr=__builtin_amdgcn_permlane32_swap(__float_as_uint(m),__float_as_uint(m),false,false);
  return max2f(__uint_as_float(rr[0]),__uint_as_float(rr[1]));
}
__device__ __forceinline__ void pv(f32x16*o,int vb,bf16x8 pa0,bf16x8 pa1,bf16x8 pa2,bf16x8 pa3){
  #pragma unroll
  for(int d0=0;d0<2;++d0){s16x4 lo[4],hi[4];
    #pragma unroll
    for(int ks=0;ks<4;++ks){
      asm volatile("ds_read_b64_tr_b16 %0,%1 offset:%c2":"=&v"(lo[ks]):"v"(vb),"i"(d0*4096+ks*1024):"memory");
      asm volatile("ds_read_b64_tr_b16 %0,%1 offset:%c2":"=&v"(hi[ks]):"v"(vb),"i"(d0*4096+ks*1024+512):"memory");}
    asm volatile("s_waitcnt lgkmcnt(0)":::"memory");SBAR();
    #define PK(k) (bf16x8){lo[k][0],lo[k][1],lo[k][2],lo[k][3],hi[k][0],hi[k][1],hi[k][2],hi[k][3]}
    o[d0]=__builtin_amdgcn_mfma_f32_32x32x16_bf16(pa0,PK(0),o[d0],0,0,0);
    o[d0]=__builtin_amdgcn_mfma_f32_32x32x16_bf16(pa1,PK(1),o[d0],0,0,0);
    o[d0]=__builtin_amdgcn_mfma_f32_32x32x16_bf16(pa2,PK(2),o[d0],0,0,0);
    o[d0]=__builtin_amdgcn_mfma_f32_32x32x16_bf16(pa3,PK(3),o[d0],0,0,0);
    #undef PK
  }
}

#ifndef ATTN_STORE16
#define ATTN_STORE16(p,v) (*(u32x4*)(p)=(v))
#endif
template<int THRL> __device__ __forceinline__ void attn_unit(const int wid,int b,int qb,const bf16*Qc,const bf16*__restrict__ Kc,const bf16*__restrict__ Vc,bf16*Oc,const float*btabm,char*shm){
  int lane; asm volatile("v_mbcnt_lo_u32_b32 %0, -1, 0\n\tv_mbcnt_hi_u32_b32 %0, -1, %0 ; dep %1":"=v"(lane):"s"(qb));
  const int tid=wid*64+lane,r32=lane&31,hi=lane>>5;
  const long rowbase=(long)b*SEQ; const int q0=qb*QB;
  const bf16*Qw=Qc+(rowbase+q0+wid*QBLK)*DM;
  const bf16*Kh=Kc+rowbase*DM,*Vh=Vc+rowbase*DM;
  const unsigned lds0=(unsigned)(uintptr_t)shm;
  float*wsf=(float*)(shm+LDS_WS)+wid*64;
  const float b31n=btabm[127*16]; const float b31l=b31n*1.4426950408889634f;
  { float*R=(float*)(shm+LDS_BT); for(int j=tid;j<BT_N;j+=NW*64){ int d=447-j; float v=0.f; if(d>=0&&d<127) v=(btabm[d*16]-b31n)*1.4426950408889634f; R[j]=v; } }
  const bf16*ksrc=Kh+(long)lane*DM+wid*8;
  const bf16*vsrc=Vh+(long)(16*(wid&3)+(lane>>2))*DM+(wid>>2)*32+(lane&3)*8;
  const unsigned kdst=lds0+LDS_K+wid*1024, vdst=lds0+LDS_V+wid*1024;
  #define DMA_K(t,slot) glds16(ksrc+(long)(t)*KVBLK*DM,(unsigned)__builtin_amdgcn_readfirstlane(kdst+(slot)))
  #define DMA_V(t,slot) glds16(vsrc+(long)(t)*KVBLK*DM,(unsigned)__builtin_amdgcn_readfirstlane(vdst+(slot)))
  const int vb0=(int)(lds0+LDS_V)+((lane>>4)&1)*32+(lane&3)*8+(4*hi+((lane&15)>>2))*64;
  const char*Kbase=shm+LDS_K; bf16x8 kf[8];
  const lds_cptr shm3=(lds_cptr)shm; const lds_cptr kp0=shm3+LDS_K+hi*1024+r32*16; const lds_cptr vp0=shm3+LDS_V+((lane>>4)&1)*32+(lane&3)*8+(4*hi+((lane&15)>>2))*64;
  const int NT=(q0+QB)/KVBLK;
  DMA_K(0,0);DMA_V(0,0);DMA_K(1,SLOTB);
  bf16x8 qr[4];
  #pragma unroll
  for(int d0=0;d0<4;++d0)qr[d0]=*reinterpret_cast<const bf16x8*>(&Qw[(long)r32*DM+d0*16+hi*8]);
  float mhat=0.f,l_reg=0.f;f32x16 o[2];o[0]=f32x16{};o[1]=f32x16{};
  const int qrel=wid*QBLK+r32;
  typedef __attribute__((address_space(3))) const float* lds_fptr;
  const lds_fptr Rl=(lds_fptr)((lds_cptr)shm+LDS_BT)+(447-(q0+qrel-4*hi));
  #define CBIAS(P0,P1,t) do{ const lds_fptr rp_=Rl+64*(t); \
    _Pragma("unroll") for(int g_=0;g_<4;++g_){ SBAR(); _Pragma("unroll") for(int r=4*g_;r<4*g_+4;++r){ P0[r]+=rp_[(r&3)+8*(r>>2)]; P1[r]+=rp_[32+(r&3)+8*(r>>2)]; } } SBAR(); }while(0)
  #define CMASK(P0,P1,t) do{ if((t)>=NT-7){ CBIAS(P0,P1,t); } int jb_=(t)-(NT-4); if(jb_>=0)cmask(P0,P1,jb_,qrel,hi);}while(0)
  bool resc=false;
  #define START(P0,P1) do{ const float rm=rowmax(P0,P1); resc=false; \
    { const float dl=rm; mhat=fadd_s(mhat,dl); \
      _Pragma("unroll") for(int r=0;r<16;++r){P0[r]=fsub_s(P0[r],dl);P1[r]=fsub_s(P1[r],dl);} \
      } \
    _Pragma("unroll") for(int r=0;r<16;++r)P0[r]=__builtin_amdgcn_exp2f(P0[r]); }while(0)
  #define RESC() do{ if(resc){ asm volatile("s_waitcnt lgkmcnt(0)":::"memory"); \
      _Pragma("unroll") for(int d_=0;d_<2;++d_) _Pragma("unroll") for(int r=0;r<16;++r)o[d_][r]*=wsf[crow(r,hi)]; } }while(0)
  f32x16 pA0,pA1,pB0,pB1;
  int sl_prev=0,sl_cur=0,sl_next=SLOTB;
  #define ROT() do{sl_prev=sl_cur;sl_cur=sl_next;sl_next=(sl_next==(NSLOT-1)*SLOTB)?0:sl_next+SLOTB;}while(0)
  DMA_K(2,2*SLOTB);
  WAIT_BAR(3);
  qkt(pA0,pA1,Kbase,qr,r32,hi);asm volatile("s_nop 15\n\ts_nop 7":"+v"(pA0),"+v"(pA1));
  #pragma unroll
  for(int r=0;r<16;++r){pA0[r]+=b31l;pA1[r]+=b31l;}
  CMASK(pA0,pA1,0);
  START(pA0,pA1);
  _Pragma("unroll") for(int r=0;r<16;++r)pA1[r]=__builtin_amdgcn_exp2f(pA1[r]);
  WAIT_BAR(0);
  DMA_K(3,0);DMA_V(1,SLOTB);
  ROT();
  kload8(kf,kp0+sl_cur);
  WAIT_BAR(2);
  s16x4 vlo[8],vhi[8]; u32x4 pw0,pw1,pw2,pw3;
  #define PKW(P,B) cvtpk_s(P[B],P[B+1])
  #define PAF(k) __builtin_bit_cast(bf16x8,pw##k)
  #define VFR(i) (bf16x8){vlo[i][0],vlo[i][1],vlo[i][2],vlo[i][3],vhi[i][0],vhi[i][1],vhi[i][2],vhi[i][3]}
  #define PIN(x) asm volatile("":"+v"(x))
  #define MX3(a,b,c) __builtin_fmaxf(__builtin_fmaxf((a),(b)),(c))
  #define GAPA(MF,A0,A1,A2,A3,W0,W1,PW) do{ MF; sacc+=A0; sacc+=A1; sacc+=A2; sacc+=A3; PIN(sacc); W0; W1; PIN(PW); SBAR(); }while(0)
  #define EX(v) __builtin_amdgcn_exp2f(v)
  #define GAPB(MF,X,B) do{ MF; X[B]=EX(X[B]); X[B+1]=EX(X[B+1]); X[B+2]=EX(X[B+2]); X[B+3]=EX(X[B+3]); PIN(X); SBAR(); }while(0)
  #define VRD(i) do{ vlo[i]=vtr(vp_+(((i)>>2)*4096+((i)&3)*1024)); vhi[i]=vtr(vp_+(((i)>>2)*4096+((i)&3)*1024+512)); }while(0)
  #define KRD(G,j) do{ if(G){ kload2(kf,kp0+sl_next,j); SBAR(); } }while(0)
  #define STEP(C0,C1,P0,P1,t,GK,GV,GL) do{ SBAR(); \
    const lds_cptr vp_=vp0+sl_prev; \
    VRD(0); SBAR(); float sacc=(P0[0]+P0[1]); \
    GAPA(C0=__builtin_amdgcn_mfma_f32_32x32x16_bf16(kf[0],qr[0],f32x16{},0,0,0), P0[2],P0[3],P0[4],P0[5],     pw0[0]=PKW(P0,0), pw0[1]=PKW(P0,2), pw0); \
    VRD(4); SBAR(); GAPA(C1=__builtin_amdgcn_mfma_f32_32x32x16_bf16(kf[1],qr[0],f32x16{},0,0,0), P0[6],P0[7],P0[8],P0[9],     pw0[2]=PKW(P0,4), pw0[3]=PKW(P0,6), pw0); \
    VRD(1); SBAR(); GAPA(C0=__builtin_amdgcn_mfma_f32_32x32x16_bf16(kf[2],qr[1],C0,0,0,0),   P0[10],P0[11],P0[12],P0[13], pw1[0]=PKW(P0,8), pw1[1]=PKW(P0,10), pw1); \
    VRD(5); SBAR(); GAPA(C1=__builtin_amdgcn_mfma_f32_32x32x16_bf16(kf[3],qr[1],C1,0,0,0),   P0[14],P0[15],P1[0],P1[1],   pw1[2]=PKW(P0,12),pw1[3]=PKW(P0,14), pw1); \
    VRD(2); SBAR(); GAPA(C0=__builtin_amdgcn_mfma_f32_32x32x16_bf16(kf[4],qr[2],C0,0,0,0),   P1[2],P1[3],P1[4],P1[5],     pw2[0]=PKW(P1,0), pw2[1]=PKW(P1,2), pw2); \
    VRD(6); SBAR(); GAPA(C1=__builtin_amdgcn_mfma_f32_32x32x16_bf16(kf[5],qr[2],C1,0,0,0),   P1[6],P1[7],P1[8],P1[9],     pw2[2]=PKW(P1,4), pw2[3]=PKW(P1,6), pw2); \
    VRD(3); SBAR(); GAPA(C0=__builtin_amdgcn_mfma_f32_32x32x16_bf16(kf[6],qr[3],C0,0,0,0),   P1[10],P1[11],P1[12],P1[13], pw3[0]=PKW(P1,8), pw3[1]=PKW(P1,10), pw3); \
    VRD(7); SBAR(); GAPA(C1=__builtin_amdgcn_mfma_f32_32x32x16_bf16(kf[7],qr[3],C1,0,0,0),   P1[14],P1[15],0.f,0.f,       pw3[2]=PKW(P1,12),pw3[3]=PKW(P1,14), pw3); \
    l_reg+=sacc; \
    if(GK){DMA_K((t)+3,sl_cur);} if(GV){DMA_V((t)+1,sl_next);} \
    { const float nb_=b31l-mhat; _Pragma("unroll") for(int r=0;r<16;++r){C0[r]+=nb_;C1[r]+=nb_;} } \
    CMASK(C0,C1,t); \
    { float a=MX3(C0[0],C0[1],C1[0]),b=MX3(C0[2],C0[3],C1[1]); a=MX3(a,C1[2],C1[3]); \
      _Pragma("unroll") for(int r=4;r<16;r+=4){a=MX3(a,C0[r],C0[r+1]);b=MX3(b,C0[r+2],C0[r+3]);a=MX3(a,C1[r],C1[r+1]);b=MX3(b,C1[r+2],C1[r+3]);} \
      float rm=__builtin_fmaxf(a,b); { auto rr=__builtin_amdgcn_permlane32_swap(__float_as_uint(rm),__float_as_uint(rm),false,false); rm=__builtin_fmaxf(__uint_as_float(rr[0]),__uint_as_float(rr[1])); } \
      resc=false; \
      if(__builtin_expect(__any(rm>(float)THRL),0)){ const float dl=__builtin_fmaxf(rm,0.f); mhat+=dl; \
        _Pragma("unroll") for(int r=0;r<16;++r){C0[r]-=dl;C1[r]-=dl;} \
        const float f=__builtin_amdgcn_exp2f(-dl); l_reg*=f; { int r32b_=r32; asm volatile("":"+v"(r32b_)); if(hi==0)wsf[r32b_]=f; } resc=true; } } \
    SBAR(); \
    GAPB(o[0]=__builtin_amdgcn_mfma_f32_32x32x16_bf16(PAF(0),VFR(0),o[0],0,0,0), C0,0); \
    GAPB(o[1]=__builtin_amdgcn_mfma_f32_32x32x16_bf16(PAF(0),VFR(4),o[1],0,0,0), C0,4); \
    KRD(GL,0); GAPB(o[0]=__builtin_amdgcn_mfma_f32_32x32x16_bf16(PAF(1),VFR(1),o[0],0,0,0), C0,8); \
    KRD(GL,1); GAPB(o[1]=__builtin_amdgcn_mfma_f32_32x32x16_bf16(PAF(1),VFR(5),o[1],0,0,0), C0,12); \
    KRD(GL,2); GAPB(o[0]=__builtin_amdgcn_mfma_f32_32x32x16_bf16(PAF(2),VFR(2),o[0],0,0,0), C1,0); \
    KRD(GL,3); GAPB(o[1]=__builtin_amdgcn_mfma_f32_32x32x16_bf16(PAF(2),VFR(6),o[1],0,0,0), C1,4); \
    GAPB(o[0]=__builtin_amdgcn_mfma_f32_32x32x16_bf16(PAF(3),VFR(3),o[0],0,0,0), C1,8); \
    GAPB(o[1]=__builtin_amdgcn_mfma_f32_32x32x16_bf16(PAF(3),VFR(7),o[1],0,0,0), C1,12); \
    }while(0)
  int t=1;
  #undef CMASK
  #define CMASK(P0,P1,t) do{}while(0)
  for(;t+7<NT;t+=2){
    STEP(pB0,pB1,pA0,pA1,t,true,true,true);     WAIT_BAR(2); RESC(); ROT();
    STEP(pA0,pA1,pB0,pB1,t+1,true,true,true);   WAIT_BAR(2); RESC(); ROT();
  }
  #undef CMASK
  #define CMASK(P0,P1,t) do{ CBIAS(P0,P1,t); int jb_=(t)-(NT-4); if(jb_>=0)cmask(P0,P1,jb_,qrel,hi);}while(0)
  #define ENDW(tt) do{ if((tt)+3<NT){WAIT_BAR(2);} else if((tt)+2<NT){WAIT_BAR(1);} else {WAIT_BAR(0);} }while(0)
  for(;t+1<NT;t+=2){
    STEP(pB0,pB1,pA0,pA1,t,(t+3<NT),(t+1<NT),(t+1<NT));       ENDW(t);   RESC(); ROT();
    STEP(pA0,pA1,pB0,pB1,t+1,(t+4<NT),(t+2<NT),(t+2<NT));     ENDW(t+1); RESC(); ROT();
  }
  STEP(pB0,pB1,pA0,pA1,NT-1,false,false,false); RESC();
  { float sacc=pB0[0]+pB0[1]; _Pragma("unroll") for(int r=2;r<16;++r)sacc+=pB0[r]; _Pragma("unroll") for(int r=0;r<16;++r)sacc+=pB1[r]; l_reg+=sacc;
    pw0=(u32x4){PKW(pB0,0),PKW(pB0,2),PKW(pB0,4),PKW(pB0,6)};pw1=(u32x4){PKW(pB0,8),PKW(pB0,10),PKW(pB0,12),PKW(pB0,14)};pw2=(u32x4){PKW(pB1,0),PKW(pB1,2),PKW(pB1,4),PKW(pB1,6)};pw3=(u32x4){PKW(pB1,8),PKW(pB1,10),PKW(pB1,12),PKW(pB1,14)};
    SBAR(); pv(o,vb0+sl_cur,PAF(0),PAF(1),PAF(2),PAF(3)); }
  #undef PKW
  #undef PAF
  #undef VFR
  #undef PIN
  #undef MX3
  #undef GAPA
  #undef GAPB
  #undef EX
  #undef VRD
  #undef KRD
  #undef STEP
  #undef ENDW
  {auto rr=__builtin_amdgcn_permlane32_swap(__float_as_uint(l_reg),__float_as_uint(l_reg),false,false);l_reg=__uint_as_float(rr[0])+__uint_as_float(rr[1]);}
  if(hi==0)wsf[32+r32]=l_reg;asm volatile("s_waitcnt lgkmcnt(0)":::"memory");
  float rli[16];
  #pragma unroll
  for(int r=0;r<16;++r)rli[r]=__builtin_amdgcn_rcpf(wsf[32+crow(r,hi)]);
  bf16*Ow=Oc+(long)(wid*QBLK)*OPITCH;
  { bf16*stg=(bf16*)(shm+LDS_OST)+wid*2048;
    #pragma unroll
    for(int r=0;r<16;++r){const int orow=crow(r,hi);
      #pragma unroll
      for(int d0=0;d0<2;++d0)stg[orow*64+d0*32+r32]=__float2bfloat16(o[d0][r]*rli[r]);}
    asm volatile("s_waitcnt lgkmcnt(0)":::"memory");
    #pragma unroll
    for(int i=0;i<4;++i){const int row=i*8+(lane>>3),ch=lane&7; const u32x4 v=*(const u32x4*)(stg+row*64+ch*8); ATTN_STORE16(Ow+(long)row*OPITCH+ch*8,v);} }
  asm volatile("s_waitcnt lgkmcnt(0)\n\ts_barrier":::"memory");
  #undef DMA_K
  #undef DMA_V
  #undef CMASK
  #undef CBIAS
  #undef START
  #undef RESC
  #undef ROT
}
constexpr int ATTN_LDS_BYTES=LDS_BYTES;
#undef SBAR
#undef WAIT_BAR
}

namespace attn2 {
using bf16=__hip_bfloat16;
using bf16x8=__attribute__((ext_vector_type(8)))short;
using s16x4=__attribute__((ext_vector_type(4)))short;
using f32x16=__attribute__((ext_vector_type(16)))float;
using u32x4=__attribute__((ext_vector_type(4)))unsigned;
constexpr int SEQ=2048,D=64,DM=4096,OPITCH=256;
constexpr int NW=8,QBLK=32,QB=QBLK*NW,KVBLK=64,NQB=SEQ/QB;
constexpr int ATTN_UNIT_ROWS=QB;
__device__ __forceinline__ int crow(int r,int hi){return (r&3)+8*(r>>2)+4*hi;}
#define SBAR() __builtin_amdgcn_sched_barrier(0)
__device__ __forceinline__ void cmask(f32x16&p0,f32x16&p1,int jb,int qrel,int hi){
  const float NEG=-INFINITY; int x=qrel-(64*jb+4*hi); asm volatile("":"+v"(x));
  #pragma unroll
  for(int r=0;r<16;++r){const int c=(r&3)+8*(r>>2); if(c>x)p0[r]=NEG; if(c+32>x)p1[r]=NEG;}
}

constexpr int NSLOT=3, SLOTB=8192, VSLOTB=16384;
constexpr int LDS_K=0, LDS_V=NSLOT*SLOTB, LDS_WS=LDS_V+NSLOT*VSLOTB, LDS_OST=LDS_WS+NW*64*4, LDS_BT=LDS_OST+NW*8192, BT_N=704, LDS_BYTES=LDS_BT+BT_N*4;
constexpr float C2=0.125f*1.4426950408889634f;
__device__ __forceinline__ void glds16(const void*gsrc,unsigned lds_dst){unsigned keep;
  asm volatile("s_mov_b32 %0, m0\n\ts_mov_b32 m0, %2\n\ts_nop 0\n\tglobal_load_lds_dwordx4 %1, off\n\ts_mov_b32 m0, %0":"=&s"(keep):"v"(gsrc),"s"(lds_dst):"memory");}
__device__ __forceinline__ float max3f(float a,float b,float c){float r;asm("v_max3_f32 %0, %1, %2, %3":"=v"(r):"v"(a),"v"(b),"v"(c));return r;}
__device__ __forceinline__ float max2f(float a,float b){float r;asm("v_max_f32_e32 %0, %1, %2":"=v"(r):"v"(a),"v"(b));return r;}
__device__ __forceinline__ float fadd_s(float a,float b){float r;asm("v_add_f32_e32 %0, %1, %2":"=v"(r):"v"(a),"v"(b));return r;}
__device__ __forceinline__ float fsub_s(float a,float b){float r;asm("v_sub_f32_e32 %0, %1, %2":"=v"(r):"v"(a),"v"(b));return r;}
typedef float f32x2_t __attribute__((ext_vector_type(2))); typedef __bf16 bf16x2_t __attribute__((ext_vector_type(2)));
__device__ __forceinline__ unsigned cvtpk_s(float lo,float hi){f32x2_t v={lo,hi};bf16x2_t b=__builtin_convertvector(v,bf16x2_t);return __builtin_bit_cast(unsigned,b);}
#define WAIT_BAR(N) asm volatile("s_waitcnt vmcnt(" #N ") lgkmcnt(0)\n\ts_barrier":::"memory")

__device__ __forceinline__ void qkt(f32x16&p0,f32x16&p1,const char*Kslot,const bf16x8*qr,int r32,int hi){
  const char*kb=Kslot+hi*1024+r32*16;
  #pragma unroll
  for(int d0=0;d0<4;++d0){
    const bf16x8 b0=*reinterpret_cast<const bf16x8*>(kb+d0*2048);
    const bf16x8 b1=*reinterpret_cast<const bf16x8*>(kb+d0*2048+512);
    if(d0==0){p0=__builtin_amdgcn_mfma_f32_32x32x16_bf16(b0,qr[0],f32x16{},0,0,0);p1=__builtin_amdgcn_mfma_f32_32x32x16_bf16(b1,qr[0],f32x16{},0,0,0);}
    else{p0=__builtin_amdgcn_mfma_f32_32x32x16_bf16(b0,qr[d0],p0,0,0,0);p1=__builtin_amdgcn_mfma_f32_32x32x16_bf16(b1,qr[d0],p1,0,0,0);}}
}
typedef __attribute__((address_space(3))) const char* lds_cptr;
typedef short v4i16_t __attribute__((ext_vector_type(4)));
__device__ __forceinline__ void kload8(bf16x8*kf,lds_cptr kp){
  kf[0]=*(const __attribute__((address_space(3))) bf16x8*)(kp);      kf[1]=*(const __attribute__((address_space(3))) bf16x8*)(kp+512);
  kf[2]=*(const __attribute__((address_space(3))) bf16x8*)(kp+2048); kf[3]=*(const __attribute__((address_space(3))) bf16x8*)(kp+2560);
  kf[4]=*(const __attribute__((address_space(3))) bf16x8*)(kp+4096); kf[5]=*(const __attribute__((address_space(3))) bf16x8*)(kp+4608);
  kf[6]=*(const __attribute__((address_space(3))) bf16x8*)(kp+6144); kf[7]=*(const __attribute__((address_space(3))) bf16x8*)(kp+6656);
}
__device__ __forceinline__ void kload2(bf16x8*kf,lds_cptr kp,int j){ kf[2*j]=*(const __attribute__((address_space(3))) bf16x8*)(kp+j*2048); kf[2*j+1]=*(const __attribute__((address_space(3))) bf16x8*)(kp+j*2048+512); }
__device__ __forceinline__ s16x4 vtr(lds_cptr p){ return __builtin_bit_cast(s16x4,__builtin_amdgcn_ds_read_tr16_b64_v4i16((__attribute__((address_space(3))) v4i16_t*)p)); }
__device__ __forceinline__ float rowmax(const f32x16&p0,const f32x16&p1){
  float a=max3f(p0[0],p0[1],p1[0]),b=max3f(p0[2],p0[3],p1[1]);a=max3f(a,p1[2],p1[3]);
  #pragma unroll
  for(int r=4;r<16;r+=4){a=max3f(a,p0[r],p0[r+1]);b=max3f(b,p0[r+2],p0[r+3]);a=max3f(a,p1[r],p1[r+1]);b=max3f(b,p1[r+2],p1[r+3]);}
  const float m=max2f(a,b);
  auto rr=__builtin_amdgcn_permlane32_swap(__float_as_uint(m),__float_as_uint(m),false,false);
  return max2f(__uint_as_float(rr[0]),__uint_as_float(rr[1]));
}
__device__ __forceinline__ void pv(f32x16*o,int vb,bf16x8 pa0,bf16x8 pa1,bf16x8 pa2,bf16x8 pa3){
  #pragma unroll
  for(int d0=0;d0<4;++d0){s16x4 lo[4],hi[4];
    #pragma unroll
    for(int ks=0;ks<4;++ks){
      asm volatile("ds_read_b64_tr_b16 %0,%1 offset:%c2":"=&v"(lo[ks]):"v"(vb),"i"(d0*4096+ks*1024):"memory");
      asm volatile("ds_read_b64_tr_b16 %0,%1 offset:%c2":"=&v"(hi[ks]):"v"(vb),"i"(d0*4096+ks*1024+512):"memory");}
    asm volatile("s_waitcnt lgkmcnt(0)":::"memory");SBAR();
    #define PK(k) (bf16x8){lo[k][0],lo[k][1],lo[k][2],lo[k][3],hi[k][0],hi[k][1],hi[k][2],hi[k][3]}
    o[d0]=__builtin_amdgcn_mfma_f32_32x32x16_bf16(pa0,PK(0),o[d0],0,0,0);
    o[d0]=__builtin_amdgcn_mfma_f32_32x32x16_bf16(pa1,PK(1),o[d0],0,0,0);
    o[d0]=__builtin_amdgcn_mfma_f32_32x32x16_bf16(pa2,PK(2),o[d0],0,0,0);
    o[d0]=__builtin_amdgcn_mfma_f32_32x32x16_bf16(pa3,PK(3),o[d0],0,0,0);
    #undef PK
  }
}

#ifndef ATTN_STORE16
#define ATTN_STORE16(p,v) (*(u32x4*)(p)=(v))
#endif
template<int THRL> __device__ __forceinline__ void attn_unit(const int wid,int b,int qb,const bf16*Qc,const bf16*__restrict__ Kc,const bf16*__restrict__ Vc,bf16*Oc,const float*btabm,char*shm){
  int lane; asm volatile("v_mbcnt_lo_u32_b32 %0, -1, 0\n\tv_mbcnt_hi_u32_b32 %0, -1, %0 ; dep %1":"=v"(lane):"s"(qb));
  const int tid=wid*64+lane,r32=lane&31,hi=lane>>5;
  const long rowbase=(long)b*SEQ; const int q0=qb*QB;
  const bf16*Qw=Qc+(rowbase+q0+wid*QBLK)*DM;
  const bf16*Kh=Kc+rowbase*DM,*Vh=Vc+rowbase*DM;
  const unsigned lds0=(unsigned)(uintptr_t)shm;
  float*wsf=(float*)(shm+LDS_WS)+wid*64;
  const float b31n=btabm[127*16]; const float b31l=b31n*1.4426950408889634f;
  { float*R=(float*)(shm+LDS_BT); for(int j=tid;j<BT_N;j+=NW*64){ int d=447-j; float v=0.f; if(d>=0&&d<127) v=(btabm[d*16]-b31n)*1.4426950408889634f; R[j]=v; } }
  const bf16*ksrc=Kh+(long)lane*DM+wid*8;
  const bf16*vsrc=Vh+(long)(16*(wid&3)+(lane>>2))*DM+(wid>>2)*32+(lane&3)*8;
  const unsigned kdst=lds0+LDS_K+wid*1024, vdst=lds0+LDS_V+wid*1024;
  #define DMA_K(t,slot) glds16(ksrc+(long)(t)*KVBLK*DM,(unsigned)__builtin_amdgcn_readfirstlane(kdst+(slot)))
  #define DMA_V(t,slot) do{ glds16(vsrc+(long)(t)*KVBLK*DM,(unsigned)__builtin_amdgcn_readfirstlane(vdst+2*(slot))); glds16(vsrc+64+(long)(t)*KVBLK*DM,(unsigned)__builtin_amdgcn_readfirstlane(vdst+2*(slot)+8192)); }while(0)
  const int vb0=(int)(lds0+LDS_V)+((lane>>4)&1)*32+(lane&3)*8+(4*hi+((lane&15)>>2))*64;
  const char*Kbase=shm+LDS_K; bf16x8 kf[8];
  const lds_cptr shm3=(lds_cptr)shm; const lds_cptr kp0=shm3+LDS_K+hi*1024+r32*16; const lds_cptr vp0=shm3+LDS_V+((lane>>4)&1)*32+(lane&3)*8+(4*hi+((lane&15)>>2))*64;
  const int NT=(q0+QB)/KVBLK;
  DMA_K(0,0);DMA_V(0,0);DMA_K(1,SLOTB);
  bf16x8 qr[4];
  #pragma unroll
  for(int d0=0;d0<4;++d0)qr[d0]=*reinterpret_cast<const bf16x8*>(&Qw[(long)r32*DM+d0*16+hi*8]);
  float mhat=0.f,l_reg=0.f;f32x16 o[4];o[0]=f32x16{};o[1]=f32x16{};o[2]=f32x16{};o[3]=f32x16{};
  const int qrel=wid*QBLK+r32;
  typedef __attribute__((address_space(3))) const float* lds_fptr;
  const lds_fptr Rl=(lds_fptr)((lds_cptr)shm+LDS_BT)+(447-(q0+qrel-4*hi));
  #define CBIAS(P0,P1,t) do{ const lds_fptr rp_=Rl+64*(t); \
    _Pragma("unroll") for(int g_=0;g_<4;++g_){ SBAR(); _Pragma("unroll") for(int r=4*g_;r<4*g_+4;++r){ P0[r]+=rp_[(r&3)+8*(r>>2)]; P1[r]+=rp_[32+(r&3)+8*(r>>2)]; } } SBAR(); }while(0)
  #define CMASK(P0,P1,t) do{ if((t)>=NT-7){ CBIAS(P0,P1,t); } int jb_=(t)-(NT-4); if(jb_>=0)cmask(P0,P1,jb_,qrel,hi);}while(0)
  bool resc=false;
  #define START(P0,P1) do{ const float rm=rowmax(P0,P1); resc=false; \
    { const float dl=rm; mhat=fadd_s(mhat,dl); \
      _Pragma("unroll") for(int r=0;r<16;++r){P0[r]=fsub_s(P0[r],dl);P1[r]=fsub_s(P1[r],dl);} \
      } \
    _Pragma("unroll") for(int r=0;r<16;++r)P0[r]=__builtin_amdgcn_exp2f(P0[r]); }while(0)
  #define RESC() do{ if(resc){ asm volatile("s_waitcnt lgkmcnt(0)":::"memory"); \
      _Pragma("unroll") for(int d_=0;d_<4;++d_) _Pragma("unroll") for(int r=0;r<16;++r)o[d_][r]*=wsf[crow(r,hi)]; } }while(0)
  f32x16 pA0,pA1,pB0,pB1;
  int sl_prev=0,sl_cur=0,sl_next=SLOTB;
  #define ROT() do{sl_prev=sl_cur;sl_cur=sl_next;sl_next=(sl_next==(NSLOT-1)*SLOTB)?0:sl_next+SLOTB;}while(0)
  DMA_K(2,2*SLOTB);
  WAIT_BAR(3);
  qkt(pA0,pA1,Kbase,qr,r32,hi);asm volatile("s_nop 15\n\ts_nop 7":"+v"(pA0),"+v"(pA1));
  #pragma unroll
  for(int r=0;r<16;++r){pA0[r]+=b31l;pA1[r]+=b31l;}
  CMASK(pA0,pA1,0);
  START(pA0,pA1);
  _Pragma("unroll") for(int r=0;r<16;++r)pA1[r]=__builtin_amdgcn_exp2f(pA1[r]);
  WAIT_BAR(0);
  DMA_K(3,0);DMA_V(1,SLOTB);
  ROT();
  kload8(kf,kp0+sl_cur);
  WAIT_BAR(3);
  s16x4 vfl0,vfl1,vfl2,vfl3,vfh0,vfh1,vfh2,vfh3; u32x4 pw0,pw1,pw2,pw3;
  #define PKW(P,B) cvtpk_s(P[B],P[B+1])
  #define PAF(k) __builtin_bit_cast(bf16x8,pw##k)
  #define VFRS(s_) (bf16x8){vfl##s_[0],vfl##s_[1],vfl##s_[2],vfl##s_[3],vfh##s_[0],vfh##s_[1],vfh##s_[2],vfh##s_[3]}
  #define PIN(x) asm volatile("":"+v"(x))
  #define MX3(a,b,c) __builtin_fmaxf(__builtin_fmaxf((a),(b)),(c))
  #define GAPA(MF,A0,A1,A2,A3,W0,W1,PW) do{ MF; sacc+=A0; sacc+=A1; sacc+=A2; sacc+=A3; PIN(sacc); W0; W1; PIN(PW); SBAR(); }while(0)
  #define EX(v) __builtin_amdgcn_exp2f(v)
  #define GAPB(MF,X,B) do{ MF; X[B]=EX(X[B]); X[B+1]=EX(X[B+1]); PIN(X); SBAR(); }while(0)
  #define VRF(s_,i) do{ vfl##s_=vtr(vp_+(((i)>>2)*4096+((i)&3)*1024)); vfh##s_=vtr(vp_+(((i)>>2)*4096+((i)&3)*1024+512)); }while(0)
  #define KRD(G,j) do{ if(G){ kload2(kf,kp0+sl_next,j); SBAR(); } }while(0)
  #define STEP(C0,C1,P0,P1,t,GK,GV,GL) do{ SBAR(); \
    const lds_cptr vp_=vp0+2*sl_prev; \
    float sacc=(P0[0]+P0[1]); \
    GAPA(C0=__builtin_amdgcn_mfma_f32_32x32x16_bf16(kf[0],qr[0],f32x16{},0,0,0), P0[2],P0[3],P0[4],P0[5],     pw0[0]=PKW(P0,0), pw0[1]=PKW(P0,2), pw0); \
    GAPA(C1=__builtin_amdgcn_mfma_f32_32x32x16_bf16(kf[1],qr[0],f32x16{},0,0,0), P0[6],P0[7],P0[8],P0[9],     pw0[2]=PKW(P0,4), pw0[3]=PKW(P0,6), pw0); \
    GAPA(C0=__builtin_amdgcn_mfma_f32_32x32x16_bf16(kf[2],qr[1],C0,0,0,0),   P0[10],P0[11],P0[12],P0[13], pw1[0]=PKW(P0,8), pw1[1]=PKW(P0,10), pw1); \
    GAPA(C1=__builtin_amdgcn_mfma_f32_32x32x16_bf16(kf[3],qr[1],C1,0,0,0),   P0[14],P0[15],P1[0],P1[1],   pw1[2]=PKW(P0,12),pw1[3]=PKW(P0,14), pw1); \
    GAPA(C0=__builtin_amdgcn_mfma_f32_32x32x16_bf16(kf[4],qr[2],C0,0,0,0),   P1[2],P1[3],P1[4],P1[5],     pw2[0]=PKW(P1,0), pw2[1]=PKW(P1,2), pw2); \
    GAPA(C1=__builtin_amdgcn_mfma_f32_32x32x16_bf16(kf[5],qr[2],C1,0,0,0),   P1[6],P1[7],P1[8],P1[9],     pw2[2]=PKW(P1,4), pw2[3]=PKW(P1,6), pw2); \
    GAPA(C0=__builtin_amdgcn_mfma_f32_32x32x16_bf16(kf[6],qr[3],C0,0,0,0),   P1[10],P1[11],P1[12],P1[13], pw3[0]=PKW(P1,8), pw3[1]=PKW(P1,10), pw3); \
    GAPA(C1=__builtin_amdgcn_mfma_f32_32x32x16_bf16(kf[7],qr[3],C1,0,0,0),   P1[14],P1[15],0.f,0.f,       pw3[2]=PKW(P1,12),pw3[3]=PKW(P1,14), pw3); \
    l_reg+=sacc; \
    VRF(0,0); VRF(1,4); VRF(2,8); SBAR(); \
    if(GK){DMA_K((t)+3,sl_cur);} if(GV){DMA_V((t)+1,sl_next);} \
    { const float nb_=b31l-mhat; _Pragma("unroll") for(int r=0;r<16;++r){C0[r]+=nb_;C1[r]+=nb_;} } \
    CMASK(C0,C1,t); \
    { float a=MX3(C0[0],C0[1],C1[0]),b=MX3(C0[2],C0[3],C1[1]); a=MX3(a,C1[2],C1[3]); \
      _Pragma("unroll") for(int r=4;r<16;r+=4){a=MX3(a,C0[r],C0[r+1]);b=MX3(b,C0[r+2],C0[r+3]);a=MX3(a,C1[r],C1[r+1]);b=MX3(b,C1[r+2],C1[r+3]);} \
      float rm=__builtin_fmaxf(a,b); { auto rr=__builtin_amdgcn_permlane32_swap(__float_as_uint(rm),__float_as_uint(rm),false,false); rm=__builtin_fmaxf(__uint_as_float(rr[0]),__uint_as_float(rr[1])); } \
      resc=false; \
      if(__builtin_expect(__any(rm>(float)THRL),0)){ const float dl=__builtin_fmaxf(rm,0.f); mhat+=dl; \
        _Pragma("unroll") for(int r=0;r<16;++r){C0[r]-=dl;C1[r]-=dl;} \
        const float f=__builtin_amdgcn_exp2f(-dl); l_reg*=f; { int r32b_=r32; asm volatile("":"+v"(r32b_)); if(hi==0)wsf[r32b_]=f; } resc=true; } } \
    SBAR(); \
    VRF(3,12); GAPB(o[0]=__builtin_amdgcn_mfma_f32_32x32x16_bf16(PAF(0),VFRS(0),o[0],0,0,0), C0,0); \
    VRF(0,1); GAPB(o[1]=__builtin_amdgcn_mfma_f32_32x32x16_bf16(PAF(0),VFRS(1),o[1],0,0,0), C0,2); \
    VRF(1,5); GAPB(o[2]=__builtin_amdgcn_mfma_f32_32x32x16_bf16(PAF(0),VFRS(2),o[2],0,0,0), C0,4); \
    VRF(2,9); GAPB(o[3]=__builtin_amdgcn_mfma_f32_32x32x16_bf16(PAF(0),VFRS(3),o[3],0,0,0), C0,6); \
    VRF(3,13); KRD(GL,0); GAPB(o[0]=__builtin_amdgcn_mfma_f32_32x32x16_bf16(PAF(1),VFRS(0),o[0],0,0,0), C0,8); \
    VRF(0,2); GAPB(o[1]=__builtin_amdgcn_mfma_f32_32x32x16_bf16(PAF(1),VFRS(1),o[1],0,0,0), C0,10); \
    VRF(1,6); KRD(GL,1); GAPB(o[2]=__builtin_amdgcn_mfma_f32_32x32x16_bf16(PAF(1),VFRS(2),o[2],0,0,0), C0,12); \
    VRF(2,10); GAPB(o[3]=__builtin_amdgcn_mfma_f32_32x32x16_bf16(PAF(1),VFRS(3),o[3],0,0,0), C0,14); \
    VRF(3,14); KRD(GL,2); GAPB(o[0]=__builtin_amdgcn_mfma_f32_32x32x16_bf16(PAF(2),VFRS(0),o[0],0,0,0), C1,0); \
    VRF(0,3); GAPB(o[1]=__builtin_amdgcn_mfma_f32_32x32x16_bf16(PAF(2),VFRS(1),o[1],0,0,0), C1,2); \
    VRF(1,7); KRD(GL,3); GAPB(o[2]=__builtin_amdgcn_mfma_f32_32x32x16_bf16(PAF(2),VFRS(2),o[2],0,0,0), C1,4); \
    VRF(2,11); GAPB(o[3]=__builtin_amdgcn_mfma_f32_32x32x16_bf16(PAF(2),VFRS(3),o[3],0,0,0), C1,6); \
    VRF(3,15); GAPB(o[0]=__builtin_amdgcn_mfma_f32_32x32x16_bf16(PAF(3),VFRS(0),o[0],0,0,0), C1,8); \
    GAPB(o[1]=__builtin_amdgcn_mfma_f32_32x32x16_bf16(PAF(3),VFRS(1),o[1],0,0,0), C1,10); \
    GAPB(o[2]=__builtin_amdgcn_mfma_f32_32x32x16_bf16(PAF(3),VFRS(2),o[2],0,0,0), C1,12); \
    GAPB(o[3]=__builtin_amdgcn_mfma_f32_32x32x16_bf16(PAF(3),VFRS(3),o[3],0,0,0), C1,14); \
    }while(0)
  int t=1;
  #undef CMASK
  #define CMASK(P0,P1,t) do{}while(0)
  for(;t+7<NT;t+=2){
    STEP(pB0,pB1,pA0,pA1,t,true,true,true);     WAIT_BAR(3); RESC(); ROT();
    STEP(pA0,pA1,pB0,pB1,t+1,true,true,true);   WAIT_BAR(3); RESC(); ROT();
  }
  #undef CMASK
  #define CMASK(P0,P1,t) do{ CBIAS(P0,P1,t); int jb_=(t)-(NT-4); if(jb_>=0)cmask(P0,P1,jb_,qrel,hi);}while(0)
  #define ENDW(tt) do{ if((tt)+3<NT){WAIT_BAR(3);} else if((tt)+2<NT){WAIT_BAR(2);} else {WAIT_BAR(0);} }while(0)
  for(;t+1<NT;t+=2){
    STEP(pB0,pB1,pA0,pA1,t,(t+3<NT),(t+1<NT),(t+1<NT));       ENDW(t);   RESC(); ROT();
    STEP(pA0,pA1,pB0,pB1,t+1,(t+4<NT),(t+2<NT),(t+2<NT));     ENDW(t+1); RESC(); ROT();
  }
  STEP(pB0,pB1,pA0,pA1,NT-1,false,false,false); RESC();
  { float sacc=pB0[0]+pB0[1]; _Pragma("unroll") for(int r=2;r<16;++r)sacc+=pB0[r]; _Pragma("unroll") for(int r=0;r<16;++r)sacc+=pB1[r]; l_reg+=sacc;
    pw0=(u32x4){PKW(pB0,0),PKW(pB0,2),PKW(pB0,4),PKW(pB0,6)};pw1=(u32x4){PKW(pB0,8),PKW(pB0,10),PKW(pB0,12),PKW(pB0,14)};pw2=(u32x4){PKW(pB1,0),PKW(pB1,2),PKW(pB1,4),PKW(pB1,6)};pw3=(u32x4){PKW(pB1,8),PKW(pB1,10),PKW(pB1,12),PKW(pB1,14)};
    SBAR(); pv(o,vb0+2*sl_cur,PAF(0),PAF(1),PAF(2),PAF(3)); }
  #undef PKW
  #undef PAF
  #undef VFRS
  #undef PIN
  #undef MX3
  #undef GAPA
  #undef GAPB
  #undef EX
  #undef VRF
  #undef KRD
  #undef STEP
  #undef ENDW
  {auto rr=__builtin_amdgcn_permlane32_swap(__float_as_uint(l_reg),__float_as_uint(l_reg),false,false);l_reg=__uint_as_float(rr[0])+__uint_as_float(rr[1]);}
  if(hi==0)wsf[32+r32]=l_reg;asm volatile("s_waitcnt lgkmcnt(0)":::"memory");
  float rli[16];
  #pragma unroll
  for(int r=0;r<16;++r)rli[r]=__builtin_amdgcn_rcpf(wsf[32+crow(r,hi)]);
  bf16*Ow=Oc+(long)(wid*QBLK)*OPITCH;
  { bf16*stg=(bf16*)(shm+LDS_OST)+wid*4096;
    #pragma unroll
    for(int r=0;r<16;++r){const int orow=crow(r,hi);
      #pragma unroll
      for(int d0=0;d0<4;++d0)stg[orow*128+d0*32+r32]=__float2bfloat16(o[d0][r]*rli[r]);}
    asm volatile("s_waitcnt lgkmcnt(0)":::"memory");
    #pragma unroll
    for(int i=0;i<8;++i){const int row=i*4+(lane>>4),ch=lane&15; const u32x4 v=*(const u32x4*)(stg+row*128+ch*8); ATTN_STORE16(Ow+(long)row*OPITCH+ch*8,v);} }
  asm volatile("s_waitcnt lgkmcnt(0)\n\ts_barrier":::"memory");
  #undef DMA_K
  #undef DMA_V
  #undef CMASK
  #undef CBIAS
  #undef START
  #undef RESC
  #undef ROT
}
constexpr int ATTN_LDS_BYTES=LDS_BYTES;
#undef SBAR
#undef WAIT_BAR
}

namespace topk {
typedef short bf16x8 __attribute__((ext_vector_type(8)));
typedef float f32x16 __attribute__((ext_vector_type(16)));
#define TK_WL4(wa_, wb_, a0_, a1_, b0_, b1_, j0) asm volatile("s_nop 3\n\tv_writelane_b32 %0, %2, %6\n\tv_writelane_b32 %0, %3, %7\n\tv_writelane_b32 %1, %4, %6\n\tv_writelane_b32 %1, %5, %7" : "+v"(wa_), "+v"(wb_) : "s"(a0_), "s"(a1_), "s"(b0_), "s"(b1_), "n"(j0), "n"((j0) + 1))
__device__ __forceinline__ unsigned fkey(float f) { const unsigned u = __float_as_uint(f); return (u & 0x80000000u) ? ~u : (u | 0x80000000u); }
template <int CTRL> __device__ __forceinline__ unsigned dpp_u(unsigned v) { return (unsigned)__builtin_amdgcn_update_dpp(0, (int)v, CTRL, 0xF, 0xF, true); }
__device__ __forceinline__ unsigned wsum_u(unsigned v) {
    v += dpp_u<0xB1>(v); v += dpp_u<0x4E>(v); v += dpp_u<0x141>(v); v += dpp_u<0x140>(v);
    auto r = __builtin_amdgcn_permlane16_swap(v, v, false, false); v = r[0] + r[1];
    auto r2 = __builtin_amdgcn_permlane32_swap(v, v, false, false); return r2[0] + r2[1];
}
__device__ __forceinline__ void unit(const bf16* __restrict__ qq, const bf16* __restrict__ ki, const float* __restrict__ wi, unsigned* __restrict__ sel, int b, int t0, LAS unsigned* keys, int wave, int lane) {
    if (t0 + 15 < TOPK) {
#pragma unroll
        for (int q = 0; q < 2; ++q) { const int t = t0 + 2 * wave + q, lo = 32 * lane; unsigned w = 0u; if (lo + 31 <= t) w = 0xffffffffu; else if (lo <= t) w = (2u << (t - lo)) - 1u;
            sel[((size_t)b * L + t) * 64 + lane] = w; }
        return;
    }
    const int jd = (t0 + 15) >> 5;
#ifndef TK_REP_SCORE
#define TK_REP_SCORE 1
#endif
#ifndef TK_REP_SEL
#define TK_REP_SEL 1
#endif
    for (int rs_ = 0; rs_ < TK_REP_SCORE; ++rs_) {
        const int c = lane & 31, hf = lane >> 5;
        const int qa = ((c >> 4) << 1) | ((c >> 2) & 1), ha = (c & 3) | (((c >> 3) & 1) << 2);
        bf16x8 af[4][4]; float wA[4][8], wB[4][8];
#pragma unroll
        for (int rg = 0; rg < 4; ++rg) {
            const bf16* ap = qq + ((size_t)b * L + t0 + 4 * rg + qa) * NQQ + ha * 64 + 32 * hf;
#pragma unroll
            for (int s = 0; s < 4; ++s) af[rg][s] = *(const bf16x8*)(ap + 8 * s);
            const f32x4* wp = (const f32x4*)(wi + ((size_t)b * L + t0 + 4 * rg + hf) * 8); const f32x4 w0 = wp[0], w1 = wp[1], w2 = wp[4], w3 = wp[5];
#pragma unroll
            for (int k = 0; k < 4; ++k) { wA[rg][k] = w0[k]; wA[rg][4 + k] = w1[k]; wB[rg][k] = w2[k]; wB[rg][4 + k] = w3[k]; }
        }
        const bf16* kp = ki + ((size_t)b * L + c) * 64 + 32 * hf;
        bf16x8 bn[4];
        if (wave <= jd) {
#pragma unroll
            for (int s = 0; s < 4; ++s) bn[s] = *(const bf16x8*)(kp + (size_t)wave * 32 * 64 + 8 * s);
        }
        for (int j = wave; j <= jd; j += 8) {
            bf16x8 bc[4];
#pragma unroll
            for (int s = 0; s < 4; ++s) bc[s] = bn[s];
            if (j + 8 <= jd) {
#pragma unroll
                for (int s = 0; s < 4; ++s) bn[s] = *(const bf16x8*)(kp + (size_t)(j + 8) * 32 * 64 + 8 * s);
            }
            const int key = 32 * j + c;
#pragma unroll
            for (int rg = 0; rg < 4; ++rg) {
                f32x16 acc = {};
#pragma unroll
                for (int s = 0; s < 4; ++s) acc = __builtin_amdgcn_mfma_f32_32x32x16_bf16(af[rg][s], bc[s], acc, 0, 0, 0);
                float sa = 0.f, sb = 0.f;
#pragma unroll
                for (int h = 0; h < 8; ++h) { sa += wA[rg][h] * __builtin_amdgcn_fmed3f(acc[h], 0.f, __builtin_inff()); sb += wB[rg][h] * __builtin_amdgcn_fmed3f(acc[8 + h], 0.f, __builtin_inff()); }
                const int tA = t0 + 4 * rg + hf, tB = tA + 2;
                LAS unsigned* kA = keys + (4 * rg + hf) * 2048 + key;
                kA[0] = key > tA ? 0u : fkey(sa); kA[2 * 2048] = key > tB ? 0u : fkey(sb);
            }
        }
    }
    __syncthreads();
    for (int rs_ = 0; rs_ < TK_REP_SEL; ++rs_) {
        const int nvalid = 32 * (jd + 1);
        unsigned kA[32], kB[32];
        const LAS unsigned* pa = keys + (2 * wave) * 2048 + lane; const LAS unsigned* pb = pa + 2048;
#pragma unroll
        for (int i = 0; i < 32; ++i) { const bool ok = 64 * i + lane < nvalid; kA[i] = ok ? pa[64 * i] : 0u; kB[i] = ok ? pb[64 * i] : 0u; }
        const int ilim = (nvalid + 63) >> 6;
        unsigned pA = 0u, pB = 0u; bool doneA = false, doneB = false;
        for (int bit = 31; bit >= 0; --bit) {
            const unsigned cA = pA | (1u << bit), cB = pB | (1u << bit); unsigned cnt = 0u;
#pragma unroll
            for (int g4 = 0; g4 < 8; ++g4) { if (4 * g4 < ilim) {
#pragma unroll
                for (int i = 4 * g4; i < 4 * g4 + 4; ++i) { cnt += (kA[i] >= cA) ? 1u : 0u; cnt += (kB[i] >= cB) ? 0x10000u : 0u; } __builtin_amdgcn_sched_barrier(0); } }
            cnt = wsum_u(cnt);
            const unsigned nA = cnt & 0xffffu, nB = cnt >> 16;
            if (!doneA && nA >= (unsigned)TOPK) pA = cA;
            if (!doneB && nB >= (unsigned)TOPK) pB = cB;
            doneA = doneA || nA == (unsigned)TOPK; doneB = doneB || nB == (unsigned)TOPK;
            if (doneA && doneB) break;
        }
        unsigned cge = 0u, cgt = 0u;
#pragma unroll
        for (int i = 0; i < 32; ++i) { cge += (kA[i] >= pA) ? 1u : 0u; cge += (kB[i] >= pB) ? 0x10000u : 0u; cgt += (kA[i] > pA) ? 1u : 0u; cgt += (kB[i] > pB) ? 0x10000u : 0u; if ((i & 3) == 3) __builtin_amdgcn_sched_barrier(0); }
        cge = wsum_u(cge); cgt = wsum_u(cgt);
        asm volatile("" : "+v"(pA), "+v"(pB));
        const bool tie = (cge & 0xffffu) != (unsigned)TOPK || (cge >> 16) != (unsigned)TOPK;
        unsigned wa = 0u, wb = 0u;
        if (!tie) {
#pragma unroll
            for (int i = 0; i < 32; ++i) {
                const unsigned long long mA = __builtin_amdgcn_ballot_w64(kA[i] >= pA), mB = __builtin_amdgcn_ballot_w64(kB[i] >= pB);
                const unsigned a0 = (unsigned)mA, a1 = (unsigned)(mA >> 32), b0 = (unsigned)mB, b1 = (unsigned)(mB >> 32);
                TK_WL4(wa, wb, a0, a1, b0, b1, 2 * i); __builtin_amdgcn_sched_barrier(0);
            }
        } else {
            const unsigned needA = (unsigned)TOPK - (cgt & 0xffffu), needB = (unsigned)TOPK - (cgt >> 16); unsigned runA = 0u, runB = 0u;
            const unsigned long long below = (1ull << lane) - 1ull;
#pragma unroll
            for (int i = 0; i < 32; ++i) {
                const unsigned long long eA = __builtin_amdgcn_ballot_w64(kA[i] == pA), eB = __builtin_amdgcn_ballot_w64(kB[i] == pB);
                const bool tkA = kA[i] > pA || (kA[i] == pA && runA + (unsigned)__builtin_popcountll(eA & below) < needA);
                const bool tkB = kB[i] > pB || (kB[i] == pB && runB + (unsigned)__builtin_popcountll(eB & below) < needB);
                runA += (unsigned)__builtin_popcountll(eA); runB += (unsigned)__builtin_popcountll(eB);
                const unsigned long long mA = __builtin_amdgcn_ballot_w64(tkA), mB = __builtin_amdgcn_ballot_w64(tkB);
                const unsigned a0 = (unsigned)mA, a1 = (unsigned)(mA >> 32), b0 = (unsigned)mB, b1 = (unsigned)(mB >> 32);
                TK_WL4(wa, wb, a0, a1, b0, b1, 2 * i); __builtin_amdgcn_sched_barrier(0);
            }
        }
        unsigned* so = sel + ((size_t)b * L + t0 + 2 * wave) * 64 + lane;
        so[0] = wa; so[64] = wb;
    }
    __syncthreads();
}
#undef TK_WL4
}

namespace sparse {
typedef short bf16x8 __attribute__((ext_vector_type(8)));
typedef short s16x4 __attribute__((ext_vector_type(4)));
typedef float f32x4 __attribute__((ext_vector_type(4)));
typedef int i32x4 __attribute__((ext_vector_type(4)));
typedef unsigned u32x4 __attribute__((ext_vector_type(4)));
typedef __attribute__((address_space(3))) const char* lds_cptr;
typedef short v4i16_t __attribute__((ext_vector_type(4)));
constexpr int BUF = 8192, LIST = 1024, WAVE_LDS = 2 * BUF + 2 * LIST, BT_OFF = 8 * WAVE_LDS, LDS_NEED = BT_OFF + 8192;
__device__ __forceinline__ int fsw(int r) { return ((((r & 7) ^ ((r >> 3) << 2))) << 1) | (r >> 3); }
__device__ __forceinline__ void glds16(const void* gsrc, unsigned lds_dst) { unsigned keep;
    asm volatile("s_mov_b32 %0, m0\n\ts_mov_b32 m0, %2\n\ts_nop 0\n\tglobal_load_lds_dwordx4 %1, off\n\ts_mov_b32 m0, %0" : "=&s"(keep) : "v"(gsrc), "s"(lds_dst) : "memory"); }
__device__ __forceinline__ s16x4 vtr(lds_cptr p) { return __builtin_bit_cast(s16x4, __builtin_amdgcn_ds_read_tr16_b64_v4i16((__attribute__((address_space(3))) v4i16_t*)p)); }
__device__ __forceinline__ float xmax16(float v) { auto r = __builtin_amdgcn_permlane16_swap(__float_as_uint(v), __float_as_uint(v), false, false); return fmaxf(__uint_as_float(r[0]), __uint_as_float(r[1])); }
__device__ __forceinline__ float xmax32(float v) { auto r = __builtin_amdgcn_permlane32_swap(__float_as_uint(v), __float_as_uint(v), false, false); return fmaxf(__uint_as_float(r[0]), __uint_as_float(r[1])); }
__device__ __forceinline__ unsigned cvtpk(float lo, float hi) { typedef float f2 __attribute__((ext_vector_type(2))); typedef __bf16 b2 __attribute__((ext_vector_type(2))); f2 v = {lo, hi}; b2 b = __builtin_convertvector(v, b2); return __builtin_bit_cast(unsigned, b); }
template <int CTRL> __device__ __forceinline__ int dpp_i(int v) { return __builtin_amdgcn_update_dpp(0, v, CTRL, 0xF, 0xF, true); }

__device__ __forceinline__ int expand(unsigned word, int t, unsigned* list, int lane) {
    const int cntl = __builtin_popcount(word);
    int v = cntl;
    v += __builtin_amdgcn_update_dpp(0, v, 0x111, 0xF, 0xF, true);
    v += __builtin_amdgcn_update_dpp(0, v, 0x112, 0xF, 0xF, true);
    v += __builtin_amdgcn_update_dpp(0, v, 0x114, 0xF, 0xF, true);
    v += __builtin_amdgcn_update_dpp(0, v, 0x118, 0xF, 0xF, true);
    v += __builtin_amdgcn_update_dpp(0, v, 0x142, 0xA, 0xF, true);
    v += __builtin_amdgcn_update_dpp(0, v, 0x143, 0xC, 0xF, true);
    const int total = __builtin_amdgcn_readlane(v, 63);
    int slot = v - cntl; unsigned w = word;
    const int maxc = total;
    while (__builtin_amdgcn_ballot_w64(w != 0u) != 0ull) {
        if (w != 0u) { const int bpos = __builtin_ctz(w); w &= w - 1u; const int key = 32 * lane + bpos;
            if (slot < 256) { int d = t - key; d = d > 127 ? 127 : d; list[slot] = ((unsigned)key << 8) | ((unsigned)d << 24); }
            ++slot; }
    }
    (void)maxc;
    { const int s = total + (lane & 31); if (lane < 32 && s < 256) list[s] = 0u; }
    return total < 256 ? total : 256;
}

__device__ __forceinline__ void stream(const bf16* __restrict__ qq, const bf16* __restrict__ ckv, const unsigned* __restrict__ sel, bf16* __restrict__ olat, int q0, int nq, char* wl, const float* btl, int lane) {
    const int hd = lane & 15, quad = lane >> 4;
    const unsigned lds0 = (unsigned)(uintptr_t)wl; const lds_cptr wl3 = (lds_cptr)wl;
    unsigned* lists = (unsigned*)(wl + 2 * BUF);
    const int fk = fsw(hd);
    const int qp_ = hd >> 2, pp_ = hd & 3, rv = 4 * quad + qp_, fv = fsw(rv);
    int swz[4];
#pragma unroll
    for (int i = 0; i < 4; ++i) swz[i] = 16 * (hd ^ fsw(4 * i + quad));
    const lds_cptr btl3 = (lds_cptr)(const char*)btl + 4 * hd;
#define SP_DMA(gb, li, ch, bufoff) do { const unsigned* l_ = lists + (li) * 256 + 32 * (ch) + quad; _Pragma("unroll") for (int i_ = 0; i_ < 8; ++i_) { \
        glds16((const char*)(gb) + ((l_[4 * i_] & 0xffffffu) + (unsigned)swz[i_ & 3]), (unsigned)__builtin_amdgcn_readfirstlane(lds0 + (bufoff) + 1024 * i_)); } } while (0)
#define SP_LOADQ(dst, row) do { const bf16* qp__ = qq + (size_t)(row) * NQQ + 512 + hd * 128 + 8 * quad; _Pragma("unroll") for (int s_ = 0; s_ < 4; ++s_) dst[s_] = *(const bf16x8*)(qp__ + 32 * s_); } while (0)
    bf16x8 qf[4], qfn[4]; unsigned wnext = 0u; int ncur, nnext = 0, li = 0, bufsel = 0;
    {
        SP_LOADQ(qf, q0);
        const unsigned w0 = sel[(size_t)q0 * 64 + lane];
        if (nq > 1) wnext = sel[(size_t)(q0 + 1) * 64 + lane];
        ncur = expand(w0, q0 % L, lists, lane);
        asm volatile("s_waitcnt lgkmcnt(0)" ::: "memory");
        SP_DMA(ckv + (size_t)(q0 / L) * L * 128, 0, 0, 0);
    }
    for (int qi = 0; qi < nq; ++qi) {
        const int row = q0 + qi, b = row / L, t = row % L, nch = (ncur + 31) >> 5;
        if (qi + 1 < nq) {
            nnext = expand(wnext, (row + 1) % L, lists + (li ^ 1) * 256, lane);
            SP_LOADQ(qfn, row + 1);
            if (qi + 2 < nq) wnext = sel[(size_t)(row + 2) * 64 + lane];
            asm volatile("s_waitcnt lgkmcnt(0)" ::: "memory");
        }
        f32x4 o[8];
#pragma unroll
        for (int rb = 0; rb < 8; ++rb) o[rb] = (f32x4){0.f, 0.f, 0.f, 0.f};
        float mref = -INFINITY, lsum = 0.f;
        const unsigned* dl = lists + li * 256 + 4 * quad;
        for (int ch = 0; ch < nch; ++ch) {
            const int bo = bufsel * BUF;
            if (ch + 1 < nch) { SP_DMA(ckv + (size_t)b * L * 128, li, ch + 1, BUF - bo); asm volatile("s_waitcnt vmcnt(8)" ::: "memory"); }
            else if (qi + 1 < nq) { SP_DMA(ckv + (size_t)((row + 1) / L) * L * 128, li ^ 1, 0, BUF - bo); asm volatile("s_waitcnt vmcnt(8)" ::: "memory"); }
            else asm volatile("s_waitcnt vmcnt(0)" ::: "memory");
            f32x4 sc[2];
#pragma unroll
            for (int T = 0; T < 2; ++T) { f32x4 acc = {0.f, 0.f, 0.f, 0.f}; const lds_cptr kr = wl3 + bo + 256 * (16 * T + hd);
#pragma unroll
                for (int s = 0; s < 4; ++s) { const bf16x8 kf = *(const __attribute__((address_space(3))) bf16x8*)(kr + 16 * ((4 * s + quad) ^ fk));
                    acc = __builtin_amdgcn_mfma_f32_16x16x32_bf16(kf, qf[s], acc, 0, 0, 0); }
                sc[T] = acc; }
#pragma unroll
            for (int T = 0; T < 2; ++T) { const u32x4 dx = *(const u32x4*)(dl + 32 * ch + 16 * T);
#pragma unroll
                for (int r = 0; r < 4; ++r) sc[T][r] += *(const __attribute__((address_space(3))) float*)(btl3 + ((dx[r] >> 18) & 0x3fc0u)); }
            if (ch == nch - 1 && (ncur & 31)) {
#pragma unroll
                for (int T = 0; T < 2; ++T)
#pragma unroll
                    for (int r = 0; r < 4; ++r) if (32 * ch + 16 * T + 4 * quad + r >= ncur) sc[T][r] = -INFINITY;
            }
            float mloc = fmaxf(fmaxf(fmaxf(sc[0][0], sc[0][1]), fmaxf(sc[0][2], sc[0][3])), fmaxf(fmaxf(sc[1][0], sc[1][1]), fmaxf(sc[1][2], sc[1][3])));
            mloc = xmax32(xmax16(mloc));
            if (__builtin_amdgcn_ballot_w64(mloc > mref + 8.f) != 0ull) {
                const float mn = fmaxf(mref, mloc), f = __builtin_amdgcn_exp2f(mref - mn); mref = mn; lsum *= f;
#pragma unroll
                for (int rb = 0; rb < 8; ++rb) o[rb] = o[rb] * f;
            }
            float p0[4], p1[4];
#pragma unroll
            for (int r = 0; r < 4; ++r) { p0[r] = __builtin_amdgcn_exp2f(sc[0][r] - mref); p1[r] = __builtin_amdgcn_exp2f(sc[1][r] - mref); lsum += p0[r] + p1[r]; }
            const u32x4 pw = {cvtpk(p0[0], p0[1]), cvtpk(p0[2], p0[3]), cvtpk(p1[0], p1[1]), cvtpk(p1[2], p1[3])};
            const bf16x8 pb = __builtin_bit_cast(bf16x8, pw);
            const lds_cptr v0p = wl3 + bo + 256 * rv + 8 * (pp_ & 1), v1p = v0p + 256 * 16;
#pragma unroll
            for (int rb = 0; rb < 8; ++rb) { const int pos = 16 * ((2 * rb + (pp_ >> 1)) ^ fv);
                const s16x4 a0 = vtr(v0p + pos), a1 = vtr(v1p + pos);
                const bf16x8 va = {a0[0], a0[1], a0[2], a0[3], a1[0], a1[1], a1[2], a1[3]};
                o[rb] = __builtin_amdgcn_mfma_f32_16x16x32_bf16(va, pb, o[rb], 0, 0, 0); }
            bufsel ^= 1;
        }
        lsum = xsum32(xsum16(lsum));
        const float inv = __builtin_amdgcn_rcpf(lsum);
        {
            const int so = (bufsel ^ 1) * BUF; typedef unsigned u32x2v __attribute__((ext_vector_type(2)));
            char* st = wl + so + hd * 272 + 8 * quad;
#pragma unroll
            for (int rb = 0; rb < 8; ++rb) { const u32x2v w = {cvtpk(o[rb][0] * inv, o[rb][1] * inv), cvtpk(o[rb][2] * inv, o[rb][3] * inv)}; *(u32x2v*)(st + 32 * rb) = w; }
            asm volatile("s_waitcnt lgkmcnt(0)" ::: "memory");
            const __amdgpu_buffer_rsrc_t orr = __builtin_amdgcn_make_buffer_rsrc((void*)olat, 0, 0x7ffffff0, 0x00020000); const int ob_ = row * 4096;
#pragma unroll
            for (int i = 0; i < 4; ++i) { const int c = lane + 64 * i; const u32x4 v = *(const u32x4*)(wl + so + (c >> 4) * 272 + (c & 15) * 16); __builtin_amdgcn_raw_buffer_store_b128(v, orr, ob_ + 16 * c, 0, 16); }
        }
        li ^= 1; ncur = nnext;
#pragma unroll
        for (int s = 0; s < 4; ++s) qf[s] = qfn[s];
    }
    asm volatile("s_waitcnt lgkmcnt(0)" ::: "memory");
#undef SP_DMA
#undef SP_LOADQ
}
}

namespace topk2 {
typedef short bf16x8 __attribute__((ext_vector_type(8)));
typedef float f32x4 __attribute__((ext_vector_type(4)));
__device__ __forceinline__ unsigned fkey(float f) { const unsigned u = __float_as_uint(f); return (u & 0x80000000u) ? ~u : (u | 0x80000000u); }
__device__ __forceinline__ float relu(float v) { return __builtin_amdgcn_fmed3f(v, 0.f, __builtin_inff()); }
template <int CTRL> __device__ __forceinline__ unsigned dpp_u(unsigned v) { return (unsigned)__builtin_amdgcn_update_dpp(0, (int)v, CTRL, 0xF, 0xF, true); }
__device__ __forceinline__ unsigned half_sum(unsigned v) {
    v += dpp_u<0xB1>(v); v += dpp_u<0x4E>(v); v += dpp_u<0x141>(v); v += dpp_u<0x140>(v);
    auto r = __builtin_amdgcn_permlane16_swap(v, v, false, false); return r[0] + r[1];
}
#define TK2_WL2(w0_, w1_, a0_, a1_, j0) asm volatile("s_nop 3\n\tv_writelane_b32 %0, %2, %4\n\tv_writelane_b32 %1, %3, %4" : "+v"(w0_), "+v"(w1_) : "s"(a0_), "s"(a1_), "n"(j0))
__device__ __forceinline__ void pair(const bf16* __restrict__ qq, const bf16* __restrict__ ki, const float* __restrict__ wi, unsigned* __restrict__ sel, int b, int t0, int lane) {
    const int hd16 = lane & 15, quad = lane >> 4, hf = lane >> 5, qd1 = quad & 1;
    unsigned* so = sel + ((size_t)b * L + t0) * 64 + lane;
    if (t0 + 1 < TOPK) {
#pragma unroll
        for (int q = 0; q < 2; ++q) { const int t = t0 + q, lo = 32 * lane; unsigned w = 0u; if (lo + 31 <= t) w = 0xffffffffu; else if (lo <= t) w = (2u << (t - lo)) - 1u; so[q * 64] = w; }
        return;
    }
    bf16x8 af[2];
    { const bf16* ap = qq + ((size_t)b * L + t0 + (hd16 >> 3)) * NQQ + (hd16 & 7) * 64 + 16 * quad; af[0] = *(const bf16x8*)ap; af[1] = *(const bf16x8*)(ap + 8); }
    const f32x4 w4 = *(const f32x4*)(wi + ((size_t)b * L + t0 + hf) * 8 + 4 * qd1);
    const int tq = t0 + hf, tmax = t0 + 1;
    const bf16* kp = ki + ((size_t)b * L + hd16) * 64 + 16 * quad;
    unsigned kr[64];
    bf16x8 bb[2][4][2];
#define TK2_LOADG(g, buf) do { _Pragma("unroll") for (int tt_ = 0; tt_ < 4; ++tt_) { bb[buf][tt_][0] = *(const bf16x8*)(kp + (size_t)(4 * (g) + tt_) * 1024); bb[buf][tt_][1] = *(const bf16x8*)(kp + (size_t)(4 * (g) + tt_) * 1024 + 8); } } while (0)
#ifndef TK2_REP_SCORE
#define TK2_REP_SCORE 1
#endif
#ifndef TK2_REP_SEL
#define TK2_REP_SEL 1
#endif
    for (int rs_ = 0; rs_ < TK2_REP_SCORE; ++rs_) {
    TK2_LOADG(0, 0);
#pragma unroll
    for (int g = 0; g < 32; ++g) {
        if (64 * g <= tmax) {
            if (g + 1 < 32) { if (64 * (g + 1) <= tmax) TK2_LOADG(g + 1, (g + 1) & 1); }
#pragma unroll
            for (int pr = 0; pr < 2; ++pr) {
                f32x4 aE = {0.f, 0.f, 0.f, 0.f}, aO = {0.f, 0.f, 0.f, 0.f};
                aE = __builtin_amdgcn_mfma_f32_16x16x32_bf16(af[0], bb[g & 1][2 * pr][0], aE, 0, 0, 0); aO = __builtin_amdgcn_mfma_f32_16x16x32_bf16(af[0], bb[g & 1][2 * pr + 1][0], aO, 0, 0, 0);
                aE = __builtin_amdgcn_mfma_f32_16x16x32_bf16(af[1], bb[g & 1][2 * pr][1], aE, 0, 0, 0); aO = __builtin_amdgcn_mfma_f32_16x16x32_bf16(af[1], bb[g & 1][2 * pr + 1][1], aO, 0, 0, 0);
                float pE = w4[0] * relu(aE[0]), pO = w4[0] * relu(aO[0]);
#pragma unroll
                for (int r = 1; r < 4; ++r) { pE += w4[r] * relu(aE[r]); pO += w4[r] * relu(aO[r]); }
                pE = xsum16(pE); pO = xsum16(pO);
                const float sv = qd1 ? pO : pE;
                const int key = 32 * (2 * g + pr) + (lane & 31);
                kr[2 * g + pr] = key > tq ? 0u : fkey(sv);
            }
        } else { kr[2 * g] = 0u; kr[2 * g + 1] = 0u; }
    }
    }
#undef TK2_LOADG
    const int ilim = (tmax + 32) >> 5;
    unsigned pfx = 0u; bool done = false;
    for (int rs_ = 0; rs_ < TK2_REP_SEL; ++rs_) { pfx = 0u; done = false; asm volatile("" : "+v"(pfx));
    for (int bit = 31; bit >= 0; --bit) {
        const unsigned cand = pfx | (1u << bit); unsigned cnt = 0u;
#pragma unroll
        for (int g4 = 0; g4 < 16; ++g4) { if (4 * g4 < ilim) {
#pragma unroll
            for (int i = 4 * g4; i < 4 * g4 + 4; ++i) cnt += (kr[i] >= cand) ? 1u : 0u; } }
        cnt = half_sum(cnt);
        if (!done && cnt >= (unsigned)TOPK) pfx = cand;
        done = done || cnt == (unsigned)TOPK;
        if (__builtin_amdgcn_ballot_w64(!done) == 0ull) break;
    }
    }
    unsigned cge = 0u, cgt = 0u;
#pragma unroll
    for (int i = 0; i < 64; ++i) { cge += (kr[i] >= pfx) ? 1u : 0u; cgt += (kr[i] > pfx) ? 1u : 0u; }
    cge = half_sum(cge); cgt = half_sum(cgt);
    asm volatile("" : "+v"(pfx));
    const bool tie = __builtin_amdgcn_ballot_w64(cge != (unsigned)TOPK) != 0ull;
    unsigned w0 = 0u, w1 = 0u;
    if (!tie) {
#pragma unroll
        for (int i = 0; i < 64; ++i) { const unsigned long long m = __builtin_amdgcn_ballot_w64(kr[i] >= pfx); const unsigned m0 = (unsigned)m, m1 = (unsigned)(m >> 32);
            TK2_WL2(w0, w1, m0, m1, i); __builtin_amdgcn_sched_barrier(0); }
    } else {
        const unsigned need = (unsigned)TOPK - cgt; unsigned run = 0u; const unsigned below = (1u << (lane & 31)) - 1u;
#pragma unroll
        for (int i = 0; i < 64; ++i) { const unsigned long long e = __builtin_amdgcn_ballot_w64(kr[i] == pfx); const unsigned eh = hf ? (unsigned)(e >> 32) : (unsigned)e;
            const bool tk = kr[i] > pfx || (kr[i] == pfx && run + (unsigned)__builtin_popcount(eh & below) < need);
            run += (unsigned)__builtin_popcount(eh);
            const unsigned long long m = __builtin_amdgcn_ballot_w64(tk); const unsigned m0 = (unsigned)m, m1 = (unsigned)(m >> 32);
            TK2_WL2(w0, w1, m0, m1, i); __builtin_amdgcn_sched_barrier(0); }
    }
    so[0] = w0; so[64] = w1;
}
#undef TK2_WL2
}

constexpr int NWAVES = 8;
constexpr int RING_OFF = 0, RING_BYTES = 131072;
constexpr int LDSCTL_OFF = 162816, MISC_OFF = LDSCTL_OFF + 320;
constexpr int LDS_BYTES = 163840;
static_assert(sparse::LDS_NEED <= LDSCTL_OFF && attn2::ATTN_LDS_BYTES <= LDSCTL_OFF, "phase LDS");
enum { PH_PRO = 0, PH_PRE0, PH_INPROJ0, PH_QGEMM, PH_TOPK, PH_SPARSE, PH_UV, PH_OUT0, PH_POST0, PH_INPROJ1, PH_ATTN1, PH_OUT1, PH_FINAL, N_PHASES };

struct Args { const float* in[N_IN]; float* out; unsigned char* ws; int ph_lo, ph_hi, li, pad; };

__device__ __forceinline__ int fresh_lane(int dep = 0) { int l; asm volatile("v_mbcnt_lo_u32_b32 %0, -1, 0\n\tv_mbcnt_hi_u32_b32 %0, -1, %0 ; dep %1" : "=v"(l) : "s"(dep)); return l; }
__device__ __forceinline__ float wave_sum(float v) { return wave_sum_all(v); }
template <bool HAS_G> __device__ __forceinline__ void p0_transpose_item(const float* W, int K, int N, int Npad, const float* g, bf16* WT, LAS float* scr, int item, int lane) {
    const int nblk = Npad / 32, kb = item / nblk, nb = item % nblk, k0 = 64 * kb, n0 = 32 * nb;
    const bool ok = (n0 + (lane & 31)) < N; const int nc = ok ? n0 + (lane & 31) : N - 1;
    const float* wp = W + (size_t)(k0 + (lane >> 5)) * N + nc; float v[32];
#pragma unroll
    for (int i = 0; i < 32; ++i) v[i] = wp[(size_t)(2 * i) * N];
    if (HAS_G) {
#pragma unroll
        for (int i = 0; i < 32; ++i) v[i] *= g[k0 + 2 * i + (lane >> 5)];
    }
#pragma unroll
    for (int i = 0; i < 32; ++i) scr[(2 * i + (lane >> 5)) * 33 + (lane & 31)] = ok ? v[i] : 0.f;
    LDS_WAIT(); asm volatile("" ::: "memory");
    const int c = lane & 7;
#pragma unroll
    for (int j = 0; j < 4; ++j) { const int n = (lane >> 3) + 8 * j; const LAS float* s = scr + (8 * c) * 33 + n;
        v4u o; o.x = pk2(s[0 * 33], s[1 * 33]); o.y = pk2(s[2 * 33], s[3 * 33]); o.z = pk2(s[4 * 33], s[5 * 33]); o.w = pk2(s[6 * 33], s[7 * 33]);
        *(GAS v4u*)(WT + (size_t)(n0 + n) * K + k0 + 8 * c) = o; }
    LDS_WAIT(); asm volatile("" ::: "memory");
}
typedef const __attribute__((address_space(4))) Args CArgs;
__device__ __forceinline__ CArgs* kargs(int dep) { CArgs* p = (CArgs*)__builtin_amdgcn_kernarg_segment_ptr(); asm volatile("; kargs %1" : "+s"(p) : "s"(dep)); return p; }
__device__ __forceinline__ void p0_mod(CArgs* ap, LAS unsigned char* lds, int tid, int lane, int wave, int vcu, int G) {
    unsigned char* ws = ap->ws;
    float* mod = (float*)(ws + WS_MOD); Misc* ms = (Misc*)(ws + WS_MISC);
    if (vcu < 96) {
        LAS float* cact = (LAS float*)lds;
        LAS float* red = (LAS float*)(lds + 32768);
        const float* c = ap->in[I_C];
        for (int i = tid; i < NB * D; i += NWAVES * 64) cact[i] = siluf(c[i]);
        __syncthreads();
        const int li = vcu / 48, n = (vcu % 48) * 64 + lane; const float* mw = ap->in[I_MODW] + ((size_t)li * D + wave * 128) * 3072 + n;
        float acc[NB];
#pragma unroll
        for (int b = 0; b < NB; ++b) acc[b] = 0.f;
        for (int k0 = 0; k0 < 128; k0 += 16) { float wv[16];
#pragma unroll
            for (int k = 0; k < 16; ++k) wv[k] = mw[(size_t)(k0 + k) * 3072];
#pragma unroll
            for (int k = 0; k < 16; ++k) {
#pragma unroll
                for (int b = 0; b < NB; ++b) acc[b] += cact[b * D + wave * 128 + k0 + k] * wv[k]; } }
#pragma unroll
        for (int b = 0; b < NB; ++b) red[(wave * NB + b) * 64 + lane] = acc[b];
        __syncthreads();
        { const int b = tid >> 6; float s = 0.f;
#pragma unroll
          for (int w = 0; w < NWAVES; ++w) s += red[(w * NB + b) * 64 + lane];
          mod[((size_t)li * NB + b) * 3072 + n] = s + ap->in[I_MODB][li * 3072 + n]; }
        __syncthreads();
    }
    if (vcu == 96 && tid < 128) {
        const int t = tid;
        if (t == 0) { float s1 = 0.f, s2 = 0.f; for (int i = 0; i < 64; ++i) { s1 += ap->in[I_BLQ1][i] * ap->in[I_BLK1][i]; s2 += ap->in[I_BLQ2][i] * ap->in[I_BLK2][i]; } ms->lam = expf(s1) - expf(s2) + LAMBDA_INIT; }
        int bk; if (t < 16) bk = t; else { bk = 16 + (int)(logf((float)t / 16.f) / 2.0794415416798357f * 16.f); if (bk > 31) bk = 31; } ms->lut[t] = bk;
        for (int cix = 0; cix < 16; ++cix) ms->btab[t * 16 + cix] = ap->in[I_RELB][bk * 16 + cix];
    }
}
__device__ __forceinline__ void p0_weights(CArgs* ap, LAS unsigned char* lds, int lane, int wave, int vcu, int G) {
    unsigned char* ws = ap->ws;
    LAS float* scr = (LAS float*)(lds + RING_OFF + wave * 16384);
    const int gw = vcu * NWAVES + wave, NGW = G * NWAVES;
    bf16 *win0 = (bf16*)(ws + WS_WIN0), *wq2 = (bf16*)(ws + WS_WQ2), *wuv = (bf16*)(ws + WS_WUV), *wout0 = (bf16*)(ws + WS_WOUT0), *win1 = (bf16*)(ws + WS_WIN1), *wout1 = (bf16*)(ws + WS_WOUT1);
    constexpr int I_A = 16 * 48, I_QI = 4 * 16, I_O0 = 16 * 32, I_B = 16 * 128, I_O1 = 16 * 32, NITEMS = I_A + I_QI + I_O0 + I_B + I_O1;
    for (int it = gw; it < NITEMS; it += NGW) {
        int r = it;
        if (r < I_B) { p0_transpose_item<false>(ap->in[I_BWIN], D, B_IN, B_IN, nullptr, win1, scr, r, lane); continue; } r -= I_B;
        if (r < I_A) { p0_transpose_item<false>(ap->in[I_AWIN], D, A_IN, A_INP, nullptr, win0, scr, r, lane); continue; } r -= I_A;
        if (r < I_O0) { p0_transpose_item<false>(ap->in[I_AWOUT], D, D, D, nullptr, wout0, scr, r, lane); continue; } r -= I_O0;
        if (r < I_O1) { p0_transpose_item<false>(ap->in[I_BWOUT], D, D, D, nullptr, wout1, scr, r, lane); continue; } r -= I_O1;
        p0_transpose_item<true>(ap->in[I_AWQIDX], QR, 512, 512, ap->in[I_AQN], wq2, scr, r, lane);
    }
    for (int it = gw; it < 16 * 4 * 32; it += NGW) {
        const int h = it >> 7, kt = (it >> 5) & 3, r0 = (it & 31) * 4, k = kt * 64 + lane;
        const float* uq = ap->in[I_AWUQ] + (size_t)k * 1024 + h * 64; float av[64];
#pragma unroll
        for (int d4 = 0; d4 < 16; ++d4) { const f32x4 t4 = *(const f32x4*)(uq + 4 * d4); av[4 * d4] = t4[0]; av[4 * d4 + 1] = t4[1]; av[4 * d4 + 2] = t4[2]; av[4 * d4 + 3] = t4[3]; }
        const float gk = ap->in[I_AQN][k] * C2;
#pragma unroll
        for (int rr = 0; rr < 4; ++rr) { const int r = r0 + rr; const float* uk = ap->in[I_AWUK] + ((size_t)h * 128 + r) * 64; float s = 0.f;
#pragma unroll
            for (int d = 0; d < 64; ++d) s += av[d] * uk[d];
            wq2[(size_t)(512 + h * 128 + r) * 256 + k] = (bf16)f2bf(s * gk); }
    }
    for (int i = gw * 64 + lane; i < 1024 * 512; i += NGW * 64) {
        const int n = i >> 9, kp = i & 511, h = n >> 6, d = n & 63; float v = 0.f;
        if ((kp >> 7) == ((n & 255) >> 6)) v = ap->in[I_AWUV][((size_t)h * 128 + (kp & 127)) * 64 + d];
        wuv[i] = (bf16)f2bf(v);
    }
}
__device__ __forceinline__ void prenorm_rows(const float* x, const float* g, const float* modl, bf16* H, int gw, int NGW, int lane) {
    for (int row = gw; row < M; row += NGW) {
        const int b = row / L; const GAS f32x4* xr = (const GAS f32x4*)(x + (size_t)row * D) + lane;
        f32x4 v[4]; float s = 0.f;
#pragma unroll
        for (int j = 0; j < 4; ++j) { v[j] = xr[64 * j]; s += (v[j].x * v[j].x + v[j].y * v[j].y) + (v[j].z * v[j].z + v[j].w * v[j].w); }
        const float rs = rsqrtf(wave_sum(s) * (1.f / D) + EPS);
        const f32x4* g4 = (const f32x4*)g + lane; const f32x4* sh4 = (const f32x4*)(modl + (size_t)b * 3072) + lane; const f32x4* sc4 = sh4 + 256;
        GAS unsigned long long* o8 = (GAS unsigned long long*)(H + (size_t)row * D) + lane;
#pragma unroll
        for (int j = 0; j < 4; ++j) { const f32x4 o = v[j] * rs * g4[64 * j] * (sc4[64 * j] + 1.f) + sh4[64 * j];
            o8[64 * j] = (unsigned long long)pk2(o.x, o.y) | ((unsigned long long)pk2(o.z, o.w) << 32); }
    }
}
template <bool XIN_BF16, bool XOUT_BF16> __device__ __forceinline__ void post_rows(const void* xin, const bf16* Y, const float* postg, const float* modc, const float* pregn, const float* modn, void* xout, bf16* H, int gw, int NGW, int lane) {
    for (int row = gw; row < M; row += NGW) {
        const int b = row / L; const GAS unsigned long long* y8 = (const GAS unsigned long long*)(Y + (size_t)row * D) + lane;
        f32x4 yv[4]; float s = 0.f;
#pragma unroll
        for (int j = 0; j < 4; ++j) { const unsigned long long w = y8[64 * j]; const unsigned lo = (unsigned)w, hi = (unsigned)(w >> 32);
            yv[j].x = __uint_as_float(lo << 16); yv[j].y = __uint_as_float(lo & 0xffff0000u); yv[j].z = __uint_as_float(hi << 16); yv[j].w = __uint_as_float(hi & 0xffff0000u);
            s += (yv[j].x * yv[j].x + yv[j].y * yv[j].y) + (yv[j].z * yv[j].z + yv[j].w * yv[j].w); }
        const float rs = rsqrtf(wave_sum(s) * (1.f / D) + EPS);
        const GAS f32x4* xr = (const GAS f32x4*)((const float*)xin + (size_t)row * D) + lane; GAS f32x4* xo = (GAS f32x4*)((float*)xout + (size_t)row * D) + lane;
        const GAS unsigned long long* xrb = (const GAS unsigned long long*)((const bf16*)xin + (size_t)row * D) + lane; GAS unsigned long long* xob = (GAS unsigned long long*)((bf16*)xout + (size_t)row * D) + lane;
        const f32x4* pg4 = (const f32x4*)postg + lane; const f32x4* rg4 = (const f32x4*)(modc + (size_t)b * 3072 + 2048) + lane;
        f32x4 x1[4]; float s2 = 0.f;
#pragma unroll
        for (int j = 0; j < 4; ++j) { f32x4 xi;
            if (XIN_BF16) { const unsigned long long w = xrb[64 * j]; const unsigned lo = (unsigned)w, hi = (unsigned)(w >> 32); xi.x = __uint_as_float(lo << 16); xi.y = __uint_as_float(lo & 0xffff0000u); xi.z = __uint_as_float(hi << 16); xi.w = __uint_as_float(hi & 0xffff0000u); }
            else xi = xr[64 * j];
            x1[j] = xi + rg4[64 * j] * (yv[j] * rs * pg4[64 * j]);
            if (XOUT_BF16) xob[64 * j] = (unsigned long long)pk2(x1[j].x, x1[j].y) | ((unsigned long long)pk2(x1[j].z, x1[j].w) << 32); else xo[64 * j] = x1[j];
            s2 += (x1[j].x * x1[j].x + x1[j].y * x1[j].y) + (x1[j].z * x1[j].z + x1[j].w * x1[j].w); }
        if (H) { const float r2 = rsqrtf(wave_sum(s2) * (1.f / D) + EPS);
            const f32x4* g4 = (const f32x4*)pregn + lane; const f32x4* sh4 = (const f32x4*)(modn + (size_t)b * 3072) + lane; const f32x4* sc4 = sh4 + 256;
            GAS unsigned long long* o8 = (GAS unsigned long long*)(H + (size_t)row * D) + lane;
#pragma unroll
            for (int j = 0; j < 4; ++j) { const f32x4 o = x1[j] * r2 * g4[64 * j] * (sc4[64 * j] + 1.f) + sh4[64 * j];
                o8[64 * j] = (unsigned long long)pk2(o.x, o.y) | ((unsigned long long)pk2(o.z, o.w) << 32); } }
    }
}
__device__ __forceinline__ void norm_kv_rows(const bf16* proj0, const float* stats, const float* kvg, const float* kig, bf16* ckv, bf16* ki, float* wi, int gw, int NGW, int lane) {
    for (int row = gw; row < M; row += NGW) {
        const float* st = stats + (size_t)row * 16; const bf16* p = proj0 + (size_t)row * A_INP;
        const float rkv = rsqrtf(((st[4] + st[5]) + (st[6] + st[7])) * (1.f / 128.f) + EPS), rki = rsqrtf((st[8] + st[9]) * (1.f / 64.f) + EPS);
        const unsigned w = *(const unsigned*)(p + 256 + 2 * lane);
        const float a0 = __uint_as_float(w << 16) * rkv * kvg[2 * lane], a1 = __uint_as_float(w & 0xffff0000u) * rkv * kvg[2 * lane + 1];
        *(unsigned*)(ckv + (size_t)row * 128 + 2 * lane) = pk2(a0, a1);
        ki[(size_t)row * 64 + lane] = (bf16)f2bf(bf2f(p[384 + lane]) * rki * kig[lane]);
        if (lane < 8) wi[(size_t)row * 8 + lane] = bf2f(p[448 + lane]) * (0.35355339059327373f * 0.125f);
    }
}

__global__ void __launch_bounds__(NWAVES * 64, 2) mk_fwd(Args args) {
    extern __shared__ __attribute__((aligned(16))) unsigned char lds_raw[];
    LAS unsigned char* lds = (LAS unsigned char*)lds_raw;
    const int wave = __builtin_amdgcn_readfirstlane(threadIdx.x >> 6);
    const int G = gridDim.x; const int bx = blockIdx.x; const int vcu = (G % 8 == 0) ? (bx % 8) * (G / 8) + bx / 8 : bx;
    for (int u = wave * 64 + lane_now(0); u < (LDS_BYTES - LDSCTL_OFF) / 4; u += NWAVES * 64) ((LAS unsigned*)(lds + LDSCTL_OFF))[u] = 0u;
    __syncthreads();
    XcdBarrier bar = xcd_barrier_post((unsigned*)((gu32*)(args.ws + WS_CTL) + CW_BAR) + args.li * XCD_BAR_WORDS, (volatile LAS unsigned*)(lds + MISC_OFF) + 8, wave);
    const int lo = args.ph_lo, hi = args.ph_hi;
#define IN(k) (lo <= (k) && (k) < hi)
#ifndef REP_PHASE
#define REP_PHASE (-1)
#endif
#define PHASE_BEGIN(k) if (IN(k)) { for (int rep_ = 0; rep_ < ((k) == REP_PHASE ? 2 : 1); ++rep_) { if (rep_) xcd_barrier(bar);
#define PHASE_END(k) } } SEAM(k);
#define SEAM(k) do { if (IN(k) && IN((k) + 1)) xcd_barrier(bar); } while (0)
    const int gw = vcu * NWAVES + wave, NGW = G * NWAVES;

    PHASE_BEGIN(PH_PRO) const int lane = fresh_lane(); CArgs* A = kargs(PH_PRO);
        if (G > 128) { if (vcu < 96) p0_mod(A, lds, wave * 64 + lane, lane, wave, vcu, G); else { p0_mod(A, lds, wave * 64 + lane, lane, wave, vcu, G); p0_weights(A, lds, lane, wave, vcu - 96, G - 96); } }
        else { p0_mod(A, lds, wave * 64 + lane, lane, wave, vcu, G); p0_weights(A, lds, lane, wave, vcu, G); }
    PHASE_END(PH_PRO)
    PHASE_BEGIN(PH_PRE0) CArgs* A = kargs(PH_PRE0); unsigned char* ws = A->ws; prenorm_rows(A->in[I_X], A->in[I_PREG], (const float*)(ws + WS_MOD), (bf16*)(ws + WS_H), gw, NGW, fresh_lane());
#ifndef REP_W
#define REP_W 1
#endif
        PHASE_END(PH_PRE0)
    PHASE_BEGIN(PH_INPROJ0)
        CArgs* A = kargs(PH_INPROJ0); unsigned char* ws = A->ws;
        pg8::Gemm g{(const bf16*)(ws + WS_H), (const bf16*)(ws + WS_WIN0), M, A_INP, D, D, D, 0}; pg8::StaticOrder S; S.init(M, A_INP, G, bx);
        pg8::Epi<pg8::EM_PROJ0> E{(bf16*)(ws + WS_PROJ0), A_INP, (float*)(ws + WS_STATS), nullptr, 0};
        pg8::gemm_phase<pg8::Epi<pg8::EM_PROJ0>, pg8::StaticOrder, true, true>(lds + RING_OFF, g, S, E, wave);
    PHASE_END(PH_INPROJ0)
    PHASE_BEGIN(PH_QGEMM)
        CArgs* A = kargs(PH_QGEMM); unsigned char* ws = A->ws;
        pg8::Gemm g{(const bf16*)(ws + WS_PROJ0), (const bf16*)(ws + WS_WQ2), M, NQQ, QR, A_INP, QR, 0}; pg8::StaticOrder S; S.init(M, NQQ, G, bx);
        pg8::Epi<pg8::EM_ROWSCALE> E{(bf16*)(ws + WS_QQ), NQQ, (float*)(ws + WS_STATS), nullptr, 0};
        pg8::gemm_phase<pg8::Epi<pg8::EM_ROWSCALE>, pg8::StaticOrder, true, true>(lds + RING_OFF, g, S, E, wave);
        norm_kv_rows((const bf16*)(ws + WS_PROJ0), (const float*)(ws + WS_STATS), A->in[I_AKVN], A->in[I_AKIN], (bf16*)(ws + WS_CKV), (bf16*)(ws + WS_KI), (float*)(ws + WS_WI), gw, NGW, fresh_lane());
    PHASE_END(PH_QGEMM)
    PHASE_BEGIN(PH_TOPK)
        CArgs* A = kargs(PH_TOPK); unsigned char* ws = A->ws; const Misc* ms = (const Misc*)(ws + WS_MISC);
        unsigned* sel = (unsigned*)(ws + WS_SEL); const int lane = fresh_lane();
        const bf16* qq = (const bf16*)(ws + WS_QQ); const bf16* ki = (const bf16*)(ws + WS_KI); const float* wi = (const float*)(ws + WS_WI);
        float* btl = (float*)((char*)lds_raw + sparse::BT_OFF);
        for (int i = wave * 64 + lane; i < 128 * 16; i += NWAVES * 64) btl[i] = ms->btab[i] * LOG2E;
        __syncthreads();
        for (int p = vcu; p < NB * 64; p += G) {
            const int b = p >> 6, u = p & 63;
            for (int r2 = 0; r2 < 2; ++r2) topk::unit(qq, ki, wi, sel, b, 16 * (r2 ? 127 - u : u), (LAS unsigned*)(lds + RING_OFF), wave, fresh_lane(p + r2));
            asm volatile("s_waitcnt vmcnt(0)" ::: "memory"); __syncthreads();
            const int tq0 = (wave < 4 ? 16 * u : 16 * (127 - u)) + 4 * (wave & 3);
            sparse::stream(qq, (const bf16*)(ws + WS_CKV), sel, (bf16*)(ws + WS_OLAT), b * L + tq0, 4, (char*)lds_raw + wave * sparse::WAVE_LDS, btl, fresh_lane(p + 2));
            __syncthreads();
        }
    } }
    PHASE_BEGIN(PH_SPARSE)
    PHASE_END(PH_SPARSE)
    PHASE_BEGIN(PH_UV)
        CArgs* A = kargs(PH_UV); unsigned char* ws = A->ws;
        pg8::Gemm g{(const bf16*)(ws + WS_OLAT), (const bf16*)(ws + WS_WUV), M, D, 512, 2048, 512, 512}; pg8::StaticOrder S; S.init(M, D, G, bx);
        pg8::Epi<pg8::EM_UVGATE> E{(bf16*)(ws + WS_OG0), D, nullptr, (const bf16*)(ws + WS_PROJ0) + 456, A_INP};
        pg8::gemm_phase<pg8::Epi<pg8::EM_UVGATE>, pg8::StaticOrder, true, true>(lds + RING_OFF, g, S, E, wave);
    PHASE_END(PH_UV)
    PHASE_BEGIN(PH_OUT0)
        CArgs* A = kargs(PH_OUT0); unsigned char* ws = A->ws;
        pg8::Gemm g{(const bf16*)(ws + WS_OG0), (const bf16*)(ws + WS_WOUT0), M, D, D, D, D, 0}; pg8::StaticOrder S; S.init(M, D, G, bx);
        pg8::Epi<pg8::EM_PLAIN> E{(bf16*)(ws + WS_Y0), D, nullptr, nullptr, 0};
        pg8::gemm_phase<pg8::Epi<pg8::EM_PLAIN>, pg8::StaticOrder, true, true>(lds + RING_OFF, g, S, E, wave);
    PHASE_END(PH_OUT0)
    PHASE_BEGIN(PH_POST0) CArgs* A = kargs(PH_POST0); unsigned char* ws = A->ws; const float* mod = (const float*)(ws + WS_MOD);
        post_rows<false, true>(A->in[I_X], (const bf16*)(ws + WS_Y0), A->in[I_POSTG], mod, A->in[I_PREG] + D, mod + (size_t)NB * 3072, ws + WS_X1B, (bf16*)(ws + WS_H), gw, NGW, fresh_lane()); PHASE_END(PH_POST0)
    PHASE_BEGIN(PH_INPROJ1)
        CArgs* A = kargs(PH_INPROJ1); unsigned char* ws = A->ws;
        pg8::Gemm g{(const bf16*)(ws + WS_H), (const bf16*)(ws + WS_WIN1), M, B_IN, D, D, D, 0}; pg8::StaticOrder S; S.init(M, B_IN, G, bx);
        pg8::Epi<pg8::EM_PROJ1> E{(bf16*)(ws + WS_PROJ1), B_IN, nullptr, nullptr, 0};
        pg8::gemm_phase<pg8::Epi<pg8::EM_PROJ1>, pg8::StaticOrder, true, true>(lds + RING_OFF, g, S, E, wave);
    PHASE_END(PH_INPROJ1)
    PHASE_BEGIN(PH_ATTN1)
        CArgs* A = kargs(PH_ATTN1); unsigned char* ws = A->ws; const Misc* ms = (const Misc*)(ws + WS_MISC);
        const bf16* proj1 = (const bf16*)(ws + WS_PROJ1); bf16* og1 = (bf16*)(ws + WS_OG1); const float* subln = A->in[I_BSUBLN];
        attn_body::bf16* oscr = (attn_body::bf16*)(ws + WS_OSCR);
        const attn_body::bf16* pj = (const attn_body::bf16*)proj1;
        char* shm = (char*)lds_raw + RING_OFF;
        for (int p = vcu; p < 256; p += G) {
            const int bh = p >> 2, s4 = p & 3, b = bh >> 3, h = bh & 7;
            for (int ui = 0; ui < 2; ++ui) {
                const int qb = ui == 0 ? s4 : 7 - s4;
                attn_body::bf16* ob = oscr + (size_t)vcu * 256 * attn_body::OPITCH;
                for (int vi = 0; vi < 2; ++vi) {
                    const int mp = 2 * h + vi;
                    attn2::attn_unit<8>(wave, b, qb, (const attn2::bf16*)pj + mp * 64, (const attn2::bf16*)pj + 1024 + mp * 64, (const attn2::bf16*)pj + 2048 + h * 128, (attn2::bf16*)ob + vi * 128, ms->btab + mp, shm);
                }
                asm volatile("s_waitcnt vmcnt(0)" ::: "memory");
                const int lane2 = fresh_lane(qb);
                const int ch = lane2 & 15, rsub = lane2 >> 4; const float lam = ms->lam;
                const f32x4 s0 = *(const f32x4*)(subln + 8 * ch), s1 = *(const f32x4*)(subln + 8 * ch + 4);
                for (int it = 0; it < 8; ++it) {
                    const int r = wave * 32 + 4 * it + rsub, t = qb * 256 + r; const size_t grow = (size_t)b * L + t;
                    const v4u a1 = __builtin_nontemporal_load((const v4u*)((const bf16*)ob + (size_t)r * 256 + 8 * ch)), a2 = __builtin_nontemporal_load((const v4u*)((const bf16*)ob + (size_t)r * 256 + 128 + 8 * ch));
                    const v4u gq = *(const v4u*)(proj1 + grow * B_IN + 3072 + h * 128 + 8 * ch);
                    float o[8]; float ss = 0.f;
#pragma unroll
                    for (int q = 0; q < 4; ++q) { o[2 * q] = __uint_as_float(a1[q] << 16) - lam * __uint_as_float(a2[q] << 16); o[2 * q + 1] = __uint_as_float(a1[q] & 0xffff0000u) - lam * __uint_as_float(a2[q] & 0xffff0000u);
                        ss += o[2 * q] * o[2 * q] + o[2 * q + 1] * o[2 * q + 1]; }
                    ss += dpp_f<0xB1>(ss); ss += dpp_f<0x4E>(ss); ss += dpp_f<0x141>(ss); ss += dpp_f<0x140>(ss);
                    const float rs = rsqrtf(ss * (1.f / 128.f) + EPS) * (1.f - LAMBDA_INIT);
                    v4u w;
#pragma unroll
                    for (int q = 0; q < 4; ++q) { const float g0 = __uint_as_float(gq[q] << 16), g1 = __uint_as_float(gq[q] & 0xffff0000u);
                        const float sa = q < 2 ? s0[2 * q] : s1[2 * q - 4], sb = q < 2 ? s0[2 * q + 1] : s1[2 * q - 3];
                        w[q] = pk2(o[2 * q] * rs * sa * siluf(g0), o[2 * q + 1] * rs * sb * siluf(g1)); }
                    *(v4u*)(og1 + grow * D + h * 128 + 8 * ch) = w;
                }
            }
        }
    PHASE_END(PH_ATTN1)
    PHASE_BEGIN(PH_OUT1)
        CArgs* A = kargs(PH_OUT1); unsigned char* ws = A->ws;
        pg8::Gemm g{(const bf16*)(ws + WS_OG1), (const bf16*)(ws + WS_WOUT1), M, D, D, D, D, 0}; pg8::StaticOrder S; S.init(M, D, G, bx);
        pg8::Epi<pg8::EM_PLAIN> E{(bf16*)(ws + WS_Y1), D, nullptr, nullptr, 0};
        pg8::gemm_phase<pg8::Epi<pg8::EM_PLAIN>, pg8::StaticOrder, true, true>(lds + RING_OFF, g, S, E, wave);
    PHASE_END(PH_OUT1)
    PHASE_BEGIN(PH_FINAL) CArgs* A = kargs(PH_FINAL); unsigned char* ws = A->ws;
        post_rows<true, false>(ws + WS_X1B, (const bf16*)(ws + WS_Y1), A->in[I_POSTG] + D, (const float*)(ws + WS_MOD) + (size_t)NB * 3072, nullptr, nullptr, A->out, nullptr, gw, NGW, fresh_lane()); } }
#undef IN
#undef SEAM
}

__device__ __forceinline__ float block_sum(float v, float* red) {
    for (int o = 32; o > 0; o >>= 1) v += __shfl_xor(v, o);
    __syncthreads(); if ((threadIdx.x & 63) == 0) red[threadIdx.x >> 6] = v; __syncthreads();
    return red[0] + red[1] + red[2] + red[3];
}
__device__ __forceinline__ unsigned fkey(float f) { unsigned u = __float_as_uint(f); return (u & 0x80000000u) ? ~u : (u | 0x80000000u); }
__global__ void __launch_bounds__(256) k_topk(const bf16_t* qq, const bf16_t* ki, const float* wi, unsigned* sel) {
    __shared__ float qs[512]; __shared__ unsigned keys[2048]; __shared__ unsigned cnts[256]; __shared__ unsigned words[64]; __shared__ float ws[8];
    int row = blockIdx.x, b = row / L, t = row % L, tid = threadIdx.x;
    for (int i = tid; i < 512; i += 256) qs[i] = bf2f(qq[(size_t)row * NQQ + i]);
    if (tid < 8) ws[tid] = wi[(size_t)row * 8 + tid];
    if (tid < 64) words[tid] = 0u;
    __syncthreads();
    for (int s = tid; s < L; s += 256) {
        unsigned kk = 0u;
        if (s <= t) { const bf16_t* kr = ki + ((size_t)b * L + s) * 64; float a0 = 0.f, a1 = 0.f, a2 = 0.f, a3 = 0.f, a4 = 0.f, a5 = 0.f, a6 = 0.f, a7 = 0.f;
            for (int d = 0; d < 64; ++d) { float kf = bf2f(kr[d]); a0 += qs[d] * kf; a1 += qs[64 + d] * kf; a2 += qs[128 + d] * kf; a3 += qs[192 + d] * kf;
                a4 += qs[256 + d] * kf; a5 += qs[320 + d] * kf; a6 += qs[384 + d] * kf; a7 += qs[448 + d] * kf; }
            float sc = ws[0] * fmaxf(a0, 0.f); sc += ws[1] * fmaxf(a1, 0.f); sc += ws[2] * fmaxf(a2, 0.f); sc += ws[3] * fmaxf(a3, 0.f);
            sc += ws[4] * fmaxf(a4, 0.f); sc += ws[5] * fmaxf(a5, 0.f); sc += ws[6] * fmaxf(a6, 0.f); sc += ws[7] * fmaxf(a7, 0.f);
            kk = fkey(sc); }
        keys[s] = kk;
    }
    __syncthreads();
    int nvalid = t + 1;
    if (nvalid <= TOPK) { for (int s = tid; s <= t; s += 256) atomicOr(&words[s >> 5], 1u << (s & 31)); }
    else {
        unsigned prefix = 0u;
        for (int bit = 31; bit >= 0; --bit) {
            unsigned cand = prefix | (1u << bit); unsigned c = 0;
            for (int i = 0; i < 8; ++i) c += keys[tid * 8 + i] >= cand;
            cnts[tid] = c; __syncthreads();
            for (int o = 128; o > 0; o >>= 1) { if (tid < o) cnts[tid] += cnts[tid + o]; __syncthreads(); }
            unsigned tot = cnts[0]; __syncthreads();
            if (tot >= (unsigned)TOPK) prefix = cand;
        }
        unsigned cg = 0, ce = 0; for (int i = 0; i < 8; ++i) { unsigned k = keys[tid * 8 + i]; cg += k > prefix; ce += k == prefix; }
        cnts[tid] = cg; __syncthreads();
        for (int o = 128; o > 0; o >>= 1) { if (tid < o) cnts[tid] += cnts[tid + o]; __syncthreads(); }
        unsigned ngt = cnts[0]; __syncthreads();
        cnts[tid] = ce; __syncthreads();
        if (tid == 0) { unsigned run = 0; for (int i = 0; i < 256; ++i) { unsigned v = cnts[i]; cnts[i] = run; run += v; } }
        __syncthreads();
        unsigned need = TOPK - ngt, rank = cnts[tid];
        for (int i = 0; i < 8; ++i) { int s = tid * 8 + i; unsigned k = keys[s]; bool take = k > prefix; if (k == prefix) { take = rank < need; ++rank; }
            if (take) atomicOr(&words[s >> 5], 1u << (s & 31)); }
    }
    __syncthreads();
    if (tid < 64) sel[(size_t)row * 64 + tid] = words[tid];
}
__global__ void __launch_bounds__(256) k_sparse(const bf16_t* qq, const bf16_t* ckv, const unsigned* sel, const Misc* ms, bf16_t* olat) {
    __shared__ float qa[16 * 128]; __shared__ int idx[256]; __shared__ float lg[16 * 256]; __shared__ int nsel_s;
    int row = blockIdx.x, b = row / L, t = row % L, tid = threadIdx.x;
    for (int i = tid; i < 2048; i += 256) qa[i] = bf2f(qq[(size_t)row * NQQ + 512 + i]);
    if (tid == 0) { int n = 0; for (int w = 0; w < 64; ++w) { unsigned v = sel[(size_t)row * 64 + w]; while (v) { int bpos = __ffs(v) - 1; v &= v - 1; if (n < 256) idx[n] = w * 32 + bpos; ++n; } } nsel_s = n < 256 ? n : 256; }
    __syncthreads();
    int ns = nsel_s;
    for (int p = tid; p < 16 * 256; p += 256) { int h = p >> 8, k = p & 255; float v = -INFINITY;
        if (k < ns) { const bf16_t* kr = ckv + ((size_t)b * L + idx[k]) * 128; float a = 0.f; for (int r = 0; r < 128; ++r) a += qa[h * 128 + r] * bf2f(kr[r]);
            int dd = t - idx[k]; if (dd > 127) dd = 127; v = a + ms->btab[dd * 16 + h] * LOG2E; }
        lg[p] = v; }
    __syncthreads();
    if (tid < 16) { float mx = -INFINITY; for (int k = 0; k < ns; ++k) mx = fmaxf(mx, lg[tid * 256 + k]); float s = 0.f;
        for (int k = 0; k < ns; ++k) { float e = exp2f(lg[tid * 256 + k] - mx); lg[tid * 256 + k] = e; s += e; } float inv = 1.f / s; for (int k = 0; k < ns; ++k) lg[tid * 256 + k] *= inv; }
    __syncthreads();
    for (int o = tid; o < 2048; o += 256) { int h = o >> 7, r = o & 127; float a = 0.f;
        for (int k = 0; k < ns; ++k) a += lg[h * 256 + k] * bf2f(ckv[((size_t)b * L + idx[k]) * 128 + r]);
        olat[(size_t)row * 2048 + o] = f2bf(a); }
}
__global__ void __launch_bounds__(256) k_diffattn(const bf16_t* proj, const Misc* ms, const float* subln, bf16_t* og) {
    __shared__ float q[2][64]; __shared__ float p[2][2048]; __shared__ float red[4]; __shared__ float part[2][128];
    int row = blockIdx.x, h = blockIdx.y, b = row / L, t = row % L, tid = threadIdx.x;
    if (tid < 128) q[tid >> 6][tid & 63] = bf2f(proj[(size_t)row * B_IN + (2 * h + (tid >> 6)) * 64 + (tid & 63)]);
    __syncthreads();
    float mx[2] = {-INFINITY, -INFINITY};
    for (int l = tid; l <= t; l += 256) { int dd = t - l; if (dd > 127) dd = 127;
        for (int j = 0; j < 2; ++j) { const bf16_t* kr = proj + ((size_t)b * L + l) * B_IN + 1024 + (2 * h + j) * 64; float a = 0.f;
            for (int d = 0; d < 64; ++d) a += q[j][d] * bf2f(kr[d]);
            a += ms->btab[dd * 16 + 2 * h + j] * LOG2E; p[j][l] = a; mx[j] = fmaxf(mx[j], a); } }
    float sm[2];
    for (int j = 0; j < 2; ++j) { float m = mx[j]; for (int o = 32; o > 0; o >>= 1) m = fmaxf(m, __shfl_xor(m, o));
        __syncthreads(); if ((tid & 63) == 0) red[tid >> 6] = m; __syncthreads(); m = fmaxf(fmaxf(red[0], red[1]), fmaxf(red[2], red[3]));
        float s = 0.f; for (int l = tid; l <= t; l += 256) { float e = exp2f(p[j][l] - m); p[j][l] = e; s += e; }
        sm[j] = block_sum(s, red); }
    __syncthreads();
    float lam = ms->lam, i0 = 1.f / sm[0], i1 = lam / sm[1];
    int e = tid & 127, half = tid >> 7; float a = 0.f;
    for (int l = half; l <= t; l += 2) a += (p[0][l] * i0 - p[1][l] * i1) * bf2f(proj[((size_t)b * L + l) * B_IN + 2048 + h * 128 + e]);
    part[half][e] = a; __syncthreads();
    float o = part[0][e] + part[1][e];
    float ss = block_sum(half == 0 ? o * o : 0.f, red);
    if (half == 0) { float v = o * rsqrtf(ss / 128.f + EPS) * subln[e] * (1.f - LAMBDA_INIT);
        float gte = bf2f(proj[(size_t)row * B_IN + 3072 + h * 128 + e]);
        og[(size_t)row * D + h * 128 + e] = f2bf(v * siluf(gte)); }
}


extern "C" void kernel_launch(void* const* d_in, const int* in_sizes, int n_in, void* d_out, int out_size, void* d_ws, size_t ws_size, hipStream_t stream) {
    (void)in_sizes; (void)out_size; (void)ws_size;
    static int grid = 0;
    if (grid == 0) {
        int dev = 0, cus = 0;
        if (n_in != N_IN || hipGetDevice(&dev) != hipSuccess || hipDeviceGetAttribute(&cus, hipDeviceAttributeMultiprocessorCount, dev) != hipSuccess) { grid = -1; return; }
        if (hipFuncSetAttribute((const void*)mk_fwd, hipFuncAttributeMaxDynamicSharedMemorySize, LDS_BYTES) != hipSuccess) { grid = -1; return; }
        grid = cus;
    }
    if (grid < 0) return;
    char* ws = (char*)d_ws;
    hipMemsetAsync(ws + WS_CTL, 0, CTL_ZERO_BYTES, stream);
    Args a{};
    for (int i = 0; i < N_IN; ++i) a.in[i] = (const float*)d_in[i];
    a.out = (float*)d_out; a.ws = (unsigned char*)d_ws;
    int li = 0;
    auto run = [&](int lo, int hi) { a.ph_lo = lo; a.ph_hi = hi; a.li = li++; hipLaunchKernelGGL(mk_fwd, dim3(grid), dim3(NWAVES * 64), LDS_BYTES, stream, a); };
    Misc* ms = (Misc*)(ws + WS_MISC);
    bf16_t *ckv = (bf16_t*)(ws + WS_CKV), *ki = (bf16_t*)(ws + WS_KI); float* wi = (float*)(ws + WS_WI); unsigned* sel = (unsigned*)(ws + WS_SEL);
    bf16_t *qq = (bf16_t*)(ws + WS_QQ), *olat = (bf16_t*)(ws + WS_OLAT), *proj1 = (bf16_t*)(ws + WS_PROJ1), *og1 = (bf16_t*)(ws + WS_OG1);
#ifdef PROBE_PHASE
    run(PH_PRO, PROBE_PHASE + 1); run(PROBE_PHASE, PROBE_PHASE + 1); if (PROBE_PHASE + 1 < N_PHASES) run(PROBE_PHASE + 1, PH_FINAL + 1);
#else
    run(PH_PRO, PH_FINAL + 1);
#endif
}
```
